# Optimizing an MI355X kernel written in HIP

```python
import math
import jax, jax.numpy as jnp
from jax import lax
import numpy as np

D_MODEL = 2048
BATCH = 4
SEQ = 4096
DEPTH = 1

N_META = 16
GRID_W = 64
ROW_WIN = 8
COL_WIN = 16
NA_HEAD_DIM = 64
NA_WIDTH = D_MODEL // 2
NA_HEADS = NA_WIDTH // NA_HEAD_DIM
SSM_WIDTH = D_MODEL // 2
SSM_GROUP = 16
SSM_GROUPS = SSM_WIDTH // SSM_GROUP
SSM_STATE = 64
DT_MIN = 1e-3
DT_MAX = 1e-1
D_FF = ((8 * D_MODEL // 3 + 255) // 256) * 256
CONV_W = 3
RMS_EPS = 1e-6
IN_SPLITS = [NA_WIDTH, 2 * NA_WIDTH, 3 * NA_WIDTH, 3 * NA_WIDTH + SSM_WIDTH,
             3 * NA_WIDTH + SSM_WIDTH + D_MODEL]
IN_COLS = 3 * NA_WIDTH + SSM_WIDTH + 2 * D_MODEL

kernel_name = "hybrid_natten_s5_convffn_encoder"


def rms_norm(x, g):
    xf = x.astype(jnp.float32)
    y = xf * lax.rsqrt(jnp.mean(xf * xf, axis=-1, keepdims=True) + RMS_EPS)
    return (y * g.astype(jnp.float32)).astype(x.dtype)


def neighbourhood_attention(q, k, v, rpb):
    b, L, h, dh = q.shape
    rows = (L - N_META) // GRID_W
    kr = min(ROW_WIN, rows)
    scale = dh ** -0.5
    qm, km, vm = q[:, :N_META], k[:, :N_META], v[:, :N_META]
    qg = q[:, N_META:].reshape(b, rows, GRID_W, h, dh)
    kg = k[:, N_META:].reshape(b, rows, GRID_W, h, dh)
    vg = v[:, N_META:].reshape(b, rows, GRID_W, h, dh)

    s_m = jnp.einsum('bqhd,bkhd->bhqk', qm, km).astype(jnp.float32) * scale
    p_m = jax.nn.softmax(s_m, axis=-1).astype(v.dtype)
    o_m = jnp.einsum('bhqk,bkhd->bqhd', p_m, vm)

    r_idx = jnp.arange(rows)
    row_start = jnp.clip(r_idx - kr // 2, 0, rows - kr)
    dr = row_start[:, None] + jnp.arange(kr)[None] - r_idx[:, None] + (ROW_WIN - 1)
    c_idx = jnp.arange(GRID_W)
    col_start = jnp.clip(c_idx - COL_WIN // 2, 0, GRID_W - COL_WIN)
    col_keys = col_start[:, None] + jnp.arange(COL_WIN)[None]
    dc = col_keys - c_idx[:, None] + (COL_WIN - 1)

    def row_block(args):
        q_r, r0, dr_r = args
        k_rows = lax.dynamic_slice_in_dim(kg, r0, kr, axis=1)
        v_rows = lax.dynamic_slice_in_dim(vg, r0, kr, axis=1)
        k_win = k_rows[:, :, col_keys]
        v_win = v_rows[:, :, col_keys]
        bias = rpb[:, dr_r[:, None, None], dc[None]]
        s_loc = (jnp.einsum('bchd,bicjhd->bhcij', q_r, k_win).astype(jnp.float32) * scale
                 + jnp.transpose(bias, (0, 2, 1, 3))[None].astype(jnp.float32))
        s_loc = s_loc.reshape(b, h, GRID_W, kr * COL_WIN)
        s_meta = jnp.einsum('bchd,bmhd->bhcm', q_r, km).astype(jnp.float32) * scale
        p = jax.nn.softmax(jnp.concatenate([s_loc, s_meta], axis=-1), axis=-1).astype(v.dtype)
        p_loc = p[..., :kr * COL_WIN].reshape(b, h, GRID_W, kr, COL_WIN)
        p_meta = p[..., kr * COL_WIN:]
        return (jnp.einsum('bhcij,bicjhd->bchd', p_loc, v_win)
                + jnp.einsum('bhcm,bmhd->bchd', p_meta, vm))

    o_g = lax.map(row_block, (jnp.moveaxis(qg, 1, 0), row_start, dr))
    o_g = jnp.moveaxis(o_g, 0, 1).reshape(b, rows * GRID_W, h, dh)
    return jnp.concatenate([o_m, o_g], axis=1)


def _ssm_combine(left, right):
    a_l, b_l = left
    a_r, b_r = right
    return a_r * a_l, a_r * b_l + b_r


def s5_direction(u, lam_re, lam_im, log_step, b_re, b_im, c_re, c_im, reverse):
    f32 = jnp.float32
    lam = lax.complex(lam_re.astype(f32), lam_im.astype(f32))
    step = jnp.exp(log_step.astype(f32))[:, None]
    lam_bar = jnp.exp(lam * step)
    b_mat = lax.complex(b_re.astype(f32), b_im.astype(f32))
    b_bar = ((lam_bar - 1.0) / lam)[..., None] * b_mat
    bu = jnp.einsum('blgc,gnc->blgn', u.astype(jnp.complex64), b_bar)
    a = jnp.broadcast_to(lam_bar, bu.shape)
    _, states = lax.associative_scan(_ssm_combine, (a, bu), axis=1, reverse=reverse)
    c_mat = lax.complex(c_re.astype(f32), c_im.astype(f32))
    return jnp.real(jnp.einsum('blgn,gcn->blgc', states, c_mat))


def s5_branch(u, lam_re, lam_im, log_step, b_re, b_im, c_re, c_im, d_skip, w_glu):
    b, L, _ = u.shape
    ug = u.astype(jnp.float32).reshape(b, L, SSM_GROUPS, SSM_GROUP)
    y = (s5_direction(ug, lam_re[0], lam_im[0], log_step[0], b_re[0], b_im[0], c_re[0], c_im[0], False)
         + s5_direction(ug, lam_re[1], lam_im[1], log_step[1], b_re[1], b_im[1], c_re[1], c_im[1], True)
         + ug * d_skip.astype(jnp.float32).reshape(SSM_GROUPS, SSM_GROUP))
    y = jax.nn.gelu(y.reshape(b, L, SSM_WIDTH).astype(u.dtype))
    return y * jax.nn.sigmoid(y @ w_glu)


def conv_gated_ffn(h, w_up, conv_w, conv_b, w_down):
    a, g = jnp.split(h @ w_up, 2, axis=-1)
    ap = jnp.pad(a, ((0, 0), (1, 1), (0, 0)))
    a = ap[:, :-2] * conv_w[0] + ap[:, 1:-1] * conv_w[1] + ap[:, 2:] * conv_w[2] + conv_b
    return (jax.nn.gelu(a) * g) @ w_down


def setup_inputs(seed: int = 0) -> dict:
    key = jax.random.key(seed)
    ks = jax.random.split(key, 24)
    f32 = jnp.float32
    G, N, C = SSM_GROUPS, SSM_STATE, SSM_GROUP

    def nrm(k, shape, scale):
        return jax.random.normal(k, shape, f32) * scale

    n_idx = jnp.arange(N, dtype=f32)
    lam_re = -0.5 + 0.01 * jax.random.normal(ks[5], (DEPTH, 2, G, N), f32)
    lam_im = math.pi * n_idx + 0.01 * jax.random.normal(ks[6], (DEPTH, 2, G, N), f32)
    log_step = jax.random.uniform(ks[7], (DEPTH, 2, G), f32, math.log(DT_MIN), math.log(DT_MAX))
    b_scale = (2.0 * C) ** -0.5
    c_scale = (2.0 * N) ** -0.5
    return {
        "x": nrm(ks[0], (BATCH, SEQ, D_MODEL), 1.0),
        "meta_tokens": nrm(ks[1], (N_META, D_MODEL), 1.0),
        "norm1_g": 1.0 + nrm(ks[2], (DEPTH, D_MODEL), 0.02),
        "w_in": nrm(ks[3], (DEPTH, D_MODEL, IN_COLS), D_MODEL ** -0.5),
        "na_rpb": nrm(ks[4], (DEPTH, NA_HEADS, 2 * ROW_WIN - 1, 2 * COL_WIN - 1), 0.02),
        "ssm_lam_re": lam_re,
        "ssm_lam_im": lam_im,
        "ssm_log_step": log_step,
        "ssm_b_re": nrm(ks[8], (DEPTH, 2, G, N, C), b_scale),
        "ssm_b_im": nrm(ks[9], (DEPTH, 2, G, N, C), b_scale),
        "ssm_c_re": nrm(ks[10], (DEPTH, 2, G, C, N), c_scale),
        "ssm_c_im": nrm(ks[11], (DEPTH, 2, G, C, N), c_scale),
        "ssm_d": nrm(ks[12], (DEPTH, SSM_WIDTH), 1.0),
        "w_glu": nrm(ks[13], (DEPTH, SSM_WIDTH, SSM_WIDTH), SSM_WIDTH ** -0.5),
        "w_proj_na": nrm(ks[14], (DEPTH, NA_WIDTH, D_MODEL), NA_WIDTH ** -0.5),
        "w_proj_ssm": nrm(ks[15], (DEPTH, SSM_WIDTH, D_MODEL), SSM_WIDTH ** -0.5),
        "w_out": nrm(ks[16], (DEPTH, D_MODEL, D_MODEL), D_MODEL ** -0.5),
        "norm2_g": 1.0 + nrm(ks[17], (DEPTH, D_MODEL), 0.02),
        "w_up": nrm(ks[18], (DEPTH, D_MODEL, 2 * D_FF), D_MODEL ** -0.5),
        "conv_w": nrm(ks[19], (DEPTH, CONV_W, D_FF), CONV_W ** -0.5),
        "conv_b": nrm(ks[20], (DEPTH, D_FF), 0.01),
        "w_down": nrm(ks[21], (DEPTH, D_FF, D_MODEL), D_FF ** -0.5),
        "final_g": 1.0 + nrm(ks[22], (D_MODEL,), 0.02),
    }


def reference(x, meta_tokens, norm1_g, w_in, na_rpb, ssm_lam_re, ssm_lam_im, ssm_log_step,
              ssm_b_re, ssm_b_im, ssm_c_re, ssm_c_im, ssm_d, w_glu, w_proj_na, w_proj_ssm,
              w_out, norm2_g, w_up, conv_w, conv_b, w_down, final_g):
    b = x.shape[0]
    meta = jnp.broadcast_to(meta_tokens.astype(x.dtype)[None], (b, N_META, D_MODEL))
    h = jnp.concatenate([meta, x], axis=1)
    L = h.shape[1]
    for l in range(DEPTH):
        hn = rms_norm(h, norm1_g[l])
        q, k, v, u, g_na, g_ssm = jnp.split(hn @ w_in[l], IN_SPLITS, axis=-1)
        q = q.reshape(b, L, NA_HEADS, NA_HEAD_DIM)
        k = k.reshape(b, L, NA_HEADS, NA_HEAD_DIM)
        v = v.reshape(b, L, NA_HEADS, NA_HEAD_DIM)
        y_na = neighbourhood_attention(q, k, v, na_rpb[l]).reshape(b, L, NA_WIDTH) @ w_proj_na[l]
        y_ssm = s5_branch(u, ssm_lam_re[l], ssm_lam_im[l], ssm_log_step[l], ssm_b_re[l],
                          ssm_b_im[l], ssm_c_re[l], ssm_c_im[l], ssm_d[l], w_glu[l]) @ w_proj_ssm[l]
        mixed = jax.nn.sigmoid(g_na) * y_na + jax.nn.sigmoid(g_ssm) * y_ssm
        h = h + mixed @ w_out[l]
        h = h + conv_gated_ffn(rms_norm(h, norm2_g[l]), w_up[l], conv_w[l], conv_b[l], w_down[l])
    h = rms_norm(h, final_g)
    return h[:, N_META:]
```

```cpp
#include <hip/hip_runtime.h>
#include <cstdio>
#include <cstdint>
#define MK_N_LAUNCHES 10
namespace pg8 {
#define PG8_LAS __attribute__((address_space(3)))
typedef unsigned short bf16_t;
typedef short bf16x8 __attribute__((ext_vector_type(8)));
typedef float f32x4 __attribute__((ext_vector_type(4)));
typedef unsigned u32x4 __attribute__((ext_vector_type(4)));
constexpr int BM = 256, BK = 64, HALF = 128, HTB = HALF * BK * 2  , STAGE_BYTES = 8 * HTB, NXCD = 8, WGM = 8;

__host__ __device__ __forceinline__ int lds_byte(int r, int c) { const int st = (r >> 4) * 2 + (c >> 5), rr = r & 15, cc = c & 31, ob = rr * 64 + cc * 2; return st * 1024 + (ob ^ (((ob >> 9) & 1) << 5)); }
__host__ __device__ __forceinline__ void stage_rc(int b, int& R, int& C) { const int st = b / 1024, sb = b % 1024, swz = sb ^ (((sb >> 9) & 1) << 5); R = (st >> 1) * 16 + swz / 64; C = (st & 1) * 32 + (swz % 64) / 2; }
__host__ __device__ __forceinline__ int perm32(int rho) { const int n = rho >> 4, i = rho & 15; return 8 * (i >> 2) + 4 * n + (i & 3); }

struct Unit { int pm, pn; };
struct Gemm { const bf16_t* A; const bf16_t* Bt; int M, N, K; };

struct StaticOrder {
    int nM, nN, nwg, G, c;
    __host__ __device__ void init(int M, int N, int G_, int c_) { nM = M / BM; nN = N / BM; nwg = nM * nN; G = G_; c = c_; }
    __host__ __device__ bool next(int i, Unit& u) const {
        const long L = (long)i * G + c; if (L >= nwg) return false;
        int wgid = (int)L; { const int q = nwg / NXCD, r = nwg % NXCD, xcd = wgid % NXCD, off = wgid / NXCD; wgid = (xcd < r ? xcd * (q + 1) : r * (q + 1) + (xcd - r) * q) + off; }
        const int nig = WGM * nN, gid = wgid / nig, fm = gid * WGM, gsz = (nM - fm) < WGM ? (nM - fm) : WGM;
        u.pm = fm + ((wgid % nig) % gsz); u.pn = (wgid % nig) / gsz; return true;
    }
    __device__ __forceinline__ void a_ready(const Unit&) const {}
    __device__ __forceinline__ void done(const Unit&) const {}
};

__device__ __forceinline__ unsigned cvt_pk_bf16(float lo, float hi) { unsigned r; asm volatile("v_cvt_pk_bf16_f32 %0, %1, %2" : "=v"(r) : "v"(lo), "v"(hi)); return r; }
typedef float f32x2 __attribute__((ext_vector_type(2)));
template <class Epi, class Sched, bool ALIGN_EPI = false, bool SP2 = false>
__device__ __forceinline__ void gemm_phase(PG8_LAS unsigned char* lds, const Gemm g, const Sched& S, const Epi& E) {
    const int tid = threadIdx.x, wid = __builtin_amdgcn_readfirstlane(tid >> 6), lane = tid & 63, wr = wid >> 2, wc = wid & 3, fr = lane & 15, fq = lane >> 4;
    const int K = g.K, nt = K / BK;
    unsigned voffA[2], voffB[2];
#pragma unroll
    for (int i = 0; i < 2; ++i) { int R, C; stage_rc(tid * 16 + i * 8192, R, C); const int Rb = Epi::PERM ? ((R & ~31) + perm32(R & 31)) : R;
        voffA[i] = (unsigned)(R * K + C) * 2u; voffB[i] = (unsigned)(Rb * K + C) * 2u; }
    const size_t kstep = (size_t)(BK * 2);
    const size_t hstep = (size_t)HALF * K * 2;
    const size_t tstep = 2 * hstep;
    const unsigned ldsw = (unsigned)wid * 1024u;
    const int aoff = lds_byte(wr * 64 + fr, fq * 8), boff = lds_byte(wc * 32 + fr, fq * 8);
#define PG8_SA(b, h) (((b) * 2 + (h)) * HTB)
#define PG8_SB(b, h) ((4 + (b) * 2 + (h)) * HTB)
#define PG8_STAGE(bufoff, gbase, voff) do { _Pragma("unroll") for (int _i = 0; _i < 2; ++_i) \
        __builtin_amdgcn_global_load_lds((const unsigned*)((const char*)(gbase) + (voff)[_i]), (PG8_LAS unsigned*)(lds + (bufoff) + ldsw + _i * 8192), 16, 0, 0); } while (0)
#define PG8_LDA(dst, b, h) do { _Pragma("unroll") for (int m = 0; m < 4; ++m) _Pragma("unroll") for (int k = 0; k < 2; ++k) dst[m][k] = *(const PG8_LAS bf16x8*)(lds + PG8_SA(b, h) + aoff + m * 2048 + k * 1024); } while (0)
#define PG8_LDB(dst, b, h) do { _Pragma("unroll") for (int n = 0; n < 2; ++n) _Pragma("unroll") for (int k = 0; k < 2; ++k) dst[n][k] = *(const PG8_LAS bf16x8*)(lds + PG8_SB(b, h) + boff + n * 2048 + k * 1024); } while (0)
#define PG8_MMA(ai, bj, At, Bt) do { __builtin_amdgcn_s_setprio(1); _Pragma("unroll") for (int m = 0; m < 4; ++m) _Pragma("unroll") for (int n = 0; n < 2; ++n) _Pragma("unroll") for (int k = 0; k < 2; ++k) \
        acc[ai][bj][m][n] = __builtin_amdgcn_mfma_f32_16x16x32_bf16(Bt[n][k], At[m][k], acc[ai][bj][m][n], 0, 0, 0); __builtin_amdgcn_s_setprio(0); } while (0)
#define PG8_WAIT_V(n) asm volatile("s_waitcnt vmcnt(" #n ")" ::: "memory")
#define PG8_WAIT_L(n) asm volatile("s_waitcnt lgkmcnt(" #n ")" ::: "memory")
#define PG8_BAR __builtin_amdgcn_s_barrier()
#define PG8_SCHED __builtin_amdgcn_sched_barrier(0)
    Unit cur, nxt; int ui = 0;
    if (!S.next(0, cur)) return;
    f32x4 acc[2][2][4][2];
#pragma unroll
    for (int a = 0; a < 2; ++a)
#pragma unroll
        for (int b = 0; b < 2; ++b)
#pragma unroll
            for (int m = 0; m < 4; ++m)
#pragma unroll
                for (int n = 0; n < 2; ++n) acc[a][b][m][n] = (f32x4){0.f, 0.f, 0.f, 0.f};
    bf16x8 At[4][2], B0[2][2], B1[2][2];
    const char* cA = (const char*)g.A + (size_t)cur.pm * tstep; const char* cB = (const char*)g.Bt + (size_t)cur.pn * tstep;
    S.a_ready(cur);
    if constexpr (SP2) {
        PG8_STAGE(PG8_SB(0, 0), cB, voffB); PG8_STAGE(PG8_SB(0, 1), cB + hstep, voffB); PG8_STAGE(PG8_SA(0, 0), cA, voffA); PG8_STAGE(PG8_SA(0, 1), cA + hstep, voffA);
        if (wr == 1) PG8_BAR;
        PG8_WAIT_V(2); PG8_BAR;
        PG8_STAGE(PG8_SB(1, 0), cB + kstep, voffB); PG8_STAGE(PG8_SA(1, 0), cA + kstep, voffA); PG8_STAGE(PG8_SB(1, 1), cB + hstep + kstep, voffB);
        PG8_WAIT_V(6); PG8_BAR;
    } else {
        PG8_STAGE(PG8_SB(0, 0), cB, voffB); PG8_STAGE(PG8_SA(0, 0), cA, voffA); PG8_STAGE(PG8_SB(0, 1), cB + hstep, voffB); PG8_STAGE(PG8_SA(0, 1), cA + hstep, voffA);
        if (wr == 1) PG8_BAR;
        PG8_WAIT_V(4); PG8_BAR;
        PG8_STAGE(PG8_SB(1, 0), cB + kstep, voffB); PG8_STAGE(PG8_SA(1, 0), cA + kstep, voffA); PG8_STAGE(PG8_SB(1, 1), cB + hstep + kstep, voffB);
        PG8_WAIT_V(6); PG8_BAR;
    }
    for (;;) {
        const bool has_next = S.next(ui + 1, nxt);
        const char* nA = has_next ? (const char*)g.A + (size_t)nxt.pm * tstep : cA; const char* nB = has_next ? (const char*)g.Bt + (size_t)nxt.pn * tstep : cB;
        for (int t = 0; t < nt; t += 2) {
            const bool last = (t == nt - 2);
            const char* a1 = cA + (size_t)(t + 1) * kstep;
            const char* a2 = last ? nA : cA + (size_t)(t + 2) * kstep; const char* b2 = last ? nB : cB + (size_t)(t + 2) * kstep;
            const char* a3 = a2 + kstep; const char* b3 = b2 + kstep;
            if (last && has_next) S.a_ready(nxt);
            if constexpr (SP2) {
            PG8_LDB(B0, 0, 0); PG8_LDB(B1, 0, 1); PG8_SCHED; PG8_LDA(At, 0, 0); PG8_STAGE(PG8_SA(1, 1), a1 + hstep, voffA);
            PG8_WAIT_V(8); PG8_WAIT_L(0); PG8_BAR; PG8_MMA(0, 0, At, B0); PG8_MMA(0, 1, At, B1); PG8_BAR; PG8_SCHED;
            PG8_LDA(At, 0, 1); PG8_STAGE(PG8_SB(0, 0), b2, voffB); PG8_STAGE(PG8_SB(0, 1), b2 + hstep, voffB); PG8_STAGE(PG8_SA(0, 0), a2, voffA);
            PG8_WAIT_V(8); PG8_WAIT_L(0); PG8_BAR; PG8_MMA(1, 0, At, B0); PG8_MMA(1, 1, At, B1); PG8_BAR; PG8_SCHED;
            PG8_LDB(B0, 1, 0); PG8_LDB(B1, 1, 1); PG8_SCHED; PG8_LDA(At, 1, 0); PG8_STAGE(PG8_SA(0, 1), a2 + hstep, voffA);
            PG8_WAIT_V(8); PG8_WAIT_L(0); PG8_BAR; PG8_MMA(0, 0, At, B0); PG8_MMA(0, 1, At, B1); PG8_BAR; PG8_SCHED;
            PG8_LDA(At, 1, 1); PG8_STAGE(PG8_SB(1, 0), b3, voffB); PG8_STAGE(PG8_SB(1, 1), b3 + hstep, voffB); PG8_STAGE(PG8_SA(1, 0), a3, voffA);
            PG8_WAIT_V(8); PG8_WAIT_L(0); PG8_BAR; PG8_MMA(1, 0, At, B0); PG8_MMA(1, 1, At, B1); PG8_BAR; PG8_SCHED;
            } else {
            PG8_LDB(B0, 0, 0); PG8_SCHED; PG8_LDA(At, 0, 0); PG8_STAGE(PG8_SA(1, 1), a1 + hstep, voffA);
            PG8_WAIT_L(8); PG8_BAR; PG8_WAIT_L(0); PG8_MMA(0, 0, At, B0); PG8_BAR; PG8_SCHED;
            PG8_LDB(B1, 0, 1); PG8_STAGE(PG8_SB(0, 0), b2, voffB);
            PG8_BAR; PG8_WAIT_L(0); PG8_MMA(0, 1, At, B1); PG8_BAR;
            PG8_LDA(At, 0, 1); PG8_STAGE(PG8_SA(0, 0), a2, voffA);
            PG8_BAR; PG8_WAIT_L(0); PG8_MMA(1, 0, At, B0); PG8_BAR; PG8_SCHED;
            PG8_STAGE(PG8_SB(0, 1), b2 + hstep, voffB);
            PG8_WAIT_V(6); PG8_BAR; PG8_MMA(1, 1, At, B1); PG8_BAR;
            PG8_LDB(B0, 1, 0); PG8_SCHED; PG8_LDA(At, 1, 0); PG8_STAGE(PG8_SA(0, 1), a2 + hstep, voffA);
            PG8_WAIT_L(8); PG8_BAR; PG8_WAIT_L(0); PG8_MMA(0, 0, At, B0); PG8_BAR; PG8_SCHED;
            PG8_LDB(B1, 1, 1); PG8_STAGE(PG8_SB(1, 0), b3, voffB);
            PG8_BAR; PG8_WAIT_L(0); PG8_MMA(0, 1, At, B1); PG8_BAR;
            PG8_LDA(At, 1, 1); PG8_STAGE(PG8_SA(1, 0), a3, voffA);
            PG8_BAR; PG8_WAIT_L(0); PG8_MMA(1, 0, At, B0); PG8_BAR; PG8_SCHED;
            PG8_STAGE(PG8_SB(1, 1), b3 + hstep, voffB);
            PG8_WAIT_V(6); PG8_BAR; PG8_MMA(1, 1, At, B1); PG8_BAR;
            }
        }
        if constexpr (ALIGN_EPI) { if (wr == 0) PG8_BAR; }
        if constexpr (!Epi::AFTER_DRAIN) { E(acc, cur, wr, wc, fr, fq); S.done(cur); }
        if (!has_next) break;
#pragma unroll
        for (int a = 0; a < 2; ++a)
#pragma unroll
            for (int b = 0; b < 2; ++b)
#pragma unroll
                for (int m = 0; m < 4; ++m)
#pragma unroll
                    for (int n = 0; n < 2; ++n) acc[a][b][m][n] = (f32x4){0.f, 0.f, 0.f, 0.f};
        cur = nxt; cA = nA; cB = nB; ++ui;
        if constexpr (ALIGN_EPI) { if (wr == 1) PG8_BAR; }
    }
    PG8_WAIT_V(0);
    if constexpr (!ALIGN_EPI) { if (wr == 0) PG8_BAR; }
    PG8_BAR;
    if constexpr (Epi::AFTER_DRAIN) { E.fused(acc, cur, wr, wc, fr, fq, lds, wid, lane); S.done(cur); }
#undef PG8_SA
#undef PG8_SB
#undef PG8_STAGE
#undef PG8_LDA
#undef PG8_LDB
#undef PG8_MMA
#undef PG8_WAIT_V
#undef PG8_WAIT_L
#undef PG8_BAR
#undef PG8_SCHED
}
}
#define GAS __attribute__((address_space(1)))
#define LAS __attribute__((address_space(3)))
typedef unsigned short bf16;
typedef unsigned v4u __attribute__((ext_vector_type(4)));
typedef float f32x4 __attribute__((ext_vector_type(4)));
typedef short bf16x8 __attribute__((ext_vector_type(8)));
typedef GAS unsigned gu32;
typedef GAS unsigned long long gu64;
#define RLX_AGENT __ATOMIC_RELAXED, __HIP_MEMORY_SCOPE_AGENT
#define LDS_WAIT() asm volatile("s_waitcnt lgkmcnt(0)" ::: "memory")
#define VM_WAIT() asm volatile("s_waitcnt vmcnt(0)" ::: "memory")
__device__ __forceinline__ unsigned long long rt() { return __builtin_amdgcn_s_memrealtime(); }
__device__ __forceinline__ unsigned f2bf(float f) { unsigned u = __builtin_bit_cast(unsigned, f); return (u + 0x7fffu + ((u >> 16) & 1u)) >> 16; }
__device__ __forceinline__ unsigned pk2(float lo, float hi) { return f2bf(lo) | (f2bf(hi) << 16); }
#define XB_TMO      128
#define XB_XCNT(j)  (256  + 64 * (j))
#define XB_XSUB(j)  (1280 + 64 * (j))
#define XB_XGEN(j)  (2304 + 64 * (j))
#define XB_TOP      3328
#define XB_TOPGEN   3392
#define XCD_BAR_WORDS 3456
#define XB_SPIN_CAP (1u << 18)

__device__ __forceinline__ unsigned xb_ld(unsigned* p)              { return __hip_atomic_load(p, __ATOMIC_RELAXED, __HIP_MEMORY_SCOPE_AGENT); }
__device__ __forceinline__ unsigned xb_add(unsigned* p, unsigned v) { return __hip_atomic_fetch_add(p, v, __ATOMIC_RELAXED, __HIP_MEMORY_SCOPE_AGENT); }
__device__ __forceinline__ unsigned xb_xcc_id() { return (unsigned)__builtin_amdgcn_s_getreg((3 << 11) | 20) & 0xFu; }
#define XB_SPIN(cond, bar) do { unsigned _sp = 0; while (cond) { __builtin_amdgcn_s_sleep(1); \
    if ((++_sp & 255u) == 0u) { if (xb_ld(&(bar)[XB_TMO])) break; if (_sp > XB_SPIN_CAP) { atomicAdd(&(bar)[XB_TMO], 1u); break; } } } } while (0)

struct XcdBarrier {
    unsigned* bar; unsigned x;
    volatile LAS unsigned* st;
};

__device__ __forceinline__ XcdBarrier xcd_barrier_post(unsigned* bar, volatile LAS unsigned* st) {
    XcdBarrier b; b.bar = bar; b.x = xb_xcc_id(); b.st = st;
    if (threadIdx.x == 0) (void)xb_add(&bar[XB_XCNT(b.x)], 1u);
    return b;
}
__device__ __forceinline__ void xcd_barrier_complete(unsigned* bar, unsigned x, unsigned& nloc, unsigned& nx) {
    const unsigned G = gridDim.x * gridDim.y * gridDim.z;
    unsigned sum, cnt, mine, sp = 0u;
    for (;;) {
        sum = 0u; cnt = 0u; mine = 0u;
#pragma unroll
        for (unsigned j = 0; j < 16; ++j) { const unsigned c = xb_ld(&bar[XB_XCNT(j)]); sum += c; cnt += (c > 0u) ? 1u : 0u; mine = (j == x) ? c : mine; }
        if (sum == G) break;
        __builtin_amdgcn_s_sleep(1);
        if ((++sp & 255u) == 0u) { if (xb_ld(&bar[XB_TMO])) break; if (sp > XB_SPIN_CAP) { atomicAdd(&bar[XB_TMO], 1u); break; } }
    }
    nloc = mine > 0u ? mine : 1u; nx = cnt > 0u ? cnt : 1u;
}

__device__ __forceinline__ void xcd_barrier(const XcdBarrier& b) {
    asm volatile("s_waitcnt vmcnt(0)" ::: "memory");
    __syncthreads();
    if (threadIdx.x == 0) {
        unsigned* bar = b.bar;
        __builtin_amdgcn_s_waitcnt(0);
        unsigned nloc = b.st[0], nx = b.st[1];
        if (nloc == 0u) { xcd_barrier_complete(bar, b.x, nloc, nx); b.st[0] = nloc; b.st[1] = nx; }
        const unsigned old = xb_add(&bar[XB_XSUB(b.x)], 1u);
        const unsigned gen = old / nloc;
        if (old + 1u == (gen + 1u) * nloc) {
            __builtin_amdgcn_fence(__ATOMIC_RELEASE, "agent");
            asm volatile("s_waitcnt vmcnt(0)" ::: "memory");
            const unsigned og = xb_add(&bar[XB_TOP], 1u);
            const unsigned tg = og / nx;
            if (og + 1u == (tg + 1u) * nx) xb_add(&bar[XB_TOPGEN], 1u);
            else XB_SPIN(xb_ld(&bar[XB_TOPGEN]) == tg, bar);
            __builtin_amdgcn_fence(__ATOMIC_ACQUIRE, "agent");
            xb_add(&bar[XB_XGEN(b.x)], 1u);
            asm volatile("s_waitcnt vmcnt(0)" ::: "memory");
        } else {
            XB_SPIN(xb_ld(&bar[XB_XGEN(b.x)]) == gen, bar);
            __builtin_amdgcn_fence(__ATOMIC_ACQUIRE, "agent");
            asm volatile("s_waitcnt vmcnt(0)" ::: "memory");
        }
    }
    __syncthreads();
}

constexpr int NB = 4, SEQ = 4096, DM = 2048, LPOS = 4112, M = NB * SEQ;
constexpr int DFF = 5632, NHEAD = 16, HD = 64;
constexpr int NIN = 8192, NMAIN = 7168;
constexpr int NCH = 257;
constexpr float EPS = 1e-6f;
constexpr int NWAVES = 8;

constexpr size_t MiB = 1u << 20;
constexpr size_t WS_CTL = 0, CTL_ZERO_BYTES = 1 * MiB;
constexpr size_t WS_WIN = 1 * MiB, WS_WUP = 33 * MiB, WS_WDOWN = 77 * MiB, WS_WOUT = 99 * MiB, WS_WNA = 107 * MiB, WS_WSSM = 111 * MiB, WS_WGLU = 115 * MiB;
constexpr size_t WS_Q = 117 * MiB, WS_K = 149 * MiB, WS_VT = 181 * MiB, WS_U = 213 * MiB, WS_O = 247 * MiB;
constexpr size_t WS_MIX = 117 * MiB;
constexpr size_t WS_ACT = 117 * MiB;
constexpr size_t WS_SGNA = 293 * MiB, WS_SGSSM = 357 * MiB;
constexpr size_t WS_H2B = 293 * MiB;
constexpr size_t WS_EA = 357 * MiB, WS_EP = 369 * MiB, WS_EG = 381 * MiB;
constexpr size_t WS_XB = 421 * MiB;
constexpr size_t WS_YG = 421 * MiB, WS_SGLU = 453 * MiB;
constexpr size_t WS_SMALL = 485 * MiB, WS_END = 512 * MiB;
constexpr size_t SM_R1 = 0, SM_R1M = 192 * 1024, SM_Q15 = 196 * 1024, SM_SGNA15 = 200 * 1024, SM_SGSSM15 = 208 * 1024;
constexpr size_t SM_XBM = 256 * 1024, SM_KM = 320 * 1024, SM_VMT = 352 * 1024, SM_AYG15 = 416 * 1024, SM_AO15 = 448 * 1024, SM_AS15 = 480 * 1024;
constexpr size_t SM_AMIX15 = 512 * 1024, SM_AH2B15 = 576 * 1024, SM_A15 = 640 * 1024, SM_LAM16 = 768 * 1024;
constexpr size_t CTL_ROWSQ2 = 256 * 1024, CTL_ROWSQ3 = 320 * 1024, CTL_ROWSQM = 384 * 1024;
constexpr int CW_BAR = 4096;
constexpr size_t OUT_P = 0, OUT_TR = 8 * MiB, OUT_XIN = 32 * MiB;

constexpr int RING_BYTES = 131072 + 1024;
constexpr int MISC_OFF = RING_BYTES + 320;
constexpr int LDS_BYTES = 147456;
static_assert(MISC_OFF + 128 <= LDS_BYTES, "LDS map");

typedef float f32x2 __attribute__((ext_vector_type(2)));
typedef unsigned v2u __attribute__((ext_vector_type(2)));
struct Frame {
    LAS unsigned char* lds;
    int tid, lane, wave, vcu, G, gw, NGW;
    const float* in[23];
    float* out; unsigned char* ws;
};
#define IN_X 0
#define IN_META 1
#define IN_G1 2
#define IN_WIN 3
#define IN_RPB 4
#define IN_LAMRE 5
#define IN_LAMIM 6
#define IN_LOGSTEP 7
#define IN_BRE 8
#define IN_BIM 9
#define IN_CRE 10
#define IN_CIM 11
#define IN_SSMD 12
#define IN_WGLU 13
#define IN_WNA 14
#define IN_WSSM 15
#define IN_WOUT 16
#define IN_G2 17
#define IN_WUP 18
#define IN_CONVW 19
#define IN_CONVB 20
#define IN_WDOWN 21
#define IN_GF 22
#define WSP(T, off) ((T*)(F.ws + (off)))
#define SMP(T, off) ((T*)(F.ws + WS_SMALL + (off)))

__device__ __forceinline__ float wave_sum(float v) {
#pragma unroll
    for (int o = 1; o < 64; o <<= 1) v += __shfl_xor(v, o);
    return v;
}
typedef __bf16 bf16x2_t __attribute__((ext_vector_type(2)));
__device__ __forceinline__ unsigned cvtpk(float lo, float hi) { f32x2 v = {lo, hi}; bf16x2_t b = __builtin_convertvector(v, bf16x2_t); return __builtin_bit_cast(unsigned, b); }
__device__ __forceinline__ float bf2f(bf16 h) { return __builtin_bit_cast(float, (unsigned)h << 16); }
__device__ __forceinline__ float sigmoidf_(float x) { return __builtin_amdgcn_rcpf(1.0f + __expf(-x)); }
__device__ __forceinline__ float gelu_tanh(float x) { const float u = x * (1.0f + 0.044715f * x * x); return x * __builtin_amdgcn_rcpf(1.0f + __expf(-1.5957691216057308f * u)); }
__device__ __forceinline__ bf16x8 ldfrag(const bf16* base, int ld, int lane) { return *(const bf16x8*)(base + (size_t)(lane & 15) * ld + 8 * (lane >> 4)); }
__device__ __forceinline__ bf16x8 ldfrag_lds(const LAS bf16* base, int ld, int lane) { return *(const LAS bf16x8*)(base + (lane & 15) * ld + 8 * (lane >> 4)); }
#define MFMA16(a, b, c) __builtin_amdgcn_mfma_f32_16x16x32_bf16((a), (b), (c), 0, 0, 0)
__device__ __forceinline__ f32x4 wave_nt16(const bf16* A, int lda, const bf16* Bt, int ldb, int K, int lane, f32x4 acc) {
#pragma unroll 4
    for (int k = 0; k < K; k += 32) acc = MFMA16(ldfrag(A + k, lda, lane), ldfrag(Bt + k, ldb, lane), acc);
    return acc;
}

__device__ __forceinline__ void p0_transpose_item(const float* W, int K, int N, bf16* WT, int dest_row0, const float* kscale, LAS float* scr, int kb, int nb, int lane) {
    const int k0 = 64 * kb, n0 = 32 * nb;
#pragma unroll 8
    for (int i = 0; i < 32; ++i) { const int kk = 2 * i + (lane >> 5); float v = W[(size_t)(k0 + kk) * N + n0 + (lane & 31)]; if (kscale) v *= kscale[k0 + kk]; scr[kk * 33 + (lane & 31)] = v; }
    LDS_WAIT(); asm volatile("" ::: "memory");
    const int c = lane & 7;
#pragma unroll
    for (int j = 0; j < 4; ++j) { const int n = (lane >> 3) + 8 * j; const LAS float* s = scr + (8 * c) * 33 + n;
        v4u o; o.x = pk2(s[0 * 33], s[1 * 33]); o.y = pk2(s[2 * 33], s[3 * 33]); o.z = pk2(s[4 * 33], s[5 * 33]); o.w = pk2(s[6 * 33], s[7 * 33]);
        *(v4u*)(WT + (size_t)(dest_row0 + n) * K + k0 + 8 * c) = o; }
    LDS_WAIT(); asm volatile("" ::: "memory");
}
__device__ __forceinline__ void p0_row(const float* xrow, bf16* orow, float* rout, int lane) {
    const f32x4* xr = (const f32x4*)xrow + lane;
    f32x4 v[8]; float s = 0.f;
#pragma unroll
    for (int j = 0; j < 8; ++j) { v[j] = xr[64 * j]; s += (v[j].x * v[j].x + v[j].y * v[j].y) + (v[j].z * v[j].z + v[j].w * v[j].w); }
    s = wave_sum(s);
    if (lane == 0) *rout = 1.0f / sqrtf(s * (1.0f / DM) + EPS);
    unsigned long long* o8 = (unsigned long long*)orow + lane;
#pragma unroll
    for (int j = 0; j < 8; ++j) o8[64 * j] = (unsigned long long)pk2(v[j].x, v[j].y) | ((unsigned long long)pk2(v[j].z, v[j].w) << 32);
}
__device__ __forceinline__ void sincos_d(double x, double& s, double& c) {
    const double TWO_PI = 6.283185307179586476925286766559;
    const double k = __builtin_rint(x / TWO_PI); double r = x - k * TWO_PI; r *= 0.25;
    const double r2 = r * r;
    double sn = r * (1.0 + r2 * (-1.0 / 6 + r2 * (1.0 / 120 + r2 * (-1.0 / 5040 + r2 * (1.0 / 362880 + r2 * (-1.0 / 39916800 + r2 * (1.0 / 6227020800.0)))))));
    double cs = 1.0 + r2 * (-0.5 + r2 * (1.0 / 24 + r2 * (-1.0 / 720 + r2 * (1.0 / 40320 + r2 * (-1.0 / 3628800 + r2 * (1.0 / 479001600.0 + r2 * (-1.0 / 87178291200.0)))))));
#pragma unroll
    for (int i = 0; i < 2; ++i) { const double s2 = 2.0 * sn * cs, c2 = cs * cs - sn * sn; sn = s2; cs = c2; }
    s = sn; c = cs;
}
__device__ __forceinline__ void p0_s5_tables(Frame& F, int dir, int g) {
    LAS float* LP = (LAS float*)F.lds;
    LAS float* BB = LP + 17 * 64 * 2;
    LAS float* CC = BB + 64 * 16 * 2;
    LAS float* KK = CC + 16 * 64 * 2;
    const int t = F.tid, dg = dir * 64 + g;
    if (t < 64) {
        const int n = t;
        const float lre = F.in[IN_LAMRE][dg * 64 + n], lim = F.in[IN_LAMIM][dg * 64 + n], step = expf(F.in[IN_LOGSTEP][dg]);
        const float mag = expf(lre * step); double sd, cd; sincos_d((double)lim * (double)step, sd, cd);
        const float l1r = mag * (float)cd, l1i = mag * (float)sd;
        float pr = 1.f, pi = 0.f;
        for (int d = 0; d <= 16; ++d) { LP[(d * 64 + n) * 2] = pr; LP[(d * 64 + n) * 2 + 1] = pi; const float nr = pr * l1r - pi * l1i, ni = pr * l1i + pi * l1r; pr = nr; pi = ni; }
        const float ar = l1r - 1.f, ai = l1i, den = 1.0f / (lre * lre + lim * lim);
        const float fr_ = (ar * lre + ai * lim) * den, fi_ = (ai * lre - ar * lim) * den;
        for (int c = 0; c < 16; ++c) { const float br = F.in[IN_BRE][(dg * 64 + n) * 16 + c], bi = F.in[IN_BIM][(dg * 64 + n) * 16 + c];
            BB[(n * 16 + c) * 2] = fr_ * br - fi_ * bi; BB[(n * 16 + c) * 2 + 1] = fr_ * bi + fi_ * br; }
    }
    for (int e = t; e < 1024; e += 512) { const int c = e >> 6, n = e & 63; CC[e * 2] = F.in[IN_CRE][(dg * 16 + c) * 64 + n]; CC[e * 2 + 1] = F.in[IN_CIM][(dg * 16 + c) * 64 + n]; }
    __syncthreads();
    for (int e = t; e < 4096; e += 512) { const int d = e >> 8, c = (e >> 4) & 15, cp = e & 15; float acc = 0.f;
        for (int n = 0; n < 64; ++n) { const float cr = CC[(c * 64 + n) * 2], ci = CC[(c * 64 + n) * 2 + 1], lr = LP[(d * 64 + n) * 2], li = LP[(d * 64 + n) * 2 + 1];
            const float zr = cr * lr - ci * li, zi = cr * li + ci * lr; acc += zr * BB[(n * 16 + cp) * 2] - zi * BB[(n * 16 + cp) * 2 + 1]; }
        KK[e] = acc; }
    bf16* P = (bf16*)((unsigned char*)F.out + OUT_P) + (size_t)dg * 128 * 256;
    bf16* TR = (bf16*)((unsigned char*)F.out + OUT_TR) + (size_t)dg * 256 * 384;
    for (int e = t; e < 128 * 256; e += 512) { const int s = e >> 8, k = e & 255, part = s >> 6, n = s & 63, j = k >> 4, cp = k & 15, ex = dir ? j : 15 - j;
        const float lr = LP[(ex * 64 + n) * 2], li = LP[(ex * 64 + n) * 2 + 1], br = BB[(n * 16 + cp) * 2], bi = BB[(n * 16 + cp) * 2 + 1];
        P[e] = (bf16)f2bf(part ? (lr * bi + li * br) : (lr * br - li * bi)); }
    for (int e = t; e < 256 * 128; e += 512) { const int row = e >> 7, s = e & 127, i = row >> 4, c = row & 15, part = s >> 6, n = s & 63, ex = dir ? 16 - i : i + 1;
        const float cr = CC[(c * 64 + n) * 2], ci = CC[(c * 64 + n) * 2 + 1], lr = LP[(ex * 64 + n) * 2], li = LP[(ex * 64 + n) * 2 + 1];
        TR[(size_t)row * 384 + 256 + s] = (bf16)f2bf(part ? -(cr * li + ci * lr) : (cr * lr - ci * li)); }
    if (t < 64) { float* L16 = SMP(float, SM_LAM16) + (size_t)(dg * 64 + t) * 2; L16[0] = LP[(16 * 64 + t) * 2]; L16[1] = LP[(16 * 64 + t) * 2 + 1]; }
    __syncthreads();
    for (int e = t; e < 256 * 256; e += 512) { const int row = e >> 8, k = e & 255, i = row >> 4, c = row & 15, j = k >> 4, cp = k & 15, d = dir ? j - i : i - j;
        TR[(size_t)row * 384 + k] = (bf16)(d >= 0 ? f2bf(KK[(d * 16 + c) * 16 + cp]) : 0u); }
    __syncthreads();
}
__device__ __forceinline__ void p0_prologue(Frame& F) {
    if (F.vcu < 128) p0_s5_tables(F, F.vcu >> 6, F.vcu & 63);
    LAS float* scr = (LAS float*)(F.lds + F.wave * 16384);
    const int gw = F.gw, NGW = F.NGW;
    constexpr int I_IN = 32 * 256, I_UP = 32 * 352, I_DOWN = 88 * 64, I_OUT = 32 * 64, I_NA = 16 * 64, I_SSM = 16 * 64, I_GLU = 16 * 32;
    constexpr int NITEMS = I_IN + I_UP + I_DOWN + I_OUT + I_NA + I_SSM + I_GLU;
    for (int it = gw; it < NITEMS; it += NGW) {
        int r = it;
        if (r < I_IN) { const int nb = r % 256, kb = r / 256, n0 = nb * 32;
            int dest = n0 < 2048 ? n0 : (n0 < 3072 ? 7168 + (n0 - 2048) : (n0 < 4096 ? 2048 + (n0 - 3072) : 3072 + (n0 - 4096)));
            p0_transpose_item(F.in[IN_WIN], DM, NIN, WSP(bf16, WS_WIN), dest, F.in[IN_G1], scr, kb, nb, F.lane); continue; } r -= I_IN;
        if (r < I_UP) { const int nb = r % 352, kb = r / 352, n0 = nb * 32; const int isg = n0 >= DFF, j0 = isg ? n0 - DFF : n0;
            const int dest = 256 * (j0 >> 7) + (isg ? 128 : 0) + (j0 & 127);
            p0_transpose_item(F.in[IN_WUP], DM, 2 * DFF, WSP(bf16, WS_WUP), dest, F.in[IN_G2], scr, kb, nb, F.lane); continue; } r -= I_UP;
        if (r < I_DOWN) { p0_transpose_item(F.in[IN_WDOWN], DFF, DM, WSP(bf16, WS_WDOWN), (r % 64) * 32, nullptr, scr, r / 64, r % 64, F.lane); continue; } r -= I_DOWN;
        if (r < I_OUT) { p0_transpose_item(F.in[IN_WOUT], DM, DM, WSP(bf16, WS_WOUT), (r % 64) * 32, nullptr, scr, r / 64, r % 64, F.lane); continue; } r -= I_OUT;
        if (r < I_NA) { p0_transpose_item(F.in[IN_WNA], 1024, DM, WSP(bf16, WS_WNA), (r % 64) * 32, nullptr, scr, r / 64, r % 64, F.lane); continue; } r -= I_NA;
        if (r < I_SSM) { p0_transpose_item(F.in[IN_WSSM], 1024, DM, WSP(bf16, WS_WSSM), (r % 64) * 32, nullptr, scr, r / 64, r % 64, F.lane); continue; } r -= I_SSM;
        p0_transpose_item(F.in[IN_WGLU], 1024, 1024, WSP(bf16, WS_WGLU), (r % 32) * 32, nullptr, scr, r / 32, r % 32, F.lane);
    }
    for (int m = gw; m < M; m += NGW) p0_row(F.in[IN_X] + (size_t)m * DM, WSP(bf16, WS_XB) + (size_t)m * DM, SMP(float, SM_R1) + m, F.lane);
    if (gw < 16) p0_row(F.in[IN_META] + (size_t)gw * DM, SMP(bf16, SM_XBM) + (size_t)gw * DM, SMP(float, SM_R1M) + gw, F.lane);
}

typedef float f32x4 __attribute__((ext_vector_type(4)));
__device__ __forceinline__ v4u pack8(f32x4 v0, f32x4 v1) { v4u w; w.x = cvtpk(v0[0], v0[1]); w.y = cvtpk(v0[2], v0[3]); w.z = cvtpk(v1[0], v1[1]); w.w = cvtpk(v1[2], v1[3]); return w; }
__device__ __forceinline__ void unpack8(v4u w, f32x4& v0, f32x4& v1) {
    v0[0] = __builtin_bit_cast(float, w.x << 16); v0[1] = __builtin_bit_cast(float, w.x & 0xffff0000u); v0[2] = __builtin_bit_cast(float, w.y << 16); v0[3] = __builtin_bit_cast(float, w.y & 0xffff0000u);
    v1[0] = __builtin_bit_cast(float, w.z << 16); v1[1] = __builtin_bit_cast(float, w.z & 0xffff0000u); v1[2] = __builtin_bit_cast(float, w.w << 16); v1[3] = __builtin_bit_cast(float, w.w & 0xffff0000u); }
__device__ __forceinline__ f32x4 sig4(f32x4 v) { f32x4 o; o[0] = sigmoidf_(v[0]); o[1] = sigmoidf_(v[1]); o[2] = sigmoidf_(v[2]); o[3] = sigmoidf_(v[3]); return o; }

struct EpiG1 {
    static constexpr bool PERM = true, AFTER_DRAIN = false;
    const float* r1; bf16 *Q, *K, *U, *SGNA, *SGSSM;
    __device__ __forceinline__ void operator()(const f32x4 (&acc)[2][2][4][2], const pg8::Unit& u, int wr, int wc, int fr, int fq) const {
        const int seg = u.pn < 4 ? 0 : (u.pn < 8 ? 1 : (u.pn < 12 ? 2 : (u.pn < 20 ? 3 : 4)));
#pragma unroll
        for (int ai = 0; ai < 2; ++ai)
#pragma unroll
            for (int m = 0; m < 4; ++m) { const int row = u.pm * 256 + ai * 128 + wr * 64 + m * 16 + fr; const float rs = r1[row];
#pragma unroll
                for (int bj = 0; bj < 2; ++bj) { const int c0 = u.pn * 256 + bj * 128 + wc * 32 + 8 * fq; f32x4 v0 = acc[ai][bj][m][0] * rs, v1 = acc[ai][bj][m][1] * rs;
                    if (seg == 0) { v0 = v0 * 0.125f; v1 = v1 * 0.125f; *(v4u*)(Q + (size_t)row * 1024 + c0) = pack8(v0, v1); }
                    else if (seg == 1) { *(v4u*)(K + (size_t)row * 1024 + (c0 - 1024)) = pack8(v0, v1); }
                    else if (seg == 2) { const int cu = c0 - 2048, g = cu >> 4, b = row >> 12, t = row & 4095; *(v4u*)(U + ((size_t)(b * 64 + g) * LPOS + 16 + t) * 16 + (cu & 15)) = pack8(v0, v1); }
                    else if (seg == 3) { *(v4u*)(SGNA + (size_t)row * 2048 + (c0 - 3072)) = pack8(sig4(v0), sig4(v1)); }
                    else { *(v4u*)(SGSSM + (size_t)row * 2048 + (c0 - 5120)) = pack8(sig4(v0), sig4(v1)); } } }
    }
};
struct EpiVt {
    static constexpr bool PERM = true, AFTER_DRAIN = false;
    const float* r1; bf16* VT;
    __device__ __forceinline__ void operator()(const f32x4 (&acc)[2][2][4][2], const pg8::Unit& u, int wr, int wc, int fr, int fq) const {
#pragma unroll
        for (int bj = 0; bj < 2; ++bj) { const int c0 = u.pn * 256 + bj * 128 + wc * 32 + 8 * fq; const f32x4 s0 = *(const f32x4*)(r1 + c0), s1 = *(const f32x4*)(r1 + c0 + 4);
#pragma unroll
            for (int ai = 0; ai < 2; ++ai)
#pragma unroll
                for (int m = 0; m < 4; ++m) { const int row = u.pm * 256 + ai * 128 + wr * 64 + m * 16 + fr; *(v4u*)(VT + (size_t)row * M + c0) = pack8(acc[ai][bj][m][0] * s0, acc[ai][bj][m][1] * s1); } }
    }
};
struct EpiGlu {
    static constexpr bool PERM = true, AFTER_DRAIN = false;
    const bf16* YG; bf16* S;
    __device__ __forceinline__ void operator()(const f32x4 (&acc)[2][2][4][2], const pg8::Unit& u, int wr, int wc, int fr, int fq) const {
#pragma unroll
        for (int ai = 0; ai < 2; ++ai)
#pragma unroll
            for (int m = 0; m < 4; ++m) { const int row = u.pm * 256 + ai * 128 + wr * 64 + m * 16 + fr;
#pragma unroll
                for (int bj = 0; bj < 2; ++bj) { const int c0 = u.pn * 256 + bj * 128 + wc * 32 + 8 * fq; f32x4 y0, y1; unpack8(*(const v4u*)(YG + (size_t)row * 1024 + c0), y0, y1);
                    *(v4u*)(S + (size_t)row * 1024 + c0) = pack8(y0 * sig4(acc[ai][bj][m][0]), y1 * sig4(acc[ai][bj][m][1])); } }
    }
};
template <bool ADD> struct EpiMix {
    static constexpr bool PERM = true, AFTER_DRAIN = false;
    const bf16* GATE; bf16* MIX;
    __device__ __forceinline__ void operator()(const f32x4 (&acc)[2][2][4][2], const pg8::Unit& u, int wr, int wc, int fr, int fq) const {
#pragma unroll
        for (int ai = 0; ai < 2; ++ai)
#pragma unroll
            for (int m = 0; m < 4; ++m) { const int row = u.pm * 256 + ai * 128 + wr * 64 + m * 16 + fr;
#pragma unroll
                for (int bj = 0; bj < 2; ++bj) { const int c0 = u.pn * 256 + bj * 128 + wc * 32 + 8 * fq; f32x4 g0, g1; unpack8(*(const v4u*)(GATE + (size_t)row * 2048 + c0), g0, g1);
                    f32x4 v0 = g0 * acc[ai][bj][m][0], v1 = g1 * acc[ai][bj][m][1];
                    if (ADD) { f32x4 p0, p1; unpack8(*(const v4u*)(MIX + (size_t)row * 2048 + c0), p0, p1); v0 = v0 + p0; v1 = v1 + p1; }
                    *(v4u*)(MIX + (size_t)row * 2048 + c0) = pack8(v0, v1); } }
    }
};
struct EpiRes {
    static constexpr bool PERM = true, AFTER_DRAIN = false;
    const float* base; float* out; bf16* outb; float* rowsq;
    __device__ __forceinline__ void operator()(const f32x4 (&acc)[2][2][4][2], const pg8::Unit& u, int wr, int wc, int fr, int fq) const {
#pragma unroll
        for (int ai = 0; ai < 2; ++ai)
#pragma unroll
            for (int m = 0; m < 4; ++m) { const int row = u.pm * 256 + ai * 128 + wr * 64 + m * 16 + fr; float ss = 0.f;
#pragma unroll
                for (int bj = 0; bj < 2; ++bj) { const size_t off = (size_t)row * 2048 + u.pn * 256 + bj * 128 + wc * 32 + 8 * fq;
                    const f32x4 v0 = *(const f32x4*)(base + off) + acc[ai][bj][m][0], v1 = *(const f32x4*)(base + off + 4) + acc[ai][bj][m][1];
                    *(f32x4*)(out + off) = v0; *(f32x4*)(out + off + 4) = v1; if (outb) *(v4u*)(outb + off) = pack8(v0, v1);
                    ss += (v0[0] * v0[0] + v0[1] * v0[1]) + (v0[2] * v0[2] + v0[3] * v0[3]) + (v1[0] * v1[0] + v1[1] * v1[1]) + (v1[2] * v1[2] + v1[3] * v1[3]); }
                ss += __shfl_xor(ss, 16); ss += __shfl_xor(ss, 32);
                if (fq == 0) atomicAdd(rowsq + row, ss); }
    }
};
struct EpiUp {
    static constexpr bool PERM = true, AFTER_DRAIN = false;
    const float* rowsq; const float* convw; const float* convb; bf16* ACT; float *EA, *EP, *EG;
    __device__ __forceinline__ void operator()(const f32x4 (&acc)[2][2][4][2], const pg8::Unit& u, int wr, int wc, int fr, int fq) const {
        const int lane = fq * 16 + fr, ja0 = u.pn * 128 + wc * 32 + 8 * fq;
        const int up_src = (lane & 48) | ((fr + 15) & 15), dn_src = (lane & 48) | ((fr + 1) & 15);
#pragma unroll
        for (int ai = 0; ai < 2; ++ai) {
            float r2[4];
#pragma unroll
            for (int m = 0; m < 4; ++m) r2[m] = 1.0f / sqrtf(rowsq[u.pm * 256 + ai * 128 + wr * 64 + m * 16 + fr] * (1.0f / DM) + EPS);
#pragma unroll
            for (int n = 0; n < 2; ++n) {
                const int ja = ja0 + 4 * n;
                const f32x4 w0 = *(const f32x4*)(convw + ja), w1 = *(const f32x4*)(convw + DFF + ja), w2 = *(const f32x4*)(convw + 2 * DFF + ja), cb = *(const f32x4*)(convb + ja);
                f32x4 av[4], gv[4], cv[4];
#pragma unroll
                for (int m = 0; m < 4; ++m) { av[m] = acc[ai][0][m][n] * r2[m]; gv[m] = acc[ai][1][m][n] * r2[m]; }
#pragma unroll
                for (int m = 0; m < 4; ++m) {
#pragma unroll
                    for (int i = 0; i < 4; ++i) {
                        const float su = (m > 0 && fr == 15) ? av[m - 1][i] : av[m][i]; float upv = __shfl(su, up_src);
                        const float sd = (m < 3 && fr == 0) ? av[m + 1][i] : av[m][i]; float dnv = __shfl(sd, dn_src);
                        if (m == 0 && fr == 0) upv = 0.f;
                        if (m == 3 && fr == 15) dnv = 0.f;
                        cv[m][i] = w0[i] * upv + w1[i] * av[m][i] + w2[i] * dnv + cb[i];
                    }
                }
#pragma unroll
                for (int m = 0; m < 4; ++m) { const int row = u.pm * 256 + ai * 128 + wr * 64 + m * 16 + fr;
                    const bool top = (m == 0 && fr == 0), bot = (m == 3 && fr == 15);
                    if (top || bot) { const size_t eo = (size_t)((row >> 6) * 2 + (bot ? 1 : 0)) * DFF + ja; *(f32x4*)(EA + eo) = av[m]; *(f32x4*)(EP + eo) = cv[m]; *(f32x4*)(EG + eo) = gv[m]; }
                    else { v2u w; w.x = cvtpk(gelu_tanh(cv[m][0]) * gv[m][0], gelu_tanh(cv[m][1]) * gv[m][1]); w.y = cvtpk(gelu_tanh(cv[m][2]) * gv[m][2], gelu_tanh(cv[m][3]) * gv[m][3]);
                        *(v2u*)(ACT + (size_t)row * DFF + ja) = w; } }
            }
        }
    }
};

__device__ __forceinline__ void p1_meta(Frame& F) {
    const int lane = F.lane, lr = lane & 15, lg = lane >> 4;
    for (int cb = F.gw; cb < 512; cb += F.NGW) {
        f32x4 acc = {0.f, 0.f, 0.f, 0.f};
        acc = wave_nt16(SMP(bf16, SM_XBM), DM, WSP(bf16, WS_WIN) + (size_t)(16 * cb) * DM, DM, DM, lane, acc);
        const float* r1m = SMP(float, SM_R1M);
        const int col = 16 * cb + lr;
#pragma unroll
        for (int r = 0; r < 4; ++r) { const int j = 4 * lg + r; const float v = acc[r] * r1m[j];
            if (col < 1024) { if (j == 15) SMP(float, SM_Q15)[col] = v * 0.125f; }
            else if (col < 2048) SMP(bf16, SM_KM)[j * 1024 + (col - 1024)] = (bf16)f2bf(v);
            else if (col < 3072) { const int cu = col - 2048, g = cu >> 4; const bf16 h = (bf16)f2bf(v);
#pragma unroll
                for (int b = 0; b < NB; ++b) WSP(bf16, WS_U)[((size_t)(b * 64 + g) * LPOS + j) * 16 + (cu & 15)] = h; }
            else if (col < 5120) { if (j == 15) SMP(float, SM_SGNA15)[col - 3072] = sigmoidf_(v); }
            else if (col < 7168) { if (j == 15) SMP(float, SM_SGSSM15)[col - 5120] = sigmoidf_(v); }
            else { bf16* vm = SMP(bf16, SM_VMT) + (size_t)(col - 7168) * 32; vm[j] = (bf16)f2bf(v); vm[16 + j] = 0; } }
    }
}
__device__ __forceinline__ void p2_meta_attn(Frame& F, int h) {
    const int lane = F.lane, j = lane & 15;
    const float* q15 = SMP(float, SM_Q15) + h * 64; const bf16* km = SMP(bf16, SM_KM) + j * 1024 + h * 64;
    float s = 0.f;
    for (int d = 0; d < 64; ++d) s += q15[d] * bf2f(km[d]);
    float mx = s;
#pragma unroll
    for (int o = 1; o < 16; o <<= 1) mx = fmaxf(mx, __shfl_xor(mx, o));
    float p = __expf(s - mx), sum = p;
#pragma unroll
    for (int o = 1; o < 16; o <<= 1) sum += __shfl_xor(sum, o);
    p = p / sum;
    const bf16* vm = SMP(bf16, SM_VMT) + (size_t)(h * 64 + lane) * 32; float o = 0.f;
    for (int k = 0; k < 16; ++k) o += __shfl(p, k) * bf2f(vm[k]);
    const bf16 ob = (bf16)f2bf(o);
#pragma unroll
    for (int b = 0; b < NB; ++b) SMP(bf16, SM_AO15)[b * 1024 + h * 64 + lane] = ob;
}
__device__ __forceinline__ void p3a_meta(Frame& F) {
    const int lane = F.lane, lr = lane & 15, lg = lane >> 4;
    for (int cb = F.gw; cb < 64; cb += F.NGW) {
        f32x4 acc = {0.f, 0.f, 0.f, 0.f};
        acc = wave_nt16(SMP(bf16, SM_AYG15), 1024, WSP(bf16, WS_WGLU) + (size_t)(16 * cb) * 1024, 1024, 1024, lane, acc);
#pragma unroll
        for (int r = 0; r < 4; ++r) { const int i = 4 * lg + r, col = 16 * cb + lr; const float y = bf2f(SMP(bf16, SM_AYG15)[i * 1024 + col]); SMP(bf16, SM_AS15)[i * 1024 + col] = (bf16)f2bf(y * sigmoidf_(acc[r])); }
    }
}
__device__ __forceinline__ void p3b_meta(Frame& F) {
    const int lane = F.lane, lr = lane & 15, lg = lane >> 4;
    for (int cb = F.gw; cb < 128; cb += F.NGW) {
        f32x4 a1 = {0.f, 0.f, 0.f, 0.f}, a2 = {0.f, 0.f, 0.f, 0.f};
        a1 = wave_nt16(SMP(bf16, SM_AO15), 1024, WSP(bf16, WS_WNA) + (size_t)(16 * cb) * 1024, 1024, 1024, lane, a1);
        a2 = wave_nt16(SMP(bf16, SM_AS15), 1024, WSP(bf16, WS_WSSM) + (size_t)(16 * cb) * 1024, 1024, 1024, lane, a2);
        const int col = 16 * cb + lr; const float gn = SMP(float, SM_SGNA15)[col], gs = SMP(float, SM_SGSSM15)[col];
#pragma unroll
        for (int r = 0; r < 4; ++r) { const int i = 4 * lg + r; SMP(bf16, SM_AMIX15)[i * 2048 + col] = (bf16)f2bf(gn * a1[r] + gs * a2[r]); }
    }
}
__device__ __forceinline__ void p3c_meta(Frame& F) {
    const int lane = F.lane, lr = lane & 15, lg = lane >> 4;
    for (int cb = F.gw; cb < 128; cb += F.NGW) {
        f32x4 acc = {0.f, 0.f, 0.f, 0.f};
        acc = wave_nt16(SMP(bf16, SM_AMIX15), 2048, WSP(bf16, WS_WOUT) + (size_t)(16 * cb) * 2048, 2048, 2048, lane, acc);
        const int col = 16 * cb + lr; const float mt = F.in[IN_META][15 * DM + col];
#pragma unroll
        for (int r = 0; r < 4; ++r) { const int i = 4 * lg + r; const float v = mt + acc[r]; SMP(bf16, SM_AH2B15)[i * 2048 + col] = (bf16)f2bf(v);
            float ss = v * v;
#pragma unroll
            for (int o = 1; o < 16; o <<= 1) ss += __shfl_xor(ss, o);
            if (lr == 0 && i < NB) atomicAdd((float*)(F.ws + WS_CTL + CTL_ROWSQM) + i, ss); }
    }
}
__device__ __forceinline__ void p4_meta(Frame& F) {
    const int lane = F.lane, lr = lane & 15, lg = lane >> 4;
    for (int cb = F.gw; cb < DFF / 16; cb += F.NGW) {
        const int j0 = 16 * cb, wrow = 256 * (j0 >> 7) + (j0 & 127);
        f32x4 acc = {0.f, 0.f, 0.f, 0.f};
        acc = wave_nt16(SMP(bf16, SM_AH2B15), 2048, WSP(bf16, WS_WUP) + (size_t)wrow * 2048, 2048, 2048, lane, acc);
        if (lg == 0) {
#pragma unroll
            for (int r = 0; r < 4; ++r) { const float r2 = 1.0f / sqrtf(((const float*)(F.ws + WS_CTL + CTL_ROWSQM))[r] * (1.0f / DM) + EPS); SMP(float, SM_A15)[r * DFF + j0 + lr] = acc[r] * r2; } }
    }
}

__device__ __forceinline__ void na_task(Frame& F, int task, LAS bf16* P  ) {
    const int qb = task & 3, r = (task >> 2) & 63, h = (task >> 8) & 15, b = task >> 12;
    const int lane = F.lane, lr = lane & 15, lg = lane >> 4;
    const int w0 = (qb == 0) ? 0 : (qb == 1) ? 8 : (qb == 2) ? 24 : 32;
    const int rs = min(max(r - 4, 0), 56);
    const int cq = 16 * qb + lr, cs = min(max(cq - 8, 0), 48);
    const bf16* Qp = WSP(bf16, WS_Q) + ((size_t)(b * SEQ + r * 64 + 16 * qb) * 1024 + h * 64);
    const bf16x8 qf0 = ldfrag(Qp, 1024, lane), qf1 = ldfrag(Qp + 32, 1024, lane);
    const float* rpb = F.in[IN_RPB] + h * 15 * 31;
    f32x4 s[17];
#pragma unroll
    for (int t = 0; t < 16; ++t) { const int kr = rs + (t >> 1), hf = t & 1;
        const bf16* Kp = WSP(bf16, WS_K) + ((size_t)(b * SEQ + kr * 64 + w0 + 16 * hf) * 1024 + h * 64);
        f32x4 a = {0.f, 0.f, 0.f, 0.f};
        a = MFMA16(ldfrag(Kp, 1024, lane), qf0, a); a = MFMA16(ldfrag(Kp + 32, 1024, lane), qf1, a);
#pragma unroll
        for (int i = 0; i < 4; ++i) { const int kc = w0 + 16 * hf + 4 * lg + i; const bool valid = (kc >= cs) && (kc < cs + 16);
            const float bias = valid ? rpb[(kr - r + 7) * 31 + (kc - cq + 15)] : 0.f;
            s[t][i] = valid ? a[i] + bias : -INFINITY; } }
    { f32x4 a = {0.f, 0.f, 0.f, 0.f}; const bf16* Kp = SMP(bf16, SM_KM) + h * 64;
      a = MFMA16(ldfrag(Kp, 1024, lane), qf0, a); a = MFMA16(ldfrag(Kp + 32, 1024, lane), qf1, a); s[16] = a; }
#ifdef DBG_NA_B
    { bf16* Op = WSP(bf16, WS_O) + ((size_t)(b * SEQ + r * 64 + 16 * qb + lr) * 1024 + h * 64);
#pragma unroll
      for (int db = 0; db < 4; ++db) { f32x4 o = s[db * 4 + 1] + s[db * 4 + 2] + s[16];
#pragma unroll
        for (int i = 0; i < 4; ++i) { float v = s[db * 4][i]; o[i] += (v == -INFINITY) ? 0.f : v; v = s[db * 4 + 3][i]; o[i] += (v == -INFINITY) ? 1.f : v; if (!(o[i] > -1e30f)) o[i] = -7.f; }
        v2u w; w.x = cvtpk(o[0], o[1]); w.y = cvtpk(o[2], o[3]); *(v2u*)(Op + 16 * db + 4 * lg) = w; }
      return; }
#endif
    float mx = -INFINITY;
#pragma unroll
    for (int t = 0; t < 17; ++t) mx = fmaxf(mx, fmaxf(fmaxf(s[t][0], s[t][1]), fmaxf(s[t][2], s[t][3])));
    mx = fmaxf(mx, __shfl_xor(mx, 16)); mx = fmaxf(mx, __shfl_xor(mx, 32));
    float sum = 0.f;
#pragma unroll
    for (int t = 0; t < 17; ++t) {
#pragma unroll
        for (int i = 0; i < 4; ++i) { const float p = __expf(s[t][i] - mx); s[t][i] = p; sum += p; } }
    sum += __shfl_xor(sum, 16); sum += __shfl_xor(sum, 32);
    const float inv = 1.0f / sum;
#pragma unroll
    for (int t = 0; t < 17; ++t) { v2u w; w.x = cvtpk(s[t][0] * inv, s[t][1] * inv); w.y = cvtpk(s[t][2] * inv, s[t][3] * inv);
        *(LAS v2u*)(P + lr * 288 + t * 16 + 4 * lg) = w; }
    { v2u z; z.x = 0u; z.y = 0u; *(LAS v2u*)(P + lr * 288 + 272 + 4 * lg) = z; }
    LDS_WAIT(); asm volatile("" ::: "memory");
    bf16* Op = WSP(bf16, WS_O) + ((size_t)(b * SEQ + r * 64 + 16 * qb + lr) * 1024 + h * 64);
#pragma unroll
    for (int db = 0; db < 4; ++db) {
        f32x4 o = {0.f, 0.f, 0.f, 0.f};
        const bf16* Vp = WSP(bf16, WS_VT) + (size_t)(h * 64 + 16 * db) * M + (b * SEQ + rs * 64 + w0);
#pragma unroll
        for (int s8 = 0; s8 < 8; ++s8) o = MFMA16(ldfrag(Vp + s8 * 64, M, lane), ldfrag_lds(P + 32 * s8, 288, lane), o);
        o = MFMA16(ldfrag(SMP(bf16, SM_VMT) + (size_t)(h * 64 + 16 * db) * 32, 32, lane), ldfrag_lds(P + 256, 288, lane), o);
        v2u w; w.x = cvtpk(o[0], o[1]); w.y = cvtpk(o[2], o[3]);
        *(v2u*)(Op + 16 * db + 4 * lg) = w;
    }
    LDS_WAIT(); asm volatile("" ::: "memory");
}

__device__ __forceinline__ void s5_block(Frame& F, int b, int g) {
    LAS float* S = (LAS float*)F.lds;
    const int lane = F.lane, lr = lane & 15, lg = lane >> 4, wv = F.wave;
    const bf16* Ug = WSP(bf16, WS_U) + (size_t)(b * 64 + g) * LPOS * 16;
    bf16* XinAll = (bf16*)((unsigned char*)F.out + OUT_XIN) + (size_t)(b * 64 + g) * 2 * NCH * 128;
    for (int dir = 0; dir < 2; ++dir) {
        const int dg = dir * 64 + g;
        const bf16* P = (const bf16*)((const unsigned char*)F.out + OUT_P) + (size_t)dg * 128 * 256;
        for (int task = wv; task < 17 * 8; task += NWAVES) { const int rb = task >> 3, cb = task & 7;
            f32x4 acc = {0.f, 0.f, 0.f, 0.f};
            acc = wave_nt16(Ug + (size_t)(16 * rb) * 256, 256, P + (size_t)(16 * cb) * 256, 256, 256, lane, acc);
#pragma unroll
            for (int r = 0; r < 4; ++r) { const int ch = 16 * rb + 4 * lg + r; if (ch < NCH) S[ch * 128 + 16 * cb + lr] = acc[r]; } }
        __syncthreads();
        if (wv == 0) {
            const float* L16 = SMP(float, SM_LAM16) + (size_t)(dg * 64 + lane) * 2; const float lr16 = L16[0], li16 = L16[1];
            bf16* Xin = XinAll + (size_t)dir * NCH * 128;
            float xr = 0.f, xi = 0.f;
            for (int cc = 0; cc < NCH; ++cc) { const int c = dir ? (NCH - 1 - cc) : cc;
                Xin[c * 128 + lane] = (bf16)f2bf(xr); Xin[c * 128 + 64 + lane] = (bf16)f2bf(xi);
                const float sr = S[c * 128 + lane], si = S[c * 128 + 64 + lane];
                const float nr = lr16 * xr - li16 * xi + sr, ni = lr16 * xi + li16 * xr + si; xr = nr; xi = ni; }
        }
        __syncthreads();
    }
    __threadfence(); __syncthreads();
    const float* Dsk = F.in[IN_SSMD] + g * 16;
    for (int task = wv; task < 17 * 16; task += NWAVES) { const int rb = task >> 4, cb = task & 15;
        f32x4 acc = {0.f, 0.f, 0.f, 0.f};
#pragma unroll
        for (int dir = 0; dir < 2; ++dir) { const int dg = dir * 64 + g;
            const bf16* TR = (const bf16*)((const unsigned char*)F.out + OUT_TR) + (size_t)dg * 256 * 384 + (size_t)(16 * cb) * 384;
            acc = wave_nt16(Ug + (size_t)(16 * rb) * 256, 256, TR, 384, 256, lane, acc);
            acc = wave_nt16(XinAll + (size_t)dir * NCH * 128 + (size_t)(16 * rb) * 128, 128, TR + 256, 384, 128, lane, acc); }
        const float dsk = Dsk[lr];
#pragma unroll
        for (int r = 0; r < 4; ++r) { const int ch = 16 * rb + 4 * lg + r; if (ch < NCH) { const int pos = ch * 16 + cb;
            const float y = acc[r] + dsk * bf2f(Ug[(size_t)pos * 16 + lr]); const bf16 yb = (bf16)f2bf(gelu_tanh(y));
            if (pos >= 16) WSP(bf16, WS_YG)[(size_t)(b * SEQ + pos - 16) * 1024 + g * 16 + lr] = yb;
            else if (pos == 15) SMP(bf16, SM_AYG15)[b * 1024 + g * 16 + lr] = yb; } }
    }
    __syncthreads();
}

__device__ __forceinline__ void p5_fixup(Frame& F) {
    const float* EA = WSP(float, WS_EA); const float* EP = WSP(float, WS_EP); const float* EG = WSP(float, WS_EG);
    const float* cw = F.in[IN_CONVW]; bf16* ACT = WSP(bf16, WS_ACT);
    for (size_t e = (size_t)F.vcu * 512 + F.tid; e < (size_t)512 * DFF; e += (size_t)F.G * 512) {
        const int er = (int)(e / DFF), j = (int)(e % DFF), eblk = er >> 1, side = er & 1, row = eblk * 64 + (side ? 63 : 0);
        float nb, w;
        if (!side) { w = cw[j]; nb = ((row & 4095) == 0) ? SMP(float, SM_A15)[(row >> 12) * DFF + j] : EA[(size_t)((eblk - 1) * 2 + 1) * DFF + j]; }
        else { w = cw[2 * DFF + j]; nb = ((row & 4095) == 4095) ? 0.f : EA[(size_t)((eblk + 1) * 2) * DFF + j]; }
        const float v = EP[e] + w * nb;
        ACT[(size_t)row * DFF + j] = (bf16)f2bf(gelu_tanh(v) * EG[e]);
    }
}
__device__ __forceinline__ void p7_final(Frame& F) {
    const float* rowsq = (const float*)(F.ws + WS_CTL + CTL_ROWSQ3); const f32x4* gf = (const f32x4*)F.in[IN_GF] + F.lane;
    for (int m = F.gw; m < M; m += F.NGW) {
        const float rs = 1.0f / sqrtf(rowsq[m] * (1.0f / DM) + EPS);
        f32x4* xr = (f32x4*)(F.out + (size_t)m * DM) + F.lane;
#pragma unroll
        for (int j = 0; j < 8; ++j) xr[64 * j] = xr[64 * j] * rs * gf[64 * j];
    }
}

#ifndef MK_N_LAUNCHES
#define MK_N_LAUNCHES 1
#endif
constexpr int N_PHASES = 10;
struct Args { const float* in[23]; float* out; unsigned char* ws; int ph_lo, ph_hi, li, pad; };
__global__ void __launch_bounds__(NWAVES * 64, 2) skel_fwd(Args args) {
    extern __shared__ __attribute__((aligned(16))) unsigned char lds_raw[];
    Frame F;
    F.lds = (LAS unsigned char*)lds_raw;
    F.tid = threadIdx.x; F.lane = F.tid & 63; F.wave = __builtin_amdgcn_readfirstlane(F.tid >> 6);
    F.G = gridDim.x; { const int bx = blockIdx.x; F.vcu = (F.G % 8 == 0) ? (bx % 8) * (F.G / 8) + bx / 8 : bx; }
    F.gw = F.vcu * NWAVES + F.wave; F.NGW = F.G * NWAVES;
#pragma unroll
    for (int i = 0; i < 23; ++i) F.in[i] = args.in[i];
    F.out = args.out; F.ws = args.ws;
    volatile LAS unsigned* MISC = (volatile LAS unsigned*)(F.lds + MISC_OFF);
    for (int u = F.tid; u < (LDS_BYTES - RING_BYTES) / 4; u += NWAVES * 64) ((LAS unsigned*)(F.lds + RING_BYTES))[u] = 0u;
    __syncthreads();
    XcdBarrier bar; bar.bar = (unsigned*)(F.ws + WS_CTL) + CW_BAR; bar.x = 0; bar.st = nullptr;
    if (MK_N_LAUNCHES == 1) bar = xcd_barrier_post((unsigned*)(F.ws + WS_CTL) + CW_BAR, MISC + 8);
    const int lo = args.ph_lo, hi = args.ph_hi;
#define IN(k) (lo <= (k) && (k) < hi)
#define SEAM(k) do { if (IN(k) && IN((k) + 1)) xcd_barrier(bar); } while (0)
    const int bid = (int)blockIdx.x;

    if (IN(0)) { p0_prologue(F); } SEAM(0);

    if (IN(1)) {
        p1_meta(F); VM_WAIT(); __syncthreads();
        { pg8::Gemm g{WSP(bf16, WS_XB), WSP(bf16, WS_WIN), M, NMAIN, DM}; pg8::StaticOrder S; S.init(M, NMAIN, F.G, bid);
          EpiG1 E{SMP(float, SM_R1), WSP(bf16, WS_Q), WSP(bf16, WS_K), WSP(bf16, WS_U), WSP(bf16, WS_SGNA), WSP(bf16, WS_SGSSM)};
          pg8::gemm_phase<EpiG1, pg8::StaticOrder, true, true>(F.lds, g, S, E); }
        { pg8::Gemm g{WSP(bf16, WS_WIN) + (size_t)NMAIN * DM, WSP(bf16, WS_XB), 1024, M, DM}; pg8::StaticOrder S; S.init(1024, M, F.G, bid);
          EpiVt E{SMP(float, SM_R1), WSP(bf16, WS_VT)};
          pg8::gemm_phase<EpiVt, pg8::StaticOrder, true, true>(F.lds, g, S, E); }
    } SEAM(1);

    if (IN(2)) {
#ifndef DBG_SKIP_S5
        for (int bg = F.vcu; bg < NB * 64; bg += F.G) s5_block(F, bg >> 6, bg & 63);
        if (F.gw < NHEAD) p2_meta_attn(F, F.gw);
#endif
        LAS bf16* P = (LAS bf16*)(F.lds + F.wave * 9216);
        for (int task = F.gw; task < NB * NHEAD * 64 * 4; task += F.NGW) na_task(F, task, P);
        __syncthreads();
    } SEAM(2);

    if (IN(3)) {
        p3a_meta(F); VM_WAIT(); __syncthreads();
        pg8::Gemm g{WSP(bf16, WS_YG), WSP(bf16, WS_WGLU), M, 1024, 1024}; pg8::StaticOrder S; S.init(M, 1024, F.G, bid);
        EpiGlu E{WSP(bf16, WS_YG), WSP(bf16, WS_SGLU)};
        pg8::gemm_phase<EpiGlu, pg8::StaticOrder, true, true>(F.lds, g, S, E);
    } SEAM(3);

    if (IN(4)) {
        p3b_meta(F); VM_WAIT(); __syncthreads();
        { pg8::Gemm g{WSP(bf16, WS_O), WSP(bf16, WS_WNA), M, DM, 1024}; pg8::StaticOrder S; S.init(M, DM, F.G, bid);
          EpiMix<false> E{WSP(bf16, WS_SGNA), WSP(bf16, WS_MIX)};
          pg8::gemm_phase<EpiMix<false>, pg8::StaticOrder, true, true>(F.lds, g, S, E); }
        { pg8::Gemm g{WSP(bf16, WS_SGLU), WSP(bf16, WS_WSSM), M, DM, 1024}; pg8::StaticOrder S; S.init(M, DM, F.G, bid);
          EpiMix<true> E{WSP(bf16, WS_SGSSM), WSP(bf16, WS_MIX)};
          pg8::gemm_phase<EpiMix<true>, pg8::StaticOrder, true, true>(F.lds, g, S, E); }
    } SEAM(4);

    if (IN(5)) {
        p3c_meta(F); VM_WAIT(); __syncthreads();
        pg8::Gemm g{WSP(bf16, WS_MIX), WSP(bf16, WS_WOUT), M, DM, DM}; pg8::StaticOrder S; S.init(M, DM, F.G, bid);
        EpiRes E{F.in[IN_X], F.out, WSP(bf16, WS_H2B), (float*)(F.ws + WS_CTL + CTL_ROWSQ2)};
        pg8::gemm_phase<EpiRes, pg8::StaticOrder, true, true>(F.lds, g, S, E);
    } SEAM(5);

    if (IN(6)) {
        p4_meta(F); VM_WAIT(); __syncthreads();
        pg8::Gemm g{WSP(bf16, WS_H2B), WSP(bf16, WS_WUP), M, 2 * DFF, DM}; pg8::StaticOrder S; S.init(M, 2 * DFF, F.G, bid);
        EpiUp E{(const float*)(F.ws + WS_CTL + CTL_ROWSQ2), F.in[IN_CONVW], F.in[IN_CONVB], WSP(bf16, WS_ACT), WSP(float, WS_EA), WSP(float, WS_EP), WSP(float, WS_EG)};
        pg8::gemm_phase<EpiUp, pg8::StaticOrder, true, true>(F.lds, g, S, E);
    } SEAM(6);

    if (IN(7)) { p5_fixup(F); } SEAM(7);

    if (IN(8)) {
        pg8::Gemm g{WSP(bf16, WS_ACT), WSP(bf16, WS_WDOWN), M, DM, DFF}; pg8::StaticOrder S; S.init(M, DM, F.G, bid);
        EpiRes E{F.out, F.out, nullptr, (float*)(F.ws + WS_CTL + CTL_ROWSQ3)};
        pg8::gemm_phase<EpiRes, pg8::StaticOrder, true, true>(F.lds, g, S, E);
    } SEAM(8);

    if (IN(9)) { p7_final(F); }

#ifdef DBG_STOP
    if (IN(10)) {
        const unsigned short* w16 = (const unsigned short*)F.ws;
        const size_t NE = (size_t)M * DM;
        for (size_t i = (size_t)F.vcu * 512 + F.tid; i < NE; i += (size_t)F.G * 512) {
            float acc = 0.f;
            const unsigned own = ((const unsigned*)F.out)[i];
            if (i < ((size_t)8 << 20) || (DBG_STOP >= 3 && DBG_OWN && i < ((size_t)16 << 20))) acc += (float)(own & 0xffffu) + (float)(own >> 16);
            for (size_t o = (size_t)DBG_LO * (MiB / 2) + i; o < (size_t)DBG_HI * (MiB / 2); o += NE) acc += (float)w16[o];
            F.out[i] = acc;
        }
    }
#endif
#undef IN
#undef SEAM
}

extern "C" void kernel_launch(void* const* d_in, const int* in_sizes, int n_in, void* d_out, int out_size, void* d_ws, size_t ws_size, hipStream_t stream) {
    static int grid = 0;
    if (grid == 0) {
        if (n_in != 23 || out_size != M * DM || ws_size < WS_END) { fprintf(stderr, "kernel_launch: unexpected shapes (n_in %d out %d ws %zu)\n", n_in, out_size, ws_size); grid = -1; return; }
        int dev = 0, cus = 0, per_cu = 0;
        if (hipGetDevice(&dev) != hipSuccess || hipDeviceGetAttribute(&cus, hipDeviceAttributeMultiprocessorCount, dev) != hipSuccess) { grid = -1; return; }
        if (hipFuncSetAttribute((const void*)skel_fwd, hipFuncAttributeMaxDynamicSharedMemorySize, LDS_BYTES) != hipSuccess) { fprintf(stderr, "kernel_launch: hipFuncSetAttribute failed\n"); grid = -1; return; }
        if (hipOccupancyMaxActiveBlocksPerMultiprocessor(&per_cu, (const void*)skel_fwd, NWAVES * 64, LDS_BYTES) != hipSuccess || per_cu < 1) fprintf(stderr, "kernel_launch: occupancy query reports %d\n", per_cu);
        (void)hipGetLastError();
        grid = cus;
    }
    if (grid < 0) return;
    if (hipMemsetAsync((char*)d_ws + WS_CTL, 0, CTL_ZERO_BYTES, stream) != hipSuccess) return;
    Args a{};
    for (int i = 0; i < 23; ++i) a.in[i] = (const float*)d_in[i];
    a.out = (float*)d_out; a.ws = (unsigned char*)d_ws;
#ifdef DBG_STOP
    const int nl = DBG_STOP + 1;
#else
    const int nl = MK_N_LAUNCHES;
#endif
    for (int li = 0; li < nl; ++li) {
        a.ph_lo = (MK_N_LAUNCHES == 1) ? 0 : li; a.ph_hi = (MK_N_LAUNCHES == 1) ? N_PHASES : li + 1; a.li = li;
#ifdef DBG_STOP
        if (li == DBG_STOP) { a.ph_lo = 10; a.ph_hi = 11; }
#endif
        hipLaunchKernelGGL(skel_fwd, dim3(grid), dim3(NWAVES * 64), LDS_BYTES, stream, a);
        const hipError_t le = hipPeekAtLastError();
        if (le != hipSuccess) { fprintf(stderr, "kernel_launch: launch %d failed: %s\n", li, hipGetErrorName(le)); break; }
    }
}
```

```cpp
#include <hip/hip_runtime.h>
#include <cstdio>
#include <cstdint>
#define MK_N_LAUNCHES 1
namespace pg8 {
#define PG8_LAS __attribute__((address_space(3)))
typedef unsigned short bf16_t;
typedef short bf16x8 __attribute__((ext_vector_type(8)));
typedef float f32x4 __attribute__((ext_vector_type(4)));
typedef unsigned u32x4 __attribute__((ext_vector_type(4)));
constexpr int BM = 256, BK = 64, HALF = 128, HTB = HALF * BK * 2  , STAGE_BYTES = 8 * HTB, NXCD = 8, WGM = 8;

__host__ __device__ __forceinline__ int lds_byte(int r, int c) { const int st = (r >> 4) * 2 + (c >> 5), rr = r & 15, cc = c & 31, ob = rr * 64 + cc * 2; return st * 1024 + (ob ^ (((ob >> 9) & 1) << 5)); }
__host__ __device__ __forceinline__ void stage_rc(int b, int& R, int& C) { const int st = b / 1024, sb = b % 1024, swz = sb ^ (((sb >> 9) & 1) << 5); R = (st >> 1) * 16 + swz / 64; C = (st & 1) * 32 + (swz % 64) / 2; }
__host__ __device__ __forceinline__ int perm32(int rho) { const int n = rho >> 4, i = rho & 15; return 8 * (i >> 2) + 4 * n + (i & 3); }

struct Unit { int pm, pn; };
struct Gemm { const bf16_t* A; const bf16_t* Bt; int M, N, K; };

struct StaticOrder {
    int nM, nN, nwg, G, c;
    __host__ __device__ void init(int M, int N, int G_, int c_) { nM = M / BM; nN = N / BM; nwg = nM * nN; G = G_; c = c_; }
    __host__ __device__ bool next(int i, Unit& u) const {
        const long L = (long)i * G + c; if (L >= nwg) return false;
        int wgid = (int)L; { const int q = nwg / NXCD, r = nwg % NXCD, xcd = wgid % NXCD, off = wgid / NXCD; wgid = (xcd < r ? xcd * (q + 1) : r * (q + 1) + (xcd - r) * q) + off; }
        const int nig = WGM * nN, gid = wgid / nig, fm = gid * WGM, gsz = (nM - fm) < WGM ? (nM - fm) : WGM;
        u.pm = fm + ((wgid % nig) % gsz); u.pn = (wgid % nig) / gsz; return true;
    }
    __device__ __forceinline__ void a_ready(const Unit&) const {}
    __device__ __forceinline__ void done(const Unit&) const {}
};

__device__ __forceinline__ unsigned cvt_pk_bf16(float lo, float hi) { unsigned r; asm volatile("v_cvt_pk_bf16_f32 %0, %1, %2" : "=v"(r) : "v"(lo), "v"(hi)); return r; }
typedef float f32x2 __attribute__((ext_vector_type(2)));
typedef int v8i32 __attribute__((ext_vector_type(8)));
typedef int i32x4_ __attribute__((ext_vector_type(4)));
template <class Epi, class Sched, bool ALIGN_EPI = false, bool SP2 = false, bool F8 = false>
__device__ __forceinline__ void gemm_phase(PG8_LAS unsigned char* lds, const Gemm g, const Sched& S, const Epi& E) {
    const int tid = threadIdx.x, wid = __builtin_amdgcn_readfirstlane(tid >> 6), lane = tid & 63, wr = wid >> 2, wc = wid & 3, fr = lane & 15, fq = lane >> 4;
    const int K = g.K, nt = K / BK;
    unsigned voffA[2], voffB[2];
#pragma unroll
    for (int i = 0; i < 2; ++i) { int R, C; stage_rc(tid * 16 + i * 8192, R, C); const int Rb = Epi::PERM ? ((R & ~31) + perm32(R & 31)) : R;
        const int Ra = Epi::APERM ? ((R & ~63) + 4 * (R & 15) + ((R >> 4) & 3)) : R;
        voffA[i] = (unsigned)(Ra * K + C) * 2u; voffB[i] = (unsigned)(Rb * K + C) * 2u; }
    const size_t kstep = (size_t)(BK * 2);
    const size_t hstep = (size_t)HALF * K * 2;
    const size_t tstep = 2 * hstep;
    const unsigned ldsw = (unsigned)wid * 1024u;
    const int aoff = lds_byte(wr * 64 + fr, fq * 8), boff = lds_byte(wc * 32 + fr, fq * 8);
#define PG8_SA(b, h) (((b) * 2 + (h)) * HTB)
#define PG8_SB(b, h) ((4 + (b) * 2 + (h)) * HTB)
#define PG8_STAGE(bufoff, gbase, voff) do { _Pragma("unroll") for (int _i = 0; _i < 2; ++_i) \
        __builtin_amdgcn_global_load_lds((const unsigned*)((const char*)(gbase) + (voff)[_i]), (PG8_LAS unsigned*)(lds + (bufoff) + ldsw + _i * 8192), 16, 0, 0); } while (0)
#define PG8_LDA(dst, b, h) do { _Pragma("unroll") for (int m = 0; m < 4; ++m) _Pragma("unroll") for (int k = 0; k < 2; ++k) dst[m][k] = *(const PG8_LAS bf16x8*)(lds + PG8_SA(b, h) + aoff + m * 2048 + k * 1024); } while (0)
#define PG8_LDB(dst, b, h) do { _Pragma("unroll") for (int n = 0; n < 2; ++n) _Pragma("unroll") for (int k = 0; k < 2; ++k) dst[n][k] = *(const PG8_LAS bf16x8*)(lds + PG8_SB(b, h) + boff + n * 2048 + k * 1024); } while (0)
#define PG8_CAT8(x, y) (__builtin_shufflevector(__builtin_bit_cast(i32x4_, x), __builtin_bit_cast(i32x4_, y), 0, 1, 2, 3, 4, 5, 6, 7))
#define PG8_MMA(ai, bj, At, Bt) do { __builtin_amdgcn_s_setprio(1); \
        if constexpr (F8) { _Pragma("unroll") for (int m = 0; m < 4; ++m) _Pragma("unroll") for (int n = 0; n < 2; ++n) { const v8i32 b8_ = PG8_CAT8(Bt[n][0], Bt[n][1]), a8_ = PG8_CAT8(At[m][0], At[m][1]); \
            asm volatile("v_mfma_f32_16x16x128_f8f6f4 %0, %1, %2, %0" : "+v"(acc[ai][bj][m][n]) : "v"(b8_), "v"(a8_)); } } \
        else { _Pragma("unroll") for (int m = 0; m < 4; ++m) _Pragma("unroll") for (int n = 0; n < 2; ++n) _Pragma("unroll") for (int k = 0; k < 2; ++k) \
            acc[ai][bj][m][n] = __builtin_amdgcn_mfma_f32_16x16x32_bf16(Bt[n][k], At[m][k], acc[ai][bj][m][n], 0, 0, 0); } __builtin_amdgcn_s_setprio(0); } while (0)
#define PG8_WAIT_V(n) asm volatile("s_waitcnt vmcnt(" #n ")" ::: "memory")
#define PG8_WAIT_L(n) asm volatile("s_waitcnt lgkmcnt(" #n ")" ::: "memory")
#define PG8_BAR __builtin_amdgcn_s_barrier()
#define PG8_SCHED __builtin_amdgcn_sched_barrier(0)
    Unit cur, nxt; int ui = 0;
    if (!S.next(0, cur)) return;
    f32x4 acc[2][2][4][2];
#pragma unroll
    for (int a = 0; a < 2; ++a)
#pragma unroll
        for (int b = 0; b < 2; ++b)
#pragma unroll
            for (int m = 0; m < 4; ++m)
#pragma unroll
                for (int n = 0; n < 2; ++n) acc[a][b][m][n] = (f32x4){0.f, 0.f, 0.f, 0.f};
    bf16x8 At[4][2], B0[2][2], B1[2][2];
    const char* cA = (const char*)g.A + (size_t)cur.pm * tstep; const char* cB = (const char*)g.Bt + (size_t)cur.pn * tstep;
    S.a_ready(cur);
    if constexpr (SP2) {
        PG8_STAGE(PG8_SB(0, 0), cB, voffB); PG8_STAGE(PG8_SB(0, 1), cB + hstep, voffB); PG8_STAGE(PG8_SA(0, 0), cA, voffA); PG8_STAGE(PG8_SA(0, 1), cA + hstep, voffA);
        if (wr == 1) PG8_BAR;
        PG8_WAIT_V(2); PG8_BAR;
        PG8_STAGE(PG8_SB(1, 0), cB + kstep, voffB); PG8_STAGE(PG8_SA(1, 0), cA + kstep, voffA); PG8_STAGE(PG8_SB(1, 1), cB + hstep + kstep, voffB);
        PG8_WAIT_V(6); PG8_BAR;
    } else {
        PG8_STAGE(PG8_SB(0, 0), cB, voffB); PG8_STAGE(PG8_SA(0, 0), cA, voffA); PG8_STAGE(PG8_SB(0, 1), cB + hstep, voffB); PG8_STAGE(PG8_SA(0, 1), cA + hstep, voffA);
        if (wr == 1) PG8_BAR;
        PG8_WAIT_V(4); PG8_BAR;
        PG8_STAGE(PG8_SB(1, 0), cB + kstep, voffB); PG8_STAGE(PG8_SA(1, 0), cA + kstep, voffA); PG8_STAGE(PG8_SB(1, 1), cB + hstep + kstep, voffB);
        PG8_WAIT_V(6); PG8_BAR;
    }
    for (;;) {
        const bool has_next = S.next(ui + 1, nxt);
        const char* nA = has_next ? (const char*)g.A + (size_t)nxt.pm * tstep : cA; const char* nB = has_next ? (const char*)g.Bt + (size_t)nxt.pn * tstep : cB;
        for (int t = 0; t < nt; t += 2) {
            const bool last = (t == nt - 2);
            const char* a1 = cA + (size_t)(t + 1) * kstep;
            const char* a2 = last ? nA : cA + (size_t)(t + 2) * kstep; const char* b2 = last ? nB : cB + (size_t)(t + 2) * kstep;
            const char* a3 = a2 + kstep; const char* b3 = b2 + kstep;
            if (last && has_next) S.a_ready(nxt);
            if constexpr (SP2) {
            PG8_LDB(B0, 0, 0); PG8_LDB(B1, 0, 1); PG8_SCHED; PG8_LDA(At, 0, 0); PG8_STAGE(PG8_SA(1, 1), a1 + hstep, voffA);
            PG8_WAIT_V(8); PG8_WAIT_L(0); PG8_BAR; PG8_MMA(0, 0, At, B0); PG8_MMA(0, 1, At, B1); PG8_BAR; PG8_SCHED;
            PG8_LDA(At, 0, 1); PG8_STAGE(PG8_SB(0, 0), b2, voffB); PG8_STAGE(PG8_SB(0, 1), b2 + hstep, voffB); PG8_STAGE(PG8_SA(0, 0), a2, voffA);
            PG8_WAIT_V(8); PG8_WAIT_L(0); PG8_BAR; PG8_MMA(1, 0, At, B0); PG8_MMA(1, 1, At, B1); PG8_BAR; PG8_SCHED;
            PG8_LDB(B0, 1, 0); PG8_LDB(B1, 1, 1); PG8_SCHED; PG8_LDA(At, 1, 0); PG8_STAGE(PG8_SA(0, 1), a2 + hstep, voffA);
            PG8_WAIT_V(8); PG8_WAIT_L(0); PG8_BAR; PG8_MMA(0, 0, At, B0); PG8_MMA(0, 1, At, B1); PG8_BAR; PG8_SCHED;
            PG8_LDA(At, 1, 1); PG8_STAGE(PG8_SB(1, 0), b3, voffB); PG8_STAGE(PG8_SB(1, 1), b3 + hstep, voffB); PG8_STAGE(PG8_SA(1, 0), a3, voffA);
            PG8_WAIT_V(8); PG8_WAIT_L(0); PG8_BAR; PG8_MMA(1, 0, At, B0); PG8_MMA(1, 1, At, B1); PG8_BAR; PG8_SCHED;
            } else {
            PG8_LDB(B0, 0, 0); PG8_SCHED; PG8_LDA(At, 0, 0); PG8_STAGE(PG8_SA(1, 1), a1 + hstep, voffA);
            PG8_WAIT_L(8); PG8_BAR; PG8_WAIT_L(0); PG8_MMA(0, 0, At, B0); PG8_BAR; PG8_SCHED;
            PG8_LDB(B1, 0, 1); PG8_STAGE(PG8_SB(0, 0), b2, voffB);
            PG8_BAR; PG8_WAIT_L(0); PG8_MMA(0, 1, At, B1); PG8_BAR;
            PG8_LDA(At, 0, 1); PG8_STAGE(PG8_SA(0, 0), a2, voffA);
            PG8_BAR; PG8_WAIT_L(0); PG8_MMA(1, 0, At, B0); PG8_BAR; PG8_SCHED;
            PG8_STAGE(PG8_SB(0, 1), b2 + hstep, voffB);
            PG8_WAIT_V(6); PG8_BAR; PG8_MMA(1, 1, At, B1); PG8_BAR;
            PG8_LDB(B0, 1, 0); PG8_SCHED; PG8_LDA(At, 1, 0); PG8_STAGE(PG8_SA(0, 1), a2 + hstep, voffA);
            PG8_WAIT_L(8); PG8_BAR; PG8_WAIT_L(0); PG8_MMA(0, 0, At, B0); PG8_BAR; PG8_SCHED;
            PG8_LDB(B1, 1, 1); PG8_STAGE(PG8_SB(1, 0), b3, voffB);
            PG8_BAR; PG8_WAIT_L(0); PG8_MMA(0, 1, At, B1); PG8_BAR;
            PG8_LDA(At, 1, 1); PG8_STAGE(PG8_SA(1, 0), a3, voffA);
            PG8_BAR; PG8_WAIT_L(0); PG8_MMA(1, 0, At, B0); PG8_BAR; PG8_SCHED;
            PG8_STAGE(PG8_SB(1, 1), b3 + hstep, voffB);
            PG8_WAIT_V(6); PG8_BAR; PG8_MMA(1, 1, At, B1); PG8_BAR;
            }
        }
        if constexpr (F8) asm volatile("s_nop 15\n\ts_nop 15\n\ts_nop 15" ::: "memory");
        if constexpr (ALIGN_EPI) { if (wr == 0) PG8_BAR; }
        if constexpr (!Epi::AFTER_DRAIN) { E(acc, cur, wr, wc, fr, fq); S.done(cur); }
        if (!has_next) break;
#pragma unroll
        for (int a = 0; a < 2; ++a)
#pragma unroll
            for (int b = 0; b < 2; ++b)
#pragma unroll
                for (int m = 0; m < 4; ++m)
#pragma unroll
                    for (int n = 0; n < 2; ++n) acc[a][b][m][n] = (f32x4){0.f, 0.f, 0.f, 0.f};
        cur = nxt; cA = nA; cB = nB; ++ui;
        if constexpr (ALIGN_EPI) { if (wr == 1) PG8_BAR; }
    }
    PG8_WAIT_V(0);
    if constexpr (!ALIGN_EPI) { if (wr == 0) PG8_BAR; }
    PG8_BAR;
    if constexpr (Epi::AFTER_DRAIN) { E.fused(acc, cur, wr, wc, fr, fq, lds, wid, lane); S.done(cur); }
#undef PG8_SA
#undef PG8_SB
#undef PG8_STAGE
#undef PG8_LDA
#undef PG8_LDB
#undef PG8_MMA
#undef PG8_CAT8
#undef PG8_WAIT_V
#undef PG8_WAIT_L
#undef PG8_BAR
#undef PG8_SCHED
}
}
#define GAS __attribute__((address_space(1)))
#define LAS __attribute__((address_space(3)))
typedef unsigned short bf16;
typedef unsigned v4u __attribute__((ext_vector_type(4)));
typedef float f32x4 __attribute__((ext_vector_type(4)));
typedef short bf16x8 __attribute__((ext_vector_type(8)));
typedef GAS unsigned gu32;
typedef GAS unsigned long long gu64;
#define RLX_AGENT __ATOMIC_RELAXED, __HIP_MEMORY_SCOPE_AGENT
#define LDS_WAIT() asm volatile("s_waitcnt lgkmcnt(0)" ::: "memory")
#define VM_WAIT() asm volatile("s_waitcnt vmcnt(0)" ::: "memory")
__device__ __forceinline__ unsigned long long rt() { return __builtin_amdgcn_s_memrealtime(); }
__device__ __forceinline__ unsigned f2bf(float f) { unsigned u = __builtin_bit_cast(unsigned, f); return (u + 0x7fffu + ((u >> 16) & 1u)) >> 16; }
__device__ __forceinline__ unsigned pk2(float lo, float hi) { return f2bf(lo) | (f2bf(hi) << 16); }
#define XB_TMO      128
#define XB_XCNT(j)  (256  + 64 * (j))
#define XB_XSUB(j)  (1280 + 64 * (j))
#define XB_XGEN(j)  (2304 + 64 * (j))
#define XB_TOP      3328
#define XB_TOPGEN   3392
#define XCD_BAR_WORDS 3456
#define XB_SPIN_CAP (1u << 18)

__device__ __forceinline__ unsigned xb_ld(unsigned* p)              { return __hip_atomic_load(p, __ATOMIC_RELAXED, __HIP_MEMORY_SCOPE_AGENT); }
__device__ __forceinline__ unsigned xb_add(unsigned* p, unsigned v) { return __hip_atomic_fetch_add(p, v, __ATOMIC_RELAXED, __HIP_MEMORY_SCOPE_AGENT); }
__device__ __forceinline__ unsigned xb_xcc_id() { return (unsigned)__builtin_amdgcn_s_getreg((3 << 11) | 20) & 0xFu; }
#define XB_SPIN(cond, bar) do { unsigned _sp = 0; while (cond) { __builtin_amdgcn_s_sleep(1); \
    if ((++_sp & 255u) == 0u) { if (xb_ld(&(bar)[XB_TMO])) break; if (_sp > XB_SPIN_CAP) { atomicAdd(&(bar)[XB_TMO], 1u); break; } } } } while (0)

struct XcdBarrier {
    unsigned* bar; unsigned x;
    volatile LAS unsigned* st;
};

__device__ __forceinline__ XcdBarrier xcd_barrier_post(unsigned* bar, volatile LAS unsigned* st) {
    XcdBarrier b; b.bar = bar; b.x = xb_xcc_id(); b.st = st;
    if (threadIdx.x == 0) (void)xb_add(&bar[XB_XCNT(b.x)], 1u);
    return b;
}
__device__ __forceinline__ void xcd_barrier_complete(unsigned* bar, unsigned x, unsigned& nloc, unsigned& nx) {
    const unsigned G = gridDim.x * gridDim.y * gridDim.z;
    unsigned sum, cnt, mine, sp = 0u;
    for (;;) {
        sum = 0u; cnt = 0u; mine = 0u;
#pragma unroll
        for (unsigned j = 0; j < 16; ++j) { const unsigned c = xb_ld(&bar[XB_XCNT(j)]); sum += c; cnt += (c > 0u) ? 1u : 0u; mine = (j == x) ? c : mine; }
        if (sum == G) break;
        __builtin_amdgcn_s_sleep(1);
        if ((++sp & 255u) == 0u) { if (xb_ld(&bar[XB_TMO])) break; if (sp > XB_SPIN_CAP) { atomicAdd(&bar[XB_TMO], 1u); break; } }
    }
    nloc = mine > 0u ? mine : 1u; nx = cnt > 0u ? cnt : 1u;
}

__device__ __forceinline__ void xcd_barrier(const XcdBarrier& b) {
    asm volatile("s_waitcnt vmcnt(0)" ::: "memory");
    __syncthreads();
    if (threadIdx.x == 0) {
        unsigned* bar = b.bar;
        __builtin_amdgcn_s_waitcnt(0);
        unsigned nloc = b.st[0], nx = b.st[1];
        if (nloc == 0u) { xcd_barrier_complete(bar, b.x, nloc, nx); b.st[0] = nloc; b.st[1] = nx; }
        const unsigned old = xb_add(&bar[XB_XSUB(b.x)], 1u);
        const unsigned gen = old / nloc;
        if (old + 1u == (gen + 1u) * nloc) {
            __builtin_amdgcn_fence(__ATOMIC_RELEASE, "agent");
            asm volatile("s_waitcnt vmcnt(0)" ::: "memory");
            const unsigned og = xb_add(&bar[XB_TOP], 1u);
            const unsigned tg = og / nx;
            if (og + 1u == (tg + 1u) * nx) xb_add(&bar[XB_TOPGEN], 1u);
            else XB_SPIN(xb_ld(&bar[XB_TOPGEN]) == tg, bar);
            __builtin_amdgcn_fence(__ATOMIC_ACQUIRE, "agent");
            xb_add(&bar[XB_XGEN(b.x)], 1u);
            asm volatile("s_waitcnt vmcnt(0)" ::: "memory");
        } else {
            XB_SPIN(xb_ld(&bar[XB_XGEN(b.x)]) == gen, bar);
            __builtin_amdgcn_fence(__ATOMIC_ACQUIRE, "agent");
            asm volatile("s_waitcnt vmcnt(0)" ::: "memory");
        }
    }
    __syncthreads();
}

constexpr int NB = 4, SEQ = 4096, DM = 2048, LPOS = 4112, M = NB * SEQ;
constexpr int DFF = 5632, NHEAD = 16, HD = 64;
constexpr int NIN = 8192, NMAIN = 7168;
constexpr int NCH = 257;
constexpr float EPS = 1e-6f;
constexpr int NWAVES = 8;

constexpr size_t MiB = 1u << 20;
constexpr size_t WS_CTL = 0, CTL_ZERO_BYTES = 1 * MiB;
constexpr size_t WS_WIN = 1 * MiB, WS_WUP = 33 * MiB, WS_WDOWN = 77 * MiB, WS_WOUT = 99 * MiB, WS_WNA = 107 * MiB, WS_WSSM = 111 * MiB, WS_WGLU = 115 * MiB;
constexpr size_t WS_Q = 117 * MiB, WS_K = 149 * MiB, WS_VT = 181 * MiB, WS_U = 213 * MiB, WS_O = 247 * MiB;
constexpr size_t WS_MIX = 117 * MiB;
constexpr size_t WS_ACT = 117 * MiB;
constexpr size_t WS_SGNA = 293 * MiB, WS_SGSSM = 357 * MiB;
constexpr size_t WS_H2B = 293 * MiB;
constexpr size_t WS_EA = 357 * MiB, WS_EP = 369 * MiB, WS_EG = 381 * MiB;
constexpr size_t WS_XB = 421 * MiB;
constexpr size_t OUT_WV8 = 22 * MiB;
constexpr size_t OUT_W8 = 64 * MiB;
constexpr size_t OUT_WNA8 = 24 * MiB;
constexpr size_t OUT_WG8 = 26 * MiB, OUT_XB8 = 32 * MiB;
constexpr size_t OUT_YG = 32 * MiB, OUT_SGLU = 64 * MiB;
constexpr size_t WS_H3B = 421 * MiB;
constexpr size_t WS_SMALL = 485 * MiB, WS_END = 512 * MiB;
constexpr size_t SM_R1 = 0, SM_R1M = 192 * 1024, SM_Q15 = 196 * 1024, SM_SGNA15 = 200 * 1024, SM_SGSSM15 = 208 * 1024;
constexpr size_t SM_XBM = 256 * 1024, SM_KM = 320 * 1024, SM_VMT = 352 * 1024, SM_AYG15 = 416 * 1024, SM_AO15 = 448 * 1024, SM_AS15 = 480 * 1024;
constexpr size_t SM_AMIX15 = 512 * 1024, SM_AH2B15 = 576 * 1024, SM_A15 = 640 * 1024, SM_LAM16 = 768 * 1024;
constexpr size_t CTL_ROWSQ2 = 256 * 1024, CTL_ROWSQ3 = 320 * 1024, CTL_ROWSQM = 384 * 1024;
constexpr int CW_BAR = 4096;
constexpr size_t OUT_P = 0, OUT_R = 8 * MiB, OUT_KL = 16 * MiB, OUT_CP = 18 * MiB, OUT_L5 = 20 * MiB;

constexpr int RING_BYTES = 131072;
constexpr int MISC_OFF = 159744 - 256;
constexpr int LDS_BYTES = 159744;
static_assert(MISC_OFF + 128 <= LDS_BYTES, "LDS map");

typedef float f32x2 __attribute__((ext_vector_type(2)));
typedef unsigned v2u __attribute__((ext_vector_type(2)));
struct Frame {
    LAS unsigned char* lds;
    int tid, lane, wave, vcu, G, gw, NGW;
    const float* in[23];
    float* out; unsigned char* ws;
};
#define IN_X 0
#define IN_META 1
#define IN_G1 2
#define IN_WIN 3
#define IN_RPB 4
#define IN_LAMRE 5
#define IN_LAMIM 6
#define IN_LOGSTEP 7
#define IN_BRE 8
#define IN_BIM 9
#define IN_CRE 10
#define IN_CIM 11
#define IN_SSMD 12
#define IN_WGLU 13
#define IN_WNA 14
#define IN_WSSM 15
#define IN_WOUT 16
#define IN_G2 17
#define IN_WUP 18
#define IN_CONVW 19
#define IN_CONVB 20
#define IN_WDOWN 21
#define IN_GF 22
#define WSP(T, off) ((T*)(F.ws + (off)))
#define SMP(T, off) ((T*)(F.ws + WS_SMALL + (off)))
#define OUTP(T, off) ((T*)((unsigned char*)F.out + (off)))

__device__ __forceinline__ float wave_sum(float v) {
#pragma unroll
    for (int o = 1; o < 64; o <<= 1) v += __shfl_xor(v, o);
    return v;
}
typedef __bf16 bf16x2_t __attribute__((ext_vector_type(2)));
__device__ __forceinline__ unsigned cvtpk(float lo, float hi) { f32x2 v = {lo, hi}; bf16x2_t b = __builtin_convertvector(v, bf16x2_t); return __builtin_bit_cast(unsigned, b); }
__device__ __forceinline__ float bf2f(bf16 h) { return __builtin_bit_cast(float, (unsigned)h << 16); }
__device__ __forceinline__ float sigmoidf_(float x) { return __builtin_amdgcn_rcpf(1.0f + __expf(-x)); }
__device__ __forceinline__ float gelu_tanh(float x) { const float z = x * __builtin_fmaf(x * x, -0.10294324f, -2.3022082f); return x * __builtin_amdgcn_rcpf(1.0f + __builtin_amdgcn_exp2f(z)); }
__device__ __forceinline__ unsigned pk4_fp8(float a, float b, float c, float d) { unsigned w = __builtin_amdgcn_cvt_pk_fp8_f32(a, b, 0, false); return __builtin_amdgcn_cvt_pk_fp8_f32(c, d, w, true); }
template <int CTRL> __device__ __forceinline__ float dpp0(float x) { return __builtin_bit_cast(float, __builtin_amdgcn_update_dpp(0, __builtin_bit_cast(int, x), CTRL, 0xf, 0xf, true)); }
__device__ __forceinline__ bf16x8 ldfrag(const bf16* base, int ld, int lane) { return *(const bf16x8*)(base + (size_t)(lane & 15) * ld + 8 * (lane >> 4)); }
__device__ __forceinline__ bf16x8 ldfrag_lds(const LAS bf16* base, int ld, int lane) { return *(const LAS bf16x8*)(base + (lane & 15) * ld + 8 * (lane >> 4)); }
#define MFMA16(a, b, c) __builtin_amdgcn_mfma_f32_16x16x32_bf16((a), (b), (c), 0, 0, 0)
__device__ __forceinline__ bf16x8 dq8(v2u w) {
    const f32x2 a = __builtin_amdgcn_cvt_pk_f32_fp8((int)w.x, false), b = __builtin_amdgcn_cvt_pk_f32_fp8((int)w.x, true), c = __builtin_amdgcn_cvt_pk_f32_fp8((int)w.y, false), d = __builtin_amdgcn_cvt_pk_f32_fp8((int)w.y, true);
    v4u o; o.x = cvtpk(a[0], a[1]); o.y = cvtpk(b[0], b[1]); o.z = cvtpk(c[0], c[1]); o.w = cvtpk(d[0], d[1]); return __builtin_bit_cast(bf16x8, o); }
template <int K> __device__ __forceinline__ f32x4 meta_nt16_f8(Frame& F, const bf16* A, int lda, const unsigned char* Bt8, int ldb) {
    constexpr int NS = K / 8 / 32;
    const int lane = F.lane;
    const bf16* ap = A + (size_t)(lane & 15) * lda + 8 * (lane >> 4) + F.wave * (K / 8); const unsigned char* bp = Bt8 + (size_t)(lane & 15) * ldb + 8 * (lane >> 4) + F.wave * (K / 8);
    bf16x8 a[NS]; v2u b[NS];
#pragma unroll
    for (int i = 0; i < NS; ++i) { a[i] = *(const bf16x8*)(ap + 32 * i); b[i] = *(const v2u*)(bp + 32 * i); }
    f32x4 acc = {0.f, 0.f, 0.f, 0.f};
#pragma unroll
    for (int i = 0; i < NS; ++i) acc = MFMA16(a[i], dq8(b[i]), acc);
    LAS f32x4* red = (LAS f32x4*)F.lds;
    red[F.wave * 64 + lane] = acc;
    __syncthreads();
    f32x4 sum = {0.f, 0.f, 0.f, 0.f};
    if (F.wave == 0) {
#pragma unroll
        for (int w = 0; w < 8; ++w) sum = sum + red[w * 64 + lane]; }
    __syncthreads();
    return sum;
}
template <int K> __device__ __forceinline__ f32x4 meta_nt16_pair(Frame& F, const bf16* A, int lda, const void* Bt, int ldb, bool f8, f32x4* other = nullptr) {
    constexpr int NS = K / 4 / 32;
    const int lane = F.lane, kq = F.wave & 3;
    const bf16* ap = A + (size_t)(lane & 15) * lda + 8 * (lane >> 4) + kq * (K / 4);
    bf16x8 a[NS], b[NS];
#pragma unroll
    for (int i = 0; i < NS; ++i) a[i] = *(const bf16x8*)(ap + 32 * i);
    if (f8) { const unsigned char* bp = (const unsigned char*)Bt + (size_t)(lane & 15) * ldb + 8 * (lane >> 4) + kq * (K / 4); v2u q[NS];
#pragma unroll
        for (int i = 0; i < NS; ++i) q[i] = *(const v2u*)(bp + 32 * i);
#pragma unroll
        for (int i = 0; i < NS; ++i) b[i] = dq8(q[i]); }
    else { const bf16* bp = (const bf16*)Bt + (size_t)(lane & 15) * ldb + 8 * (lane >> 4) + kq * (K / 4);
#pragma unroll
        for (int i = 0; i < NS; ++i) b[i] = *(const bf16x8*)(bp + 32 * i); }
    f32x4 acc = {0.f, 0.f, 0.f, 0.f};
#pragma unroll
    for (int i = 0; i < NS; ++i) acc = MFMA16(a[i], b[i], acc);
    LAS f32x4* red = (LAS f32x4*)F.lds;
    red[F.wave * 64 + lane] = acc;
    __syncthreads();
    f32x4 sum = {0.f, 0.f, 0.f, 0.f};
    if (kq == 0) {
#pragma unroll
        for (int w = 0; w < 4; ++w) sum = sum + red[(F.wave + w) * 64 + lane]; }
    if (other && F.wave == 0) { f32x4 s2 = {0.f, 0.f, 0.f, 0.f};
#pragma unroll
        for (int w = 4; w < 8; ++w) s2 = s2 + red[w * 64 + lane];
        *other = s2; }
    __syncthreads();
    return sum;
}
template <int K> __device__ __forceinline__ f32x4 meta_nt16(Frame& F, const bf16* A, int lda, const bf16* Bt, int ldb) {
    constexpr int NS = K / 8 / 32;
    const int lane = F.lane;
    const bf16* ap = A + (size_t)(lane & 15) * lda + 8 * (lane >> 4) + F.wave * (K / 8); const bf16* bp = Bt + (size_t)(lane & 15) * ldb + 8 * (lane >> 4) + F.wave * (K / 8);
    bf16x8 a[NS], b[NS];
#pragma unroll
    for (int i = 0; i < NS; ++i) { a[i] = *(const bf16x8*)(ap + 32 * i); b[i] = *(const bf16x8*)(bp + 32 * i); }
    f32x4 acc = {0.f, 0.f, 0.f, 0.f};
#pragma unroll
    for (int i = 0; i < NS; ++i) acc = MFMA16(a[i], b[i], acc);
    LAS f32x4* red = (LAS f32x4*)F.lds;
    red[F.wave * 64 + lane] = acc;
    __syncthreads();
    f32x4 sum = {0.f, 0.f, 0.f, 0.f};
    if (F.wave == 0) {
#pragma unroll
        for (int w = 0; w < 8; ++w) sum = sum + red[w * 64 + lane]; }
    __syncthreads();
    return sum;
}

constexpr int P0_TP = 264;
__device__ __forceinline__ void p0_transpose_item(const float* W, int K, int N, bf16* WT, int dest_row0, const float* kscale, LAS bf16* TT, int kb, int nb, int lane, int wave, unsigned char* W8 = nullptr, int dest8_row0 = 0, bool keep16 = false) {
    const int k0 = 256 * kb + 32 * wave, n0 = 128 * nb, kr = lane >> 5, n4 = (lane & 31) * 4;
    f32x4 v[16]; unsigned loff = (unsigned)(kr * 16 * N + n4) * 4u; asm volatile("" : "+v"(loff));
#pragma unroll
    for (int i = 0; i < 16; ++i) v[i] = __builtin_nontemporal_load((const f32x4*)((const char*)(W + (size_t)(k0 + i) * N + n0) + loff));
    if (kscale) {
#pragma unroll
        for (int i = 0; i < 16; ++i) v[i] = v[i] * kscale[k0 + 16 * kr + i]; }
    LAS unsigned* TT32 = (LAS unsigned*)TT;
#pragma unroll
    for (int p8 = 0; p8 < 8; ++p8) { const int kd = 16 * wave + ((8 * kr + p8) ^ (4 * (lane & 3)));
#pragma unroll
        for (int cc = 0; cc < 4; ++cc) TT32[(n4 + cc) * (P0_TP / 2) + kd] = cvtpk(v[2 * p8][cc], v[2 * p8 + 1][cc]); }
    __syncthreads();
    const int c = lane & 31, nr = lane >> 5;
#pragma unroll
    for (int j = 0; j < 8; ++j) { const int n = 16 * wave + 2 * j + nr; const v4u w = *(const LAS v4u*)(TT + n * P0_TP + 8 * (c ^ ((n >> 2) & 3)));
        if (!W8 || keep16) *(v4u*)(WT + (size_t)(dest_row0 + n) * K + 256 * kb + 8 * c) = w;
        if (W8) { v2u q;
            q.x = pk4_fp8(64.f * __builtin_bit_cast(float, w.x << 16), 64.f * __builtin_bit_cast(float, w.x & 0xffff0000u), 64.f * __builtin_bit_cast(float, w.y << 16), 64.f * __builtin_bit_cast(float, w.y & 0xffff0000u));
            q.y = pk4_fp8(64.f * __builtin_bit_cast(float, w.z << 16), 64.f * __builtin_bit_cast(float, w.z & 0xffff0000u), 64.f * __builtin_bit_cast(float, w.w << 16), 64.f * __builtin_bit_cast(float, w.w & 0xffff0000u));
            *(v2u*)(W8 + (size_t)(dest8_row0 + n) * K + 256 * kb + 8 * c) = q; } }
    __syncthreads();
}
__device__ __forceinline__ void p0_row(const float* xrow, bf16* orow, float* rout, int lane, unsigned* o8row = nullptr) {
    const f32x4* xr = (const f32x4*)xrow + lane;
    f32x4 v[8]; float s = 0.f;
#pragma unroll
    for (int j = 0; j < 8; ++j) { v[j] = __builtin_nontemporal_load(xr + 64 * j); s += (v[j].x * v[j].x + v[j].y * v[j].y) + (v[j].z * v[j].z + v[j].w * v[j].w); }
    s = wave_sum(s);
    if (lane == 0) *rout = 1.0f / sqrtf(s * (1.0f / DM) + EPS);
    unsigned long long* o8 = (unsigned long long*)orow + lane;
#pragma unroll
    for (int j = 0; j < 8; ++j) o8[64 * j] = (unsigned long long)pk2(v[j].x, v[j].y) | ((unsigned long long)pk2(v[j].z, v[j].w) << 32);
    if (o8row) {
#pragma unroll
        for (int j = 0; j < 8; ++j) o8row[64 * j + lane] = pk4_fp8(v[j].x, v[j].y, v[j].z, v[j].w); }
}
__device__ __forceinline__ void sincos_d(double x, double& s, double& c) {
    const double TWO_PI = 6.283185307179586476925286766559;
    const double k = __builtin_rint(x / TWO_PI); double r = x - k * TWO_PI; r *= 0.25;
    const double r2 = r * r;
    double sn = r * (1.0 + r2 * (-1.0 / 6 + r2 * (1.0 / 120 + r2 * (-1.0 / 5040 + r2 * (1.0 / 362880 + r2 * (-1.0 / 39916800 + r2 * (1.0 / 6227020800.0)))))));
    double cs = 1.0 + r2 * (-0.5 + r2 * (1.0 / 24 + r2 * (-1.0 / 720 + r2 * (1.0 / 40320 + r2 * (-1.0 / 3628800 + r2 * (1.0 / 479001600.0 + r2 * (-1.0 / 87178291200.0)))))));
#pragma unroll
    for (int i = 0; i < 2; ++i) { const double s2 = 2.0 * sn * cs, c2 = cs * cs - sn * sn; sn = s2; cs = c2; }
    s = sn; c = cs;
}
__device__ __forceinline__ void cpow_(float lre, float lim, float step, int k, float& pr, float& pi) {
    const float mag = expf(lre * step * (float)k); double sd, cd; sincos_d((double)lim * (double)step * (double)k, sd, cd); pr = mag * (float)cd; pi = mag * (float)sd;
}
__device__ __forceinline__ void p0_s5_tables(Frame& F, int dir, int g, int half) {
    LAS float* LP = (LAS float*)F.lds;
    LAS float* BB = LP + 17 * 64 * 2;
    LAS float* CC = BB + 64 * 16 * 2;
    LAS float* KK = CC + 16 * 64 * 2;
    const int t = F.tid, dg = dir * 64 + g, lane = F.lane;
    unsigned char* ob = (unsigned char*)F.out;
    const float step = expf(F.in[IN_LOGSTEP][dg]);
    for (int e = t; e < 64 * (half ? 38 : 17); e += 512) { const int n = e & 63, idx = e >> 6;
        const float lre = F.in[IN_LAMRE][dg * 64 + n], lim = F.in[IN_LAMIM][dg * 64 + n];
        const int k = idx <= 16 ? idx : (idx < 22 ? (16 << (idx - 17)) : 16 * (dir ? 15 - (idx - 22) : (idx - 22)));
        float pr, pi; cpow_(lre, lim, step, k, pr, pi);
        if (idx <= 16) { LP[(idx * 64 + n) * 2] = pr; LP[(idx * 64 + n) * 2 + 1] = pi; }
        else if (idx < 22) { float* L5 = (float*)(ob + OUT_L5 + (size_t)dg * 2560); L5[((idx - 17) * 64 + n) * 2] = pr; L5[((idx - 17) * 64 + n) * 2 + 1] = pi; }
        else { float* CP = (float*)(ob + OUT_CP + (size_t)dg * 9216); CP[(idx - 22) * 130 + 2 * n] = pr; CP[(idx - 22) * 130 + 2 * n + 1] = pi; } }
    for (int e = t; e < 1024; e += 512) { const int c = e >> 6, n = e & 63; CC[e * 2] = F.in[IN_CRE][(dg * 16 + c) * 64 + n]; CC[e * 2 + 1] = F.in[IN_CIM][(dg * 16 + c) * 64 + n]; }
    __syncthreads();
    for (int e = t; e < 1024; e += 512) { const int n = e >> 4, c = e & 15;
        const float lre = F.in[IN_LAMRE][dg * 64 + n], lim = F.in[IN_LAMIM][dg * 64 + n], l1r = LP[(64 + n) * 2], l1i = LP[(64 + n) * 2 + 1];
        const float ar = l1r - 1.f, ai = l1i, den = 1.0f / (lre * lre + lim * lim), fr_ = (ar * lre + ai * lim) * den, fi_ = (ai * lre - ar * lim) * den;
        const float br = F.in[IN_BRE][(dg * 64 + n) * 16 + c], bi = F.in[IN_BIM][(dg * 64 + n) * 16 + c];
        BB[e * 2] = fr_ * br - fi_ * bi; BB[e * 2 + 1] = fr_ * bi + fi_ * br; }
    __syncthreads();
    if (!half) {
        bf16* P = (bf16*)(ob + OUT_P) + (size_t)dg * 128 * 256;
        for (int e = t; e < 128 * 256; e += 512) { const int rho = e >> 8, k = e & 255, part = (rho >> 5) & 1, n = (rho & 31) + 32 * (rho >> 6), j = k >> 4, cp = k & 15, ex = dir ? j : 15 - j;
            const float lr = LP[(ex * 64 + n) * 2], li = LP[(ex * 64 + n) * 2 + 1], br = BB[(n * 16 + cp) * 2], bi = BB[(n * 16 + cp) * 2 + 1];
            P[e] = (bf16)f2bf(part ? (lr * bi + li * br) : (lr * br - li * bi)); }
    } else {
#pragma unroll
        for (int dd = 0; dd < 2; ++dd) { const int d = 2 * F.wave + dd, c = lane & 15; f32x4 acc = {0.f, 0.f, 0.f, 0.f};
            for (int tt = 0; tt < 32; ++tt) { const int k = 4 * tt + (lane >> 4), part = k >> 6, n = k & 63;
                const float cr = CC[(c * 64 + n) * 2], ci = CC[(c * 64 + n) * 2 + 1], lr = LP[(d * 64 + n) * 2], li = LP[(d * 64 + n) * 2 + 1];
                const float av = part ? -(cr * li + ci * lr) : (cr * lr - ci * li), bv = BB[(n * 16 + c) * 2 + part];
                acc = __builtin_amdgcn_mfma_f32_16x16x4f32(av, bv, acc, 0, 0, 0); }
#pragma unroll
            for (int r = 0; r < 4; ++r) KK[(d * 16 + 4 * (lane >> 4) + r) * 16 + c] = acc[r]; }
        bf16* R = (bf16*)(ob + OUT_R) + (size_t)dg * 256 * 128;
        for (int e = t; e < 256 * 128; e += 512) { const int row = e >> 7, kk = e & 127, q = (kk >> 3) ^ (row & 15), j = kk & 7, rt = q >> 2, s = (q >> 1) & 1, hh = q & 1, sig = 16 * s + 8 * (j >> 2) + 4 * hh + (j & 3);
            const int part = rt & 1, n = 32 * (rt >> 1) + sig, i = row >> 4, c = row & 15, ex = dir ? 16 - i : i + 1;
            const float cr = CC[(c * 64 + n) * 2], ci = CC[(c * 64 + n) * 2 + 1], lr = LP[(ex * 64 + n) * 2], li = LP[(ex * 64 + n) * 2 + 1];
            R[e] = (bf16)f2bf(part ? -(cr * li + ci * lr) : (cr * lr - ci * li)); }
        __syncthreads();
        bf16* KL = (bf16*)(ob + OUT_KL + (size_t)dg * 9216);
        for (int e = t; e < 17 * 256; e += 512) { const int d = (e >> 8) - 1, c = (e >> 4) & 15, cp = e & 15; float v = 0.f;
            if (d >= 0) { v = KK[(d * 16 + c) * 16 + cp]; if (dir == 0 && d == 0 && c == cp) v += F.in[IN_SSMD][g * 16 + c]; }
            KL[e] = (bf16)f2bf(v); }
    }
    __syncthreads();
}
__device__ __forceinline__ void p0_prologue(Frame& F) {
    for (int v = F.vcu; v < 256; v += F.G) p0_s5_tables(F, (v >> 1) >> 6, (v >> 1) & 63, v & 1);
    LAS bf16* scr = (LAS bf16*)F.lds;
    const int gw = F.gw, NGW = F.NGW;
    constexpr int I_IN = 8 * 64, I_UP = 8 * 88, I_DOWN = 22 * 16, I_OUT = 8 * 16, I_NA = 4 * 16, I_SSM = 4 * 16, I_GLU = 4 * 8;
    constexpr int NITEMS = I_IN + I_UP + I_DOWN + I_OUT + I_NA + I_SSM + I_GLU;
    for (int it = F.vcu; it < NITEMS; it += F.G) {
        int r = it;
        if (r < I_IN) { const int kb = r % 8, nb = r / 8, n0 = nb * 128;
            const int dest = n0 < 2048 ? n0 : (n0 < 3072 ? 7168 + (n0 - 2048) : (n0 < 4096 ? 2048 + (n0 - 3072) : 3072 + (n0 - 4096)));
            p0_transpose_item(F.in[IN_WIN], DM, NIN, WSP(bf16, WS_WIN), dest, F.in[IN_G1], scr, kb, nb, F.lane, F.wave, (n0 < 2048 || n0 >= 4096) ? OUTP(unsigned char, OUT_W8) : (n0 < 3072 ? OUTP(unsigned char, OUT_WV8) : nullptr), n0 < 2048 ? n0 : (n0 >= 4096 ? n0 - 2048 : n0 - 2048)); continue; } r -= I_IN;
        if (r < I_UP) { const int kb = r % 8, nb = r / 8, n0 = nb * 128; const int isg = n0 >= DFF, j0 = isg ? n0 - DFF : n0;
            const int dest = 256 * (j0 >> 7) + (isg ? 128 : 0) + (j0 & 127);
            p0_transpose_item(F.in[IN_WUP], DM, 2 * DFF, WSP(bf16, WS_WUP), dest, F.in[IN_G2], scr, kb, nb, F.lane, F.wave); continue; } r -= I_UP;
        if (r < I_DOWN) { p0_transpose_item(F.in[IN_WDOWN], DFF, DM, WSP(bf16, WS_WDOWN), (r / 22) * 128, nullptr, scr, r % 22, r / 22, F.lane, F.wave); continue; } r -= I_DOWN;
        if (r < I_OUT) { p0_transpose_item(F.in[IN_WOUT], DM, DM, WSP(bf16, WS_WOUT), (r / 8) * 128, nullptr, scr, r % 8, r / 8, F.lane, F.wave); continue; } r -= I_OUT;
        if (r < I_NA) { p0_transpose_item(F.in[IN_WNA], 1024, DM, WSP(bf16, WS_WNA), (r / 4) * 128, nullptr, scr, r % 4, r / 4, F.lane, F.wave, OUTP(unsigned char, OUT_WNA8), (r / 4) * 128); continue; } r -= I_NA;
        if (r < I_SSM) { p0_transpose_item(F.in[IN_WSSM], 1024, DM, WSP(bf16, WS_WSSM), (r / 4) * 128, nullptr, scr, r % 4, r / 4, F.lane, F.wave); continue; } r -= I_SSM;
        p0_transpose_item(F.in[IN_WGLU], 1024, 1024, WSP(bf16, WS_WGLU), (r / 4) * 128, nullptr, scr, r % 4, r / 4, F.lane, F.wave);
    }
    for (int m = gw; m < M; m += NGW) p0_row(F.in[IN_X] + (size_t)m * DM, WSP(bf16, WS_XB) + (size_t)m * DM, SMP(float, SM_R1) + m, F.lane, OUTP(unsigned, OUT_XB8) + (size_t)m * (DM / 4));
    if (gw < 16) p0_row(F.in[IN_META] + (size_t)gw * DM, SMP(bf16, SM_XBM) + (size_t)gw * DM, SMP(float, SM_R1M) + gw, F.lane);
}

typedef float f32x4 __attribute__((ext_vector_type(4)));
__device__ __forceinline__ v4u pack8(f32x4 v0, f32x4 v1) { v4u w; w.x = cvtpk(v0[0], v0[1]); w.y = cvtpk(v0[2], v0[3]); w.z = cvtpk(v1[0], v1[1]); w.w = cvtpk(v1[2], v1[3]); return w; }
__device__ __forceinline__ void unpack8(v4u w, f32x4& v0, f32x4& v1) {
    v0[0] = __builtin_bit_cast(float, w.x << 16); v0[1] = __builtin_bit_cast(float, w.x & 0xffff0000u); v0[2] = __builtin_bit_cast(float, w.y << 16); v0[3] = __builtin_bit_cast(float, w.y & 0xffff0000u);
    v1[0] = __builtin_bit_cast(float, w.z << 16); v1[1] = __builtin_bit_cast(float, w.z & 0xffff0000u); v1[2] = __builtin_bit_cast(float, w.w << 16); v1[3] = __builtin_bit_cast(float, w.w & 0xffff0000u); }
__device__ __forceinline__ unsigned q8(f32x4 v) { const unsigned a = (unsigned)(sigmoidf_(v[0]) * 255.f + 0.5f), b = (unsigned)(sigmoidf_(v[1]) * 255.f + 0.5f), c = (unsigned)(sigmoidf_(v[2]) * 255.f + 0.5f), d = (unsigned)(sigmoidf_(v[3]) * 255.f + 0.5f);
    return a | (b << 8) | (c << 16) | (d << 24); }
__device__ __forceinline__ unsigned q8n(f32x4 a, float ns) { unsigned q[4];
#pragma unroll
    for (int i = 0; i < 4; ++i) q[i] = (unsigned)__builtin_fmaf(__builtin_amdgcn_rcpf(1.0f + __builtin_amdgcn_exp2f(a[i] * ns)), 255.f, 0.5f);
    return q[0] | (q[1] << 8) | (q[2] << 16) | (q[3] << 24); }
__device__ __forceinline__ f32x4 uq8(unsigned w) { f32x4 o; o[0] = (float)(w & 0xffu); o[1] = (float)((w >> 8) & 0xffu); o[2] = (float)((w >> 16) & 0xffu); o[3] = (float)(w >> 24); return o; }
__device__ __forceinline__ f32x4 sig4(f32x4 v) { f32x4 o; o[0] = sigmoidf_(v[0]); o[1] = sigmoidf_(v[1]); o[2] = sigmoidf_(v[2]); o[3] = sigmoidf_(v[3]); return o; }

struct EpiG1 {
    static constexpr bool PERM = true, AFTER_DRAIN = false, APERM = false;
    const float* r1; bf16 *Q, *K, *U; unsigned char *SGNA, *SGSSM; int pn0;
    __device__ __forceinline__ void operator()(const f32x4 (&acc)[2][2][4][2], const pg8::Unit& u0, int wr, int wc, int fr, int fq) const {
        const pg8::Unit u{u0.pm, u0.pn + pn0};
        const int seg = u.pn < 4 ? 0 : (u.pn < 8 ? 1 : (u.pn < 12 ? 2 : (u.pn < 20 ? 3 : 4)));
        float rsv[2][4];
#pragma unroll
        for (int ai = 0; ai < 2; ++ai)
#pragma unroll
            for (int m = 0; m < 4; ++m) rsv[ai][m] = r1[u.pm * 256 + ai * 128 + wr * 64 + m * 16 + fr];
#pragma unroll
        for (int ai = 0; ai < 2; ++ai)
#pragma unroll
            for (int m = 0; m < 4; ++m) { const int row = u.pm * 256 + ai * 128 + wr * 64 + m * 16 + fr; const float rs = rsv[ai][m]; unsigned gq[4];
#pragma unroll
                for (int bj = 0; bj < 2; ++bj) { const int c0 = u.pn * 256 + bj * 128 + wc * 32 + 8 * fq; f32x4 v0 = acc[ai][bj][m][0] * rs, v1 = acc[ai][bj][m][1] * rs;
                    if (seg == 0) { v0 = v0 * 0.125f; v1 = v1 * 0.125f; *(v4u*)(Q + (size_t)row * 1024 + c0) = pack8(v0, v1); }
                    else if (seg == 1) { const int c = c0 - 1024, hh = c >> 6, d0 = c & 63, bb = row >> 12, tt = row & 4095;
                        *(v4u*)(K + ((((((size_t)(bb * 16 + hh) * 64 + (tt >> 6)) * 8 + ((tt & 63) >> 3)) * 2 + (d0 >> 5)) * 4 + ((d0 >> 3) & 3)) * 8 + (tt & 7)) * 8) = pack8(v0, v1); }
                    else if (seg == 2) { const int cu = c0 - 2048, g = cu >> 4, b = row >> 12, t = row & 4095; *(v4u*)(U + ((size_t)(b * 64 + g) * LPOS + 16 + t) * 16 + (cu & 15)) = pack8(v0, v1); }
                    else { gq[2 * bj] = q8(v0); gq[2 * bj + 1] = q8(v1); } }
                if (seg >= 3) { v4u w; w.x = gq[0]; w.y = gq[1]; w.z = gq[2]; w.w = gq[3]; *(v4u*)((seg == 3 ? SGNA + (u.pn - 12) * 256 : SGSSM + (u.pn - 20) * 256) + (size_t)row * 2048 + 64 * wc + 16 * fq) = w; } }
    }
};
struct EpiQKG {
    static constexpr bool PERM = true, AFTER_DRAIN = false, APERM = false;
    const float* r1; bf16 *Q, *K; unsigned char *SGNA, *SGSSM;
    __device__ __forceinline__ void operator()(const f32x4 (&acc)[2][2][4][2], const pg8::Unit& u, int wr, int wc, int fr, int fq) const {
        float rsv[2][4];
#pragma unroll
        for (int ai = 0; ai < 2; ++ai)
#pragma unroll
            for (int m = 0; m < 4; ++m) rsv[ai][m] = r1[u.pm * 256 + ai * 128 + wr * 64 + m * 16 + fr];
        if (u.pn >= 8) {
            unsigned char* dst = (u.pn < 16 ? SGNA + (u.pn - 8) * 256 : SGSSM + (u.pn - 16) * 256) + 64 * wc + 16 * fq;
#pragma unroll
            for (int ai = 0; ai < 2; ++ai)
#pragma unroll
                for (int m = 0; m < 4; ++m) { const int row = u.pm * 256 + ai * 128 + wr * 64 + m * 16 + fr; const float ns = rsv[ai][m] * (-1.4426950408889634f / 64.f);
                    v4u w; w.x = q8n(acc[ai][0][m][0], ns); w.y = q8n(acc[ai][0][m][1], ns); w.z = q8n(acc[ai][1][m][0], ns); w.w = q8n(acc[ai][1][m][1], ns);
                    *(v4u*)(dst + (size_t)row * 2048) = w; }
        } else {
#pragma unroll
            for (int ai = 0; ai < 2; ++ai)
#pragma unroll
                for (int m = 0; m < 4; ++m) { const int row = u.pm * 256 + ai * 128 + wr * 64 + m * 16 + fr; const float rs = rsv[ai][m] * (1.0f / 64.f);
#pragma unroll
                    for (int bj = 0; bj < 2; ++bj) { const int c0 = u.pn * 256 + bj * 128 + wc * 32 + 8 * fq;
                        if (u.pn < 4) { const float qs = rs * 0.125f; *(v4u*)(Q + (size_t)row * 1024 + c0) = pack8(acc[ai][bj][m][0] * qs, acc[ai][bj][m][1] * qs); }
                        else { const int c = c0 - 1024, hh = c >> 6, d0 = c & 63, bb = row >> 12, tt = row & 4095;
                            *(v4u*)(K + ((((((size_t)(bb * 16 + hh) * 64 + (tt >> 6)) * 8 + ((tt & 63) >> 3)) * 2 + (d0 >> 5)) * 4 + ((d0 >> 3) & 3)) * 8 + (tt & 7)) * 8) = pack8(acc[ai][bj][m][0] * rs, acc[ai][bj][m][1] * rs); } } }
        }
    }
};
struct EpiGate {
    static constexpr bool PERM = true, AFTER_DRAIN = false, APERM = false;
    const float* r1; unsigned char *SGNA, *SGSSM;
    __device__ __forceinline__ void operator()(const f32x4 (&acc)[2][2][4][2], const pg8::Unit& u, int wr, int wc, int fr, int fq) const {
        float rsv[2][4];
#pragma unroll
        for (int ai = 0; ai < 2; ++ai)
#pragma unroll
            for (int m = 0; m < 4; ++m) rsv[ai][m] = r1[u.pm * 256 + ai * 128 + wr * 64 + m * 16 + fr];
        unsigned char* dst = (u.pn < 8 ? SGNA + u.pn * 256 : SGSSM + (u.pn - 8) * 256) + 64 * wc + 16 * fq;
#pragma unroll
        for (int ai = 0; ai < 2; ++ai)
#pragma unroll
            for (int m = 0; m < 4; ++m) { const int row = u.pm * 256 + ai * 128 + wr * 64 + m * 16 + fr; const float ns = rsv[ai][m] * (-1.4426950408889634f / 64.f);
                v4u w; w.x = q8n(acc[ai][0][m][0], ns); w.y = q8n(acc[ai][0][m][1], ns); w.z = q8n(acc[ai][1][m][0], ns); w.w = q8n(acc[ai][1][m][1], ns);
                *(v4u*)(dst + (size_t)row * 2048) = w; }
    }
};
struct EpiVt {
    static constexpr bool PERM = true, AFTER_DRAIN = false, APERM = false;
    const float* r1; bf16* VT;
    __device__ __forceinline__ void operator()(const f32x4 (&acc)[2][2][4][2], const pg8::Unit& u, int wr, int wc, int fr, int fq) const {
#pragma unroll
        for (int bj = 0; bj < 2; ++bj) { const int c0 = u.pn * 256 + bj * 128 + wc * 32 + 8 * fq; const f32x4 s0 = *(const f32x4*)(r1 + c0) * (1.0f / 64.f), s1 = *(const f32x4*)(r1 + c0 + 4) * (1.0f / 64.f);
#pragma unroll
            for (int ai = 0; ai < 2; ++ai)
#pragma unroll
                for (int m = 0; m < 4; ++m) { const int row = u.pm * 256 + ai * 128 + wr * 64 + m * 16 + fr, bb = c0 >> 12, tt = c0 & 4095;
                    *(v4u*)(VT + (((((size_t)(bb * 16 + (row >> 6)) * 64 + (tt >> 6)) * 4 + ((row >> 2) & 3)) * 8 + ((tt & 63) >> 3)) * 16 + (((row >> 4) & 3) * 4 + (row & 3))) * 8) = pack8(acc[ai][bj][m][0] * s0, acc[ai][bj][m][1] * s1); } }
    }
};
struct EpiGlu {
    static constexpr bool PERM = true, AFTER_DRAIN = false, APERM = false;
    const bf16* YG; bf16* S;
    __device__ __forceinline__ void operator()(const f32x4 (&acc)[2][2][4][2], const pg8::Unit& u, int wr, int wc, int fr, int fq) const {
#pragma unroll
        for (int ai = 0; ai < 2; ++ai)
#pragma unroll
            for (int m = 0; m < 4; ++m) { const int row = u.pm * 256 + ai * 128 + wr * 64 + m * 16 + fr;
#pragma unroll
                for (int bj = 0; bj < 2; ++bj) { const int c0 = u.pn * 256 + bj * 128 + wc * 32 + 8 * fq; f32x4 y0, y1; unpack8(*(const v4u*)(YG + (size_t)row * 1024 + c0), y0, y1);
                    *(v4u*)(S + (size_t)row * 1024 + c0) = pack8(y0 * sig4(acc[ai][bj][m][0]), y1 * sig4(acc[ai][bj][m][1])); } }
    }
};
template <bool ADD> struct EpiMix {
    static constexpr bool PERM = true, AFTER_DRAIN = false, APERM = false;
    const unsigned char* GATE; bf16* MIX; float asc;
    __device__ __forceinline__ void operator()(const f32x4 (&acc)[2][2][4][2], const pg8::Unit& u, int wr, int wc, int fr, int fq) const {
#pragma unroll
        for (int ai = 0; ai < 2; ++ai)
#pragma unroll
            for (int m = 0; m < 4; ++m) { const int row = u.pm * 256 + ai * 128 + wr * 64 + m * 16 + fr;
                const v4u gw = *(const v4u*)(GATE + (size_t)row * 2048 + u.pn * 256 + 64 * wc + 16 * fq);
#pragma unroll
                for (int bj = 0; bj < 2; ++bj) { const int c0 = u.pn * 256 + bj * 128 + wc * 32 + 8 * fq;
                    f32x4 v0 = uq8(bj ? gw.z : gw.x) * (acc[ai][bj][m][0] * asc), v1 = uq8(bj ? gw.w : gw.y) * (acc[ai][bj][m][1] * asc);
                    if (ADD) { f32x4 p0, p1; unpack8(*(const v4u*)(MIX + (size_t)row * 2048 + c0), p0, p1); v0 = v0 + p0; v1 = v1 + p1; }
                    *(v4u*)(MIX + (size_t)row * 2048 + c0) = pack8(v0, v1); } }
    }
};

template <bool H2> struct EpiRes {
    static constexpr bool PERM = true, AFTER_DRAIN = false, APERM = false;
    const bf16* baseb; bf16* outb; float* rowsq;
    __device__ __forceinline__ void operator()(const f32x4 (&acc)[2][2][4][2], const pg8::Unit& u, int wr, int wc, int fr, int fq) const {
#pragma unroll
        for (int ai = 0; ai < 2; ++ai)
#pragma unroll
            for (int m = 0; m < 4; ++m) { const int row = u.pm * 256 + ai * 128 + wr * 64 + m * 16 + fr; float ss = 0.f;
#pragma unroll
                for (int bj = 0; bj < 2; ++bj) { const size_t off = (size_t)row * 2048 + u.pn * 256 + bj * 128 + wc * 32 + 8 * fq;
                    f32x4 v0, v1; unpack8(*(const v4u*)(baseb + off), v0, v1);
                    v0 = v0 + acc[ai][bj][m][0]; v1 = v1 + acc[ai][bj][m][1];
                    *(v4u*)(outb + off) = pack8(v0, v1);
                    ss += (v0[0] * v0[0] + v0[1] * v0[1]) + (v0[2] * v0[2] + v0[3] * v0[3]) + (v1[0] * v1[0] + v1[1] * v1[1]) + (v1[2] * v1[2] + v1[3] * v1[3]); }
                ss += __shfl_xor(ss, 16); ss += __shfl_xor(ss, 32);
                if (fq == 0) atomicAdd(rowsq + row, ss); }
    }
};
struct EpiUp {
    static constexpr bool PERM = true, AFTER_DRAIN = false, APERM = true;
    const float* rowsq; const float* convw; const float* convb; bf16* ACT; float *EA, *EP, *EG; LAS unsigned char* ex;
    __device__ __forceinline__ void operator()(const f32x4 (&acc)[2][2][4][2], const pg8::Unit& u, int wr, int wc, int fr, int fq) const {
        const int ja0 = u.pn * 128 + wc * 32 + 8 * fq;
        LAS f32x4* EX = (LAS f32x4*)ex;
        float r2[2][4];
#pragma unroll
        for (int ai = 0; ai < 2; ++ai) { const f32x4 rq = *(const f32x4*)(rowsq + u.pm * 256 + ai * 128 + wr * 64 + 4 * fr);
#pragma unroll
            for (int m = 0; m < 4; ++m) r2[ai][m] = __builtin_amdgcn_rsqf(rq[m] * (1.0f / DM) + EPS); }
#pragma unroll
        for (int ai = 0; ai < 2; ++ai)
#pragma unroll
            for (int n = 0; n < 2; ++n) { const int e = (((2 * ai + wr) * 2) * 4 + wc) * 8 + fq * 2 + n;
                if (fr == 0) EX[e] = acc[ai][0][0][n] * r2[ai][0];
                if (fr == 15) EX[e + 32] = acc[ai][0][3][n] * r2[ai][3]; }
        __syncthreads();
#pragma unroll
        for (int ai = 0; ai < 2; ++ai) {
            const int row0 = u.pm * 256 + ai * 128 + wr * 64 + 4 * fr, blk = 2 * ai + wr;
            const bool has_up = blk > 0, has_dn = blk < 3;
            v2u wq[2][4];
#pragma unroll
            for (int n = 0; n < 2; ++n) {
                const int ja = ja0 + 4 * n;
                const f32x4 w0 = *(const f32x4*)(convw + ja), w1 = *(const f32x4*)(convw + DFF + ja), w2 = *(const f32x4*)(convw + 2 * DFF + ja), cb = *(const f32x4*)(convb + ja);
                f32x4 upn = {0.f, 0.f, 0.f, 0.f}, dnn = {0.f, 0.f, 0.f, 0.f};
                if (has_up) upn = EX[((((blk - 1) * 2 + 1) * 4 + wc) * 8) + fq * 2 + n];
                if (has_dn) dnn = EX[((((blk + 1) * 2) * 4 + wc) * 8) + fq * 2 + n];
                f32x4 av[4], gv[4], cv[4];
#pragma unroll
                for (int m = 0; m < 4; ++m) { av[m] = acc[ai][0][m][n] * r2[ai][m]; gv[m] = acc[ai][1][m][n] * r2[ai][m]; }
#pragma unroll
                for (int i = 0; i < 4; ++i) {
                    float up0 = dpp0<0x111>(av[3][i]), dn3 = dpp0<0x101>(av[0][i]);
                    if (fr == 0) up0 = upn[i];
                    if (fr == 15) dn3 = dnn[i];
                    cv[0][i] = __builtin_fmaf(w2[i], av[1][i], __builtin_fmaf(w0[i], up0, __builtin_fmaf(w1[i], av[0][i], cb[i])));
                    cv[1][i] = __builtin_fmaf(w2[i], av[2][i], __builtin_fmaf(w0[i], av[0][i], __builtin_fmaf(w1[i], av[1][i], cb[i])));
                    cv[2][i] = __builtin_fmaf(w2[i], av[3][i], __builtin_fmaf(w0[i], av[1][i], __builtin_fmaf(w1[i], av[2][i], cb[i])));
                    cv[3][i] = __builtin_fmaf(w2[i], dn3, __builtin_fmaf(w0[i], av[2][i], __builtin_fmaf(w1[i], av[3][i], cb[i])));
                }
                if (!has_up && fr == 0) { const size_t eo = (size_t)(u.pm * 8) * DFF + ja; *(f32x4*)(EA + eo) = av[0]; *(f32x4*)(EP + eo) = cv[0]; *(f32x4*)(EG + eo) = gv[0]; }
                if (!has_dn && fr == 15) { const size_t eo = (size_t)(u.pm * 8 + 7) * DFF + ja; *(f32x4*)(EA + eo) = av[3]; *(f32x4*)(EP + eo) = cv[3]; *(f32x4*)(EG + eo) = gv[3]; }
#pragma unroll
                for (int m = 0; m < 4; ++m) { wq[n][m].x = cvtpk(gelu_tanh(cv[m][0]) * gv[m][0], gelu_tanh(cv[m][1]) * gv[m][1]); wq[n][m].y = cvtpk(gelu_tanh(cv[m][2]) * gv[m][2], gelu_tanh(cv[m][3]) * gv[m][3]); }
            }
#pragma unroll
            for (int m = 0; m < 4; ++m) { const bool edge = (m == 0 && fr == 0 && !has_up) || (m == 3 && fr == 15 && !has_dn);
                if (!edge) { v4u w; w.x = wq[0][m].x; w.y = wq[0][m].y; w.z = wq[1][m].x; w.w = wq[1][m].y; *(v4u*)(ACT + (size_t)(row0 + m) * DFF + ja0) = w; } }
        }
    }
};


__device__ __forceinline__ void p1_meta(Frame& F) {
    const int lane = F.lane, lr = lane & 15, lg = lane >> 4;
    for (int cb0 = F.vcu; cb0 < 256; cb0 += F.G) {
        const int cb = cb0 + 256 * (F.wave >> 2), c16 = 16 * cb; const bool isu = c16 >= 2048 && c16 < 3072;
        const void* bt = isu ? (const void*)(WSP(bf16, WS_WIN) + (size_t)c16 * DM)
                             : (const void*)(c16 >= 7168 ? OUTP(unsigned char, OUT_WV8) + (size_t)(c16 - 7168) * DM : OUTP(unsigned char, OUT_W8) + (size_t)(c16 < 2048 ? c16 : c16 - 1024) * DM);
        const f32x4 acc = meta_nt16_pair<DM>(F, SMP(bf16, SM_XBM), DM, bt, DM, !isu);
        if ((F.wave & 3) != 0) continue;
        const float* r1m = SMP(float, SM_R1M);
        const int col = 16 * cb + lr; const float wsc = isu ? 1.0f : (1.0f / 64.f);
#pragma unroll
        for (int r = 0; r < 4; ++r) { const int j = 4 * lg + r; const float v = acc[r] * (r1m[j] * wsc);
            if (col < 1024) { if (j == 15) SMP(float, SM_Q15)[col] = v * 0.125f; }
            else if (col < 2048) SMP(bf16, SM_KM)[j * 1024 + (col - 1024)] = (bf16)f2bf(v);
            else if (col < 3072) { const int cu = col - 2048, g = cu >> 4; const bf16 h = (bf16)f2bf(v);
#pragma unroll
                for (int b = 0; b < NB; ++b) WSP(bf16, WS_U)[((size_t)(b * 64 + g) * LPOS + j) * 16 + (cu & 15)] = h; }
            else if (col < 5120) { if (j == 15) SMP(float, SM_SGNA15)[col - 3072] = sigmoidf_(v); }
            else if (col < 7168) { if (j == 15) SMP(float, SM_SGSSM15)[col - 5120] = sigmoidf_(v); }
            else { bf16* vm = SMP(bf16, SM_VMT) + (size_t)(col - 7168) * 32; vm[j] = (bf16)f2bf(v); vm[16 + j] = 0; } }
    }
}
__device__ __forceinline__ void p2_meta_attn(Frame& F, int h) {
    const int lane = F.lane, j = lane & 15, part = lane >> 4;
    const f32x4* q4 = (const f32x4*)(SMP(float, SM_Q15) + h * 64 + 16 * part); const v4u* k4 = (const v4u*)(SMP(bf16, SM_KM) + j * 1024 + h * 64 + 16 * part);
    const f32x4 qa = q4[0], qb = q4[1], qc = q4[2], qd = q4[3]; const v4u ka = k4[0], kb = k4[1];
    f32x4 k0, k1, k2, k3; unpack8(ka, k0, k1); unpack8(kb, k2, k3);
    const f32x4 pr = qa * k0 + qb * k1 + qc * k2 + qd * k3;
    float s = (pr[0] + pr[1]) + (pr[2] + pr[3]);
    s += __shfl_xor(s, 16); s += __shfl_xor(s, 32);
    float mx = s;
#pragma unroll
    for (int o = 1; o < 16; o <<= 1) mx = fmaxf(mx, __shfl_xor(mx, o));
    float p = __expf(s - mx), sum = p;
#pragma unroll
    for (int o = 1; o < 16; o <<= 1) sum += __shfl_xor(sum, o);
    p = p / sum;
    const v4u* v4 = (const v4u*)(SMP(bf16, SM_VMT) + (size_t)(h * 64 + lane) * 32); const v4u va = v4[0], vb = v4[1];
    f32x4 v0, v1, v2, v3; unpack8(va, v0, v1); unpack8(vb, v2, v3);
    float o = 0.f;
#pragma unroll
    for (int k = 0; k < 4; ++k) { o += __shfl(p, k) * v0[k] + __shfl(p, 4 + k) * v1[k] + __shfl(p, 8 + k) * v2[k] + __shfl(p, 12 + k) * v3[k]; }
    const bf16 ob = (bf16)f2bf(o);
#pragma unroll
    for (int b = 0; b < NB; ++b) SMP(bf16, SM_AO15)[b * 1024 + h * 64 + lane] = ob;
}
__device__ __forceinline__ void p3a_meta(Frame& F) {
    const int lane = F.lane, lr = lane & 15, lg = lane >> 4;
    for (int cb = F.vcu; cb < 64; cb += F.G) {
        const f32x4 acc = meta_nt16<1024>(F, SMP(bf16, SM_AYG15), 1024, WSP(bf16, WS_WGLU) + (size_t)(16 * cb) * 1024, 1024);
        if (F.wave != 0) continue;
#pragma unroll
        for (int r = 0; r < 4; ++r) { const int i = 4 * lg + r, col = 16 * cb + lr; const float y = bf2f(SMP(bf16, SM_AYG15)[i * 1024 + col]); SMP(bf16, SM_AS15)[i * 1024 + col] = (bf16)f2bf(y * sigmoidf_(acc[r])); }
    }
}
__device__ __forceinline__ void p3b_meta(Frame& F) {
    const int lane = F.lane, lr = lane & 15, lg = lane >> 4;
    for (int cb = F.vcu; cb < 128; cb += F.G) {
        f32x4 a2 = {0.f, 0.f, 0.f, 0.f};
        const bool hi = (F.wave >> 2) != 0;
        f32x4 a1 = meta_nt16_pair<1024>(F, hi ? SMP(bf16, SM_AS15) : SMP(bf16, SM_AO15), 1024, hi ? (const void*)(WSP(bf16, WS_WSSM) + (size_t)(16 * cb) * 1024) : (const void*)(OUTP(unsigned char, OUT_WNA8) + (size_t)(16 * cb) * 1024), 1024, !hi, &a2);
        if (F.wave != 0) continue;
        a1 = a1 * (1.0f / 64.f);
        const int col = 16 * cb + lr; const float gn = SMP(float, SM_SGNA15)[col], gs = SMP(float, SM_SGSSM15)[col];
#pragma unroll
        for (int r = 0; r < 4; ++r) { const int i = 4 * lg + r; SMP(bf16, SM_AMIX15)[i * 2048 + col] = (bf16)f2bf(gn * a1[r] + gs * a2[r]); }
    }
}
__device__ __forceinline__ void p3c_meta(Frame& F) {
    const int lane = F.lane, lr = lane & 15, lg = lane >> 4;
    for (int cb = F.vcu; cb < 128; cb += F.G) {
        const f32x4 acc = meta_nt16<2048>(F, SMP(bf16, SM_AMIX15), 2048, WSP(bf16, WS_WOUT) + (size_t)(16 * cb) * 2048, 2048);
        if (F.wave != 0) continue;
        const int col = 16 * cb + lr; const float mt = F.in[IN_META][15 * DM + col];
#pragma unroll
        for (int r = 0; r < 4; ++r) { const int i = 4 * lg + r; const float v = mt + acc[r]; SMP(bf16, SM_AH2B15)[i * 2048 + col] = (bf16)f2bf(v);
            float ss = v * v;
#pragma unroll
            for (int o = 1; o < 16; o <<= 1) ss += __shfl_xor(ss, o);
            if (lr == 0 && i < NB) atomicAdd((float*)(F.ws + WS_CTL + CTL_ROWSQM) + i, ss); }
    }
}
__device__ __forceinline__ void p4_meta(Frame& F) {
    const int lane = F.lane, lr = lane & 15, lg = lane >> 4;
    for (int cb0 = F.vcu; cb0 < DFF / 32; cb0 += F.G) {
        const int cb = cb0 + (DFF / 32) * (F.wave >> 2), j0 = 16 * cb, wrow = 256 * (j0 >> 7) + (j0 & 127);
        const f32x4 acc = meta_nt16_pair<2048>(F, SMP(bf16, SM_AH2B15), 2048, WSP(bf16, WS_WUP) + (size_t)wrow * 2048, 2048, false);
        if ((F.wave & 3) != 0) continue;
        if (lg == 0) {
#pragma unroll
            for (int r = 0; r < 4; ++r) { const float r2 = 1.0f / sqrtf(((const float*)(F.ws + WS_CTL + CTL_ROWSQM))[r] * (1.0f / DM) + EPS); SMP(float, SM_A15)[r * DFF + j0 + lr] = acc[r] * r2; } }
    }
}

constexpr int NA_K_OFF = 8 * 9216, NA_RPB_OFF = NA_K_OFF + 9 * 8192;
__device__ __forceinline__ void na_prefetch(Frame& F, int gi, v4u (&k)[9], float (&bs)[2]) {
    const int r0 = (2 * gi) & 63, h = (gi >> 5) & 15, b = gi >> 9, rs0 = min(max(r0 - 4, 0), 56);
    const unsigned char* src = (const unsigned char*)(WSP(bf16, WS_K) + (size_t)((b * 16 + h) * 64 + rs0) * 4096) + F.tid * 16;
#pragma unroll
    for (int i = 0; i < 9; ++i) k[i] = *(const v4u*)(src + i * 8192);
#pragma unroll
    for (int q = 0; q < 2; ++q) { const int e = F.tid + 512 * q, x = (e & 63) - 16; bs[q] = (e < 960 && x >= 0 && x < 31) ? F.in[IN_RPB][(h * 15 + (e >> 6)) * 31 + x] : 0.f; }
}
__device__ __forceinline__ void na_commit(Frame& F, const v4u (&k)[9], const float (&bs)[2]) {
#pragma unroll
    for (int i = 0; i < 9; ++i) *(LAS v4u*)(F.lds + NA_K_OFF + i * 8192 + F.tid * 16) = k[i];
#pragma unroll
    for (int q = 0; q < 2; ++q) { const int e = F.tid + 512 * q; if (e < 960) ((LAS float*)(F.lds + NA_RPB_OFF))[e] = bs[q]; }
}
__device__ __forceinline__ void na_qload(Frame& F, int gi, bf16x8 (&qf)[2]) {
    const int qb = F.wave & 3, r = ((2 * gi) & 63) + (F.wave >> 2), h = (gi >> 5) & 15, b = gi >> 9;
    const bf16* Qp = WSP(bf16, WS_Q) + ((size_t)(b * SEQ + r * 64 + 16 * qb) * 1024 + h * 64);
    qf[0] = ldfrag(Qp, 1024, F.lane); qf[1] = ldfrag(Qp + 32, 1024, F.lane);
}
__device__ __forceinline__ void na_task(Frame& F, int gi, LAS bf16* P  , const v4u (&kpre)[9], const float (&bpre)[2], bf16x8 (&qf)[2], bool has_next) {
    const int qb = F.wave & 3, r0 = (2 * gi) & 63, r = r0 + (F.wave >> 2), h = (gi >> 5) & 15, b = gi >> 9;
    const int lane = F.lane, lr = lane & 15, lg = lane >> 4;
    const int w0 = (qb == 0) ? 0 : (qb == 1) ? 8 : (qb == 2) ? 24 : 32;
    const int rs = min(max(r - 4, 0), 56), rs0 = min(max(r0 - 4, 0), 56);
    const int cq = 16 * qb + lr, cs = min(max(cq - 8, 0), 48);
    const bf16x8 qf0 = qf[0], qf1 = qf[1];
    const LAS float* rpb = (const LAS float*)(F.lds + NA_RPB_OFF) + (rs - r + 7) * 64 + 16 + (w0 + 4 * lg - cq + 15);
    bool vld[2][4];
#pragma unroll
    for (int hf = 0; hf < 2; ++hf)
#pragma unroll
        for (int i = 0; i < 4; ++i) vld[hf][i] = (unsigned)(w0 + 16 * hf + 4 * lg + i - cs) < 16u;
    const LAS unsigned char* Kb = F.lds + NA_K_OFF + (rs - rs0) * 8192 + ((w0 >> 3) + (lr >> 3)) * 1024 + lg * 128 + (lr & 7) * 16;
    const bf16* Km = SMP(bf16, SM_KM) + lr * 1024 + h * 64 + 8 * lg;
    const bf16* Vb = WSP(bf16, WS_VT) + ((size_t)((b * 16 + h) * 64 + rs) * 4096 + ((w0 >> 3) + lg) * 128 + lr * 8);
    const bf16* Vm = SMP(bf16, SM_VMT) + (size_t)(h * 64 + 16 * (lr >> 2) + (lr & 3)) * 32 + 8 * lg;
#define NA_KLD(t, ks) (*(const LAS bf16x8*)(Kb + (((t) >> 1) * 8192 + ((t) & 1) * 2048 + (ks) * 512)))
#define NA_SB() __builtin_amdgcn_sched_barrier(0)
    f32x4 s[17];
#define NA_TILE(t, f0, f1) do { f32x4 a_ = {0.f, 0.f, 0.f, 0.f}; a_ = MFMA16((f0), qf0, a_); a_ = MFMA16((f1), qf1, a_); \
        _Pragma("unroll") for (int i = 0; i < 4; ++i) { float bias = rpb[((t) >> 1) * 64 + 16 * ((t) & 1) + i]; asm volatile("" : "+v"(bias)); s[t][i] = vld[(t) & 1][i] ? a_[i] + bias : -INFINITY; } } while (0)
    bf16x8 ka[8], kb[8]; const bf16x8 km0 = *(const bf16x8*)Km, km1 = *(const bf16x8*)(Km + 32);
#pragma unroll
    for (int t = 0; t < 4; ++t) { ka[2 * t] = NA_KLD(t, 0); ka[2 * t + 1] = NA_KLD(t, 1); }
#pragma unroll
    for (int t = 0; t < 4; ++t) { kb[2 * t] = NA_KLD(t + 4, 0); kb[2 * t + 1] = NA_KLD(t + 4, 1); }
    NA_SB();
#pragma unroll
    for (int t = 0; t < 4; ++t) NA_TILE(t, ka[2 * t], ka[2 * t + 1]);
    NA_SB();
#pragma unroll
    for (int t = 0; t < 4; ++t) { ka[2 * t] = NA_KLD(t + 8, 0); ka[2 * t + 1] = NA_KLD(t + 8, 1); }
    NA_SB();
#pragma unroll
    for (int t = 0; t < 4; ++t) NA_TILE(t + 4, kb[2 * t], kb[2 * t + 1]);
    NA_SB();
#pragma unroll
    for (int t = 0; t < 4; ++t) { kb[2 * t] = NA_KLD(t + 12, 0); kb[2 * t + 1] = NA_KLD(t + 12, 1); }
    NA_SB();
#pragma unroll
    for (int t = 0; t < 4; ++t) NA_TILE(t + 8, ka[2 * t], ka[2 * t + 1]);
    NA_SB();
#pragma unroll
    for (int t = 0; t < 4; ++t) NA_TILE(t + 12, kb[2 * t], kb[2 * t + 1]);
    { f32x4 a_ = {0.f, 0.f, 0.f, 0.f}; a_ = MFMA16(km0, qf0, a_); a_ = MFMA16(km1, qf1, a_); s[16] = a_; }
    LDS_WAIT(); __syncthreads();
    if (has_next) { na_commit(F, kpre, bpre); na_qload(F, gi + F.G, qf); }
    NA_SB();
    bf16x8 va[9], vb[9];
#pragma unroll
    for (int s8 = 0; s8 < 8; ++s8) { va[s8] = *(const bf16x8*)(Vb + s8 * 4096); vb[s8] = *(const bf16x8*)(Vb + 1024 + s8 * 4096); }
    va[8] = *(const bf16x8*)Vm; vb[8] = *(const bf16x8*)(Vm + 4 * 32);
    NA_SB();
    float mx = -INFINITY;
#pragma unroll
    for (int t = 0; t < 17; ++t) mx = fmaxf(mx, fmaxf(fmaxf(s[t][0], s[t][1]), fmaxf(s[t][2], s[t][3])));
    mx = fmaxf(mx, __shfl_xor(mx, 16)); mx = fmaxf(mx, __shfl_xor(mx, 32));
    float sum = 0.f;
#pragma unroll
    for (int t = 0; t < 17; ++t) {
#pragma unroll
        for (int i = 0; i < 4; ++i) { const float p = __expf(s[t][i] - mx); s[t][i] = p; sum += p; } }
    sum += __shfl_xor(sum, 16); sum += __shfl_xor(sum, 32);
    const float inv = 1.0f / sum;
#pragma unroll
    for (int t = 0; t < 17; ++t) { v2u w; w.x = cvtpk(s[t][0] * inv, s[t][1] * inv); w.y = cvtpk(s[t][2] * inv, s[t][3] * inv);
        *(LAS v2u*)(P + lr * 288 + t * 16 + 4 * lg) = w; }
    { v2u z; z.x = 0u; z.y = 0u; *(LAS v2u*)(P + lr * 288 + 272 + 4 * lg) = z; }
    LDS_WAIT(); asm volatile("" ::: "memory");
    unsigned char* Op = WSP(unsigned char, WS_O) + ((size_t)(b * SEQ + r * 64 + 16 * qb + lr) * 1024 + h * 64) + 16 * lg;
    unsigned ow[4];
    bf16x8 pf[9];
#pragma unroll
    for (int s8 = 0; s8 < 9; ++s8) pf[s8] = ldfrag_lds(P + 32 * s8, 288, lane);
#define NA_PV(db, vf) do { f32x4 o_ = {0.f, 0.f, 0.f, 0.f}; _Pragma("unroll") for (int s8 = 0; s8 < 9; ++s8) o_ = MFMA16(vf[s8], pf[s8], o_); \
        ow[db] = pk4_fp8(o_[0] * 16.f, o_[1] * 16.f, o_[2] * 16.f, o_[3] * 16.f); } while (0)
    NA_SB();
    NA_PV(0, va);
    NA_SB();
#pragma unroll
    for (int s8 = 0; s8 < 8; ++s8) va[s8] = *(const bf16x8*)(Vb + 2048 + s8 * 4096);
    va[8] = *(const bf16x8*)(Vm + 8 * 32);
    NA_SB();
    NA_PV(1, vb);
    NA_SB();
#pragma unroll
    for (int s8 = 0; s8 < 8; ++s8) vb[s8] = *(const bf16x8*)(Vb + 3072 + s8 * 4096);
    vb[8] = *(const bf16x8*)(Vm + 12 * 32);
    NA_SB();
    NA_PV(2, va);
    NA_SB();
    NA_PV(3, vb);
    { v4u w0; w0.x = ow[0]; w0.y = ow[1]; w0.z = ow[2]; w0.w = ow[3]; *(v4u*)Op = w0; }
    LDS_WAIT(); asm volatile("" ::: "memory");
#undef NA_KLD
#undef NA_TILE
#undef NA_PV
#undef NA_SB
}

typedef float f32x16 __attribute__((ext_vector_type(16)));
#define MFMA32(a, b, c) __builtin_amdgcn_mfma_f32_32x32x16_bf16((a), (b), (c), 0, 0, 0)
constexpr int S5_PP = 528;
constexpr int S5_A = 0, S5_B = 128 * S5_PP, S5_C = 2 * 128 * S5_PP, S5_TOT = S5_C + 8320, S5_M = S5_C + 17408;
constexpr int S5_L5 = S5_M, S5_X0 = S5_M + 5120, S5_XB0 = S5_X0 + 512, S5_U0 = S5_XB0 + 512;
static_assert(S5_U0 + 512 <= MISC_OFF, "S5 LDS map");
template <int BYTES> __device__ __forceinline__ void s5_copy(LAS unsigned char* dst, const unsigned char* src, int tid) {
    unsigned t16 = (unsigned)tid * 16u; asm volatile("" : "+v"(t16));
    constexpr int NIT = (BYTES + 8191) / 8192; v4u tmp[NIT];
#pragma unroll
    for (int i = 0; i < NIT; ++i) if (BYTES % 8192 == 0 || i < NIT - 1 || t16 + i * 8192u < (unsigned)BYTES) tmp[i] = *(const v4u*)(src + t16 + i * 8192u);
#pragma unroll
    for (int i = 0; i < NIT; ++i) if (BYTES % 8192 == 0 || i < NIT - 1 || t16 + i * 8192u < (unsigned)BYTES) *(LAS v4u*)(dst + t16 + i * 8192u) = tmp[i];
}
__device__ __forceinline__ void s5_copy_p(LAS unsigned char* dst, const unsigned char* src, int tid) {
    unsigned t16 = (unsigned)tid * 16u; asm volatile("" : "+v"(t16));
    v4u tmp[8];
#pragma unroll
    for (int i = 0; i < 8; ++i) tmp[i] = *(const v4u*)(src + t16 + i * 8192u);
#pragma unroll
    for (int i = 0; i < 8; ++i) { const unsigned o = t16 + i * 8192u; *(LAS v4u*)(dst + (o >> 9) * S5_PP + (o & 511)) = tmp[i]; }
}
#define S5_LOAD_UF(uf) bf16x8 uf[16]; { unsigned uo_ = (unsigned)(((1 + 32 * wv + r32) * 256 + 8 * h) * 2); asm volatile("" : "+v"(uo_)); const unsigned char* up_ = (const unsigned char*)Ug + uo_; \
    _Pragma("unroll") for (int ks = 0; ks < 16; ++ks) uf[ks] = *(const bf16x8*)(up_ + 32 * ks); }
template <int CTRL> __device__ __forceinline__ float s5_dpp(float x) { return __builtin_bit_cast(float, __builtin_amdgcn_update_dpp(0, __builtin_bit_cast(int, x), CTRL, 0xf, 0xf, false)); }
#define S5_PIN8(A, B, r0) asm volatile("" : "+v"(A[r0]), "+v"(A[r0 + 1]), "+v"(A[r0 + 2]), "+v"(A[r0 + 3]), "+v"(B[r0]), "+v"(B[r0 + 1]), "+v"(B[r0 + 2]), "+v"(B[r0 + 3]))
#define S5_FENCE(p, reg) do { if (((reg) & 3) == 3) { S5_PIN8(S[2 * (p)], S[2 * (p) + 1], (reg) - 3); if ((reg) < 15) S5_PIN8(S[2 * (p)], S[2 * (p) + 1], (reg) + 1); else if ((p) == 0) S5_PIN8(S[2], S[3], 0); } } while (0)
template <int dir> __device__ __forceinline__ void s5_dir(Frame& F, int g, const bf16* Ug, bf16x8 (&xf)[4][2]) {
    LAS unsigned char* L = F.lds;
    const int tid = F.tid, lane = F.lane, r32 = lane & 31, h = lane >> 5, fr = lane & 15, wv = F.wave;
    const unsigned char* ob = (const unsigned char*)F.out;
        s5_copy<8320>(L + S5_C, ob + OUT_CP + (size_t)(dir * 64 + g) * 9216, tid);
        __syncthreads();
        if (dir == 0) {
            const int rho = tid >> 2, qq = tid & 3; float acc = 0.f;
#pragma unroll
            for (int p8 = 0; p8 < 8; ++p8) { const int q = 8 * qq + p8; const v4u pw = *(const LAS v4u*)(L + S5_A + rho * S5_PP + (q << 4)), uw = *(const LAS v4u*)(L + S5_U0 + q * 16);
                acc += bf2f((bf16)(pw.x & 0xffff)) * bf2f((bf16)(uw.x & 0xffff)) + bf2f((bf16)(pw.x >> 16)) * bf2f((bf16)(uw.x >> 16)) + bf2f((bf16)(pw.y & 0xffff)) * bf2f((bf16)(uw.y & 0xffff)) + bf2f((bf16)(pw.y >> 16)) * bf2f((bf16)(uw.y >> 16))
                     + bf2f((bf16)(pw.z & 0xffff)) * bf2f((bf16)(uw.z & 0xffff)) + bf2f((bf16)(pw.z >> 16)) * bf2f((bf16)(uw.z >> 16)) + bf2f((bf16)(pw.w & 0xffff)) * bf2f((bf16)(uw.w & 0xffff)) + bf2f((bf16)(pw.w >> 16)) * bf2f((bf16)(uw.w >> 16)); }
            { int lo_ = lane; asm volatile("" : "+v"(lo_));
              acc += __builtin_bit_cast(float, __builtin_amdgcn_ds_bpermute((lo_ ^ 1) << 2, __builtin_bit_cast(int, acc))); acc += __builtin_bit_cast(float, __builtin_amdgcn_ds_bpermute((lo_ ^ 2) << 2, __builtin_bit_cast(int, acc))); }
            if (qq == 0) { const int part = (rho >> 5) & 1, n = (rho & 31) + 32 * (rho >> 6); ((LAS float*)(L + S5_X0))[part * 64 + n] = acc; }
        }
        f32x16 S[4];
#pragma unroll
        for (int rt = 0; rt < 4; ++rt) S[rt] = (f32x16){0.f,0.f,0.f,0.f,0.f,0.f,0.f,0.f,0.f,0.f,0.f,0.f,0.f,0.f,0.f,0.f};
        { unsigned pbo = (unsigned)((dir ? S5_B : S5_A) + r32 * S5_PP + h * 16); asm volatile("" : "+v"(pbo)); const LAS unsigned char* Pb = L + pbo; S5_LOAD_UF(uf)
#pragma unroll
          for (int ks = 0; ks < 16; ++ks) {
#pragma unroll
            for (int rt = 0; rt < 4; ++rt) S[rt] = MFMA32(*(const LAS bf16x8*)(Pb + rt * 32 * S5_PP + ks * 32), uf[ks], S[rt]); __builtin_amdgcn_sched_barrier(0); } }
        unsigned l5o = (unsigned)(S5_L5 + dir * 2560); asm volatile("" : "+v"(l5o)); const LAS float* L5 = (const LAS float*)(L + l5o); const LAS float* L5h = L5 + 8 * h;
#pragma unroll
        for (int p = 0; p < 2; ++p)
#pragma unroll
            for (int reg = 0; reg < 16; ++reg) { const int n = 32 * p + (reg & 3) + 8 * (reg >> 2);
#define S5_STEP(sstep) { constexpr int CT = (dir ? 0x100 : 0x110) | (1 << (sstep)); const f32x2 lam = *(const LAS f32x2*)(L5h + ((sstep) * 64 + n) * 2); \
                    const float tr = s5_dpp<CT>(S[2 * p][reg]), ti = s5_dpp<CT>(S[2 * p + 1][reg]); S[2 * p][reg] += lam.x * tr - lam.y * ti; S[2 * p + 1][reg] += lam.x * ti + lam.y * tr; }
                S5_STEP(0) S5_STEP(1) S5_STEP(2) S5_STEP(3)
#undef S5_STEP
                S5_FENCE(p, reg); }
        { unsigned tw = (unsigned)(S5_TOT + (2 * wv + (r32 >> 4)) * 512 + h * 16); asm volatile("" : "+v"(tw)); LAS float* tot = (LAS float*)(L + tw);
          if (fr == (dir ? 0 : 15)) {
#pragma unroll
            for (int p = 0; p < 2; ++p)
#pragma unroll
                for (int reg = 0; reg < 16; ++reg) { const int n = 32 * p + (reg & 3) + 8 * (reg >> 2); tot[n] = S[2 * p][reg]; tot[64 + n] = S[2 * p + 1][reg]; } } }
        __syncthreads();
        { unsigned toto = (unsigned)(S5_TOT + lane * 4), x0o = (unsigned)(S5_X0 + lane * 4); asm volatile("" : "+v"(toto), "+v"(x0o));
          const LAS float* tot = (const LAS float*)(L + toto); const f32x2 l256 = *(const LAS f32x2*)(L5 + (4 * 64 + lane) * 2);
          float wr_ = dir ? 0.f : ((const LAS float*)(L + x0o))[0], wi_ = dir ? 0.f : ((const LAS float*)(L + x0o))[64];
          float w0r = 0.f, w0i = 0.f, w1r = 0.f, w1i = 0.f;
          const int s0 = dir ? 2 * wv + 1 : 2 * wv, s1 = dir ? 2 * wv : 2 * wv + 1;
          for (int kk = 0; kk < 16; ++kk) { const int k = dir ? 15 - kk : kk;
              if (k == s0) { w0r = wr_; w0i = wi_; } if (k == s1) { w1r = wr_; w1i = wi_; }
              const float tr = tot[k * 128], ti = tot[k * 128 + 64];
              const float nr = l256.x * wr_ - l256.y * wi_ + tr, ni = l256.x * wi_ + l256.y * wr_ + ti; wr_ = nr; wi_ = ni; }
          if (dir == 1 && wv == 0) { ((LAS float*)(L + x0o))[128] = wr_; ((LAS float*)(L + x0o))[192] = wi_; }
          __syncthreads();
          LAS float* win = (LAS float*)(L + toto);
          win[s0 * 128] = w0r; win[s0 * 128 + 64] = w0i; win[s1 * 128] = w1r; win[s1 * 128 + 64] = w1i; }
        LDS_WAIT(); asm volatile("" ::: "memory");
        { unsigned wino = (unsigned)(S5_TOT + (2 * wv + (r32 >> 4)) * 512 + h * 16), cpo = (unsigned)(S5_C + fr * 520 + h * 32); asm volatile("" : "+v"(wino), "+v"(cpo));
          const LAS float* win = (const LAS float*)(L + wino); const LAS float* CP = (const LAS float*)(L + cpo);
#pragma unroll
          for (int p = 0; p < 2; ++p)
#pragma unroll
            for (int reg = 0; reg < 16; ++reg) { const int n = 32 * p + (reg & 3) + 8 * (reg >> 2);
                const float er = s5_dpp<(dir ? 0x100 : 0x110) | 1>(S[2 * p][reg]), ei = s5_dpp<(dir ? 0x100 : 0x110) | 1>(S[2 * p + 1][reg]);
                const f32x2 cp = *(const LAS f32x2*)(CP + 2 * n); const float wr_ = win[n], wi_ = win[64 + n];
                S[2 * p][reg] = er + cp.x * wr_ - cp.y * wi_; S[2 * p + 1][reg] = ei + cp.x * wi_ + cp.y * wr_; S5_FENCE(p, reg); }
#pragma unroll
          for (int rt = 0; rt < 4; ++rt)
#pragma unroll
            for (int s = 0; s < 2; ++s) { v4u w; w.x = cvtpk(S[rt][8 * s], S[rt][8 * s + 1]); w.y = cvtpk(S[rt][8 * s + 2], S[rt][8 * s + 3]); w.z = cvtpk(S[rt][8 * s + 4], S[rt][8 * s + 5]); w.w = cvtpk(S[rt][8 * s + 6], S[rt][8 * s + 7]);
                xf[rt][s] = __builtin_bit_cast(bf16x8, w); } }
        __syncthreads();
}
__device__ __forceinline__ void s5_block(Frame& F, int b, int g) {
    LAS unsigned char* L = F.lds;
    const int tid = F.tid, lane = F.lane, r32 = lane & 31, h = lane >> 5, fr = lane & 15, wv = F.wave;
    const unsigned char* ob = (const unsigned char*)F.out;
    const bf16* Ug = WSP(bf16, WS_U) + (size_t)(b * 64 + g) * LPOS * 16;
    s5_copy_p(L + S5_A, ob + OUT_P + (size_t)g * 65536, tid);
    s5_copy_p(L + S5_B, ob + OUT_P + (size_t)(64 + g) * 65536, tid);
    s5_copy<2560>(L + S5_L5, ob + OUT_L5 + (size_t)g * 2560, tid);
    s5_copy<2560>(L + S5_L5 + 2560, ob + OUT_L5 + (size_t)(64 + g) * 2560, tid);
    if (tid < 32) *(LAS v4u*)(L + S5_U0 + tid * 16) = *(const v4u*)((const unsigned char*)Ug + tid * 16);
    bf16x8 xf0[4][2], xf1[4][2];
    s5_dir<0>(F, g, Ug, xf0);
    s5_dir<1>(F, g, Ug, xf1);
    s5_copy<65536>(L + S5_A, ob + OUT_R + (size_t)g * 65536, tid);
    s5_copy<65536>(L + S5_B, ob + OUT_R + (size_t)(64 + g) * 65536, tid);
    s5_copy<8704>(L + S5_C, ob + OUT_KL + (size_t)g * 9216, tid);
    s5_copy<8704>(L + S5_C + 8704, ob + OUT_KL + (size_t)(64 + g) * 9216, tid);
    __syncthreads();
    { S5_LOAD_UF(uf)
#pragma unroll
    for (int hf = 0; hf < 4; ++hf) {
        f32x16 Y[2];
#pragma unroll
        for (int t2 = 0; t2 < 2; ++t2) Y[t2] = (f32x16){0.f,0.f,0.f,0.f,0.f,0.f,0.f,0.f,0.f,0.f,0.f,0.f,0.f,0.f,0.f,0.f};
#pragma unroll
        for (int t2 = 0; t2 < 2; ++t2) { const int RT = 2 * hf + t2;
            unsigned kfo = (unsigned)(S5_C + ((r32 & 15) * 16 + 8 * h) * 2 + (r32 >> 4) * 512), kbo = (unsigned)(S5_C + 8704 + ((r32 & 15) * 16 + 8 * h) * 2 - (r32 >> 4) * 512);
            asm volatile("" : "+v"(kfo), "+v"(kbo)); const LAS unsigned char* KLf = L + kfo; const LAS unsigned char* KLb = L + kbo;
#pragma unroll
            for (int ks = 0; ks < 16; ++ks) {
                if (ks <= 2 * RT + 1) Y[t2] = MFMA32(*(const LAS bf16x8*)(KLf + (2 * RT - ks + 1) * 512), uf[ks], Y[t2]);
                if (ks >= 2 * RT) Y[t2] = MFMA32(*(const LAS bf16x8*)(KLb + (ks - 2 * RT + 1) * 512), uf[ks], Y[t2]); __builtin_amdgcn_sched_barrier(0); }
            unsigned fx = (unsigned)((fr ^ h) << 4); asm volatile("" : "+v"(fx));
#pragma unroll
            for (int dir = 0; dir < 2; ++dir) { unsigned rbo = (unsigned)((dir ? S5_B : S5_A) + r32 * 256); asm volatile("" : "+v"(rbo)); const LAS unsigned char* Rb = L + rbo + RT * 8192;
#pragma unroll
                for (int rt = 0; rt < 4; ++rt)
#pragma unroll
                    for (int s = 0; s < 2; ++s) { Y[t2] = MFMA32(*(const LAS bf16x8*)(Rb + (((rt * 2 + s) * 32) ^ fx)), (dir ? xf1[rt][s] : xf0[rt][s]), Y[t2]); __builtin_amdgcn_sched_barrier(0); } } }
        const int chunk = 1 + 32 * wv + r32;
#pragma unroll
        for (int t2 = 0; t2 < 2; ++t2)
#pragma unroll
            for (int il = 0; il < 2; ++il) { const int pos = chunk * 16 + 2 * (2 * hf + t2) + il; bf16* yp = OUTP(bf16, OUT_YG) + (size_t)(b * SEQ + pos - 16) * 1024 + g * 16 + 4 * h;
#pragma unroll
                for (int cg = 0; cg < 2; ++cg) { const int r0 = 8 * il + 4 * cg; v2u w; w.x = cvtpk(gelu_tanh(Y[t2][r0]), gelu_tanh(Y[t2][r0 + 1])); w.y = cvtpk(gelu_tanh(Y[t2][r0 + 2]), gelu_tanh(Y[t2][r0 + 3]));
                    *(v2u*)(yp + 8 * cg) = w; } }
        __builtin_amdgcn_sched_barrier(0);
    } }
    if (tid < 256) {
        const int c = tid >> 4, q = tid & 15; float acc = 0.f;
        { const LAS unsigned char* kf = L + S5_C + ((16 - q) * 256 + c * 16) * 2; const LAS unsigned char* u0 = L + S5_U0 + q * 32;
#pragma unroll
          for (int e = 0; e < 16; ++e) acc += bf2f(*(const LAS bf16*)(kf + 2 * e)) * bf2f(*(const LAS bf16*)(u0 + 2 * e)); }
        if (q == 0) { const LAS unsigned char* kb = L + S5_C + 8704 + (1 * 256 + c * 16) * 2; const LAS unsigned char* u15 = L + S5_U0 + 15 * 32;
#pragma unroll
          for (int e = 0; e < 16; ++e) acc += bf2f(*(const LAS bf16*)(kb + 2 * e)) * bf2f(*(const LAS bf16*)(u15 + 2 * e)); }
        { const int row = 240 + c; const LAS unsigned char* rp = L + S5_B + row * 256 + ((q ^ (row & 15)) << 4); const LAS float* xb0 = (const LAS float*)(L + S5_XB0);
          const int rt = q >> 2, s = (q >> 1) & 1, hh = q & 1;
#pragma unroll
          for (int j = 0; j < 8; ++j) { const int sig = 16 * s + 8 * (j >> 2) + 4 * hh + (j & 3); acc += bf2f(*(const LAS bf16*)(rp + 2 * j)) * xb0[(rt & 1) * 64 + 32 * (rt >> 1) + sig]; } }
#pragma unroll
        for (int o = 1; o < 16; o <<= 1) acc += __shfl_xor(acc, o);
        if (q == 0) SMP(bf16, SM_AYG15)[b * 1024 + g * 16 + c] = (bf16)f2bf(gelu_tanh(acc));
    }
    __syncthreads();
}

__device__ __forceinline__ void p5_fixup_panel(Frame& F, int pm) {
    const float* EA = WSP(float, WS_EA); const float* EP = WSP(float, WS_EP); const float* EG = WSP(float, WS_EG);
    const float* cw = F.in[IN_CONVW]; bf16* ACT = WSP(bf16, WS_ACT);
    for (int j = F.tid * 4; j < DFF; j += NWAVES * 64 * 4) {
        const f32x4 w0 = *(const f32x4*)(cw + j), w2 = *(const f32x4*)(cw + 2 * DFF + j);
        f32x4 p[8], g[8], nb[8];
#pragma unroll
        for (int e = 0; e < 8; e += 7) { const int er = 8 * pm + e, eblk = er >> 1, side = er & 1, row = eblk * 64 + (side ? 63 : 0);
            p[e] = *(const f32x4*)(EP + (size_t)er * DFF + j); g[e] = *(const f32x4*)(EG + (size_t)er * DFF + j);
            if (!side) nb[e] = ((row & 4095) == 0) ? *(const f32x4*)(SMP(float, SM_A15) + (row >> 12) * DFF + j) : *(const f32x4*)(EA + (size_t)((eblk - 1) * 2 + 1) * DFF + j);
            else nb[e] = ((row & 4095) == 4095) ? (f32x4){0.f, 0.f, 0.f, 0.f} : *(const f32x4*)(EA + (size_t)((eblk + 1) * 2) * DFF + j); }
#pragma unroll
        for (int e = 0; e < 8; e += 7) { const int er = 8 * pm + e, row = (er >> 1) * 64 + ((er & 1) ? 63 : 0); const f32x4 v = p[e] + ((er & 1) ? w2 : w0) * nb[e];
            v2u w; w.x = cvtpk(gelu_tanh(v[0]) * g[e][0], gelu_tanh(v[1]) * g[e][1]); w.y = cvtpk(gelu_tanh(v[2]) * g[e][2], gelu_tanh(v[3]) * g[e][3]);
            *(v2u*)(ACT + (size_t)row * DFF + j) = w; }
    }
}
__device__ __forceinline__ void p7_final(Frame& F) {
    const float* rowsq = (const float*)(F.ws + WS_CTL + CTL_ROWSQ3); const f32x4* gf = (const f32x4*)F.in[IN_GF] + F.lane;
    for (int m = F.gw; m < M; m += 2 * F.NGW) {
        const int m2 = m + F.NGW;
        const float rs = 1.0f / sqrtf(rowsq[m] * (1.0f / DM) + EPS), rs2 = 1.0f / sqrtf(rowsq[m2] * (1.0f / DM) + EPS);
        const v2u* hr = (const v2u*)(WSP(bf16, WS_H3B) + (size_t)m * DM) + F.lane; const v2u* hr2 = (const v2u*)(WSP(bf16, WS_H3B) + (size_t)m2 * DM) + F.lane;
        f32x4* xr = (f32x4*)(F.out + (size_t)m * DM) + F.lane; f32x4* xr2 = (f32x4*)(F.out + (size_t)m2 * DM) + F.lane;
        v2u a[8], b[8];
#pragma unroll
        for (int j = 0; j < 8; ++j) { a[j] = hr[64 * j]; b[j] = hr2[64 * j]; }
#pragma unroll
        for (int j = 0; j < 8; ++j) { const f32x4 g = gf[64 * j];
            f32x4 va, vb; va[0] = __builtin_bit_cast(float, a[j].x << 16); va[1] = __builtin_bit_cast(float, a[j].x & 0xffff0000u); va[2] = __builtin_bit_cast(float, a[j].y << 16); va[3] = __builtin_bit_cast(float, a[j].y & 0xffff0000u);
            vb[0] = __builtin_bit_cast(float, b[j].x << 16); vb[1] = __builtin_bit_cast(float, b[j].x & 0xffff0000u); vb[2] = __builtin_bit_cast(float, b[j].y << 16); vb[3] = __builtin_bit_cast(float, b[j].y & 0xffff0000u);
            xr[64 * j] = va * rs * g; xr2[64 * j] = vb * rs2 * g; }
    }
}

#ifndef MK_N_LAUNCHES
#define MK_N_LAUNCHES 1
#endif
constexpr int N_PHASES = 10;
#ifndef GEMM_ALIGN
#define GEMM_ALIGN true
#endif
#ifndef GEMM_SP2
#define GEMM_SP2 true
#endif
struct Args { const float* in[23]; float* out; unsigned char* ws; int ph_lo, ph_hi, li, pad; };
__global__ void __launch_bounds__(NWAVES * 64, 2) skel_fwd(Args args) {
    extern __shared__ __attribute__((aligned(16))) unsigned char lds_raw[];
    Frame F;
    F.lds = (LAS unsigned char*)lds_raw;
    F.tid = threadIdx.x; F.lane = F.tid & 63; F.wave = __builtin_amdgcn_readfirstlane(F.tid >> 6);
    F.G = gridDim.x; { const int bx = blockIdx.x; F.vcu = (F.G % 8 == 0) ? (bx % 8) * (F.G / 8) + bx / 8 : bx; }
    F.gw = F.vcu * NWAVES + F.wave; F.NGW = F.G * NWAVES;
#pragma unroll
    for (int i = 0; i < 23; ++i) F.in[i] = args.in[i];
    F.out = args.out; F.ws = args.ws;
    volatile LAS unsigned* MISC = (volatile LAS unsigned*)(F.lds + MISC_OFF);
    for (int u = F.tid; u < (LDS_BYTES - RING_BYTES) / 4; u += NWAVES * 64) ((LAS unsigned*)(F.lds + RING_BYTES))[u] = 0u;
    __syncthreads();
    XcdBarrier bar; bar.bar = (unsigned*)(F.ws + WS_CTL) + CW_BAR; bar.x = 0; bar.st = nullptr;
    if (MK_N_LAUNCHES == 1) bar = xcd_barrier_post((unsigned*)(F.ws + WS_CTL) + CW_BAR, MISC + 8);
    const int lo = args.ph_lo, hi = args.ph_hi;
#define IN(k) (lo <= (k) && (k) < hi)
#define SEAM(k) do { if (IN(k) && IN((k) + 1)) xcd_barrier(bar); } while (0)
    const int bid = (int)blockIdx.x;

    if (IN(0)) { p0_prologue(F); } SEAM(0);

    if (IN(1)) {
        p1_meta(F); VM_WAIT(); __syncthreads();
        { pg8::Gemm g{WSP(bf16, WS_XB), WSP(bf16, WS_WIN) + (size_t)2048 * DM, M, 1024, DM}; pg8::StaticOrder S; S.init(M, 1024, F.G, bid);
          EpiG1 E{SMP(float, SM_R1), WSP(bf16, WS_Q), WSP(bf16, WS_K), WSP(bf16, WS_U), WSP(unsigned char, WS_SGNA), WSP(unsigned char, WS_SGSSM), 8};
          pg8::gemm_phase<EpiG1, pg8::StaticOrder, GEMM_ALIGN, GEMM_SP2>(F.lds, g, S, E);
          }
        { pg8::Gemm g{OUTP(bf16, OUT_XB8), OUTP(bf16, OUT_W8), M, 6144, DM / 2}; pg8::StaticOrder S; S.init(M, 6144, F.G, bid);
          EpiQKG E{SMP(float, SM_R1), WSP(bf16, WS_Q), WSP(bf16, WS_K), WSP(unsigned char, WS_SGNA), WSP(unsigned char, WS_SGSSM)};
          pg8::gemm_phase<EpiQKG, pg8::StaticOrder, GEMM_ALIGN, GEMM_SP2, true>(F.lds, g, S, E);
          }
        { pg8::Gemm g{OUTP(bf16, OUT_WV8), OUTP(bf16, OUT_XB8), 1024, M, DM / 2}; pg8::StaticOrder S; S.init(1024, M, F.G, bid);
          EpiVt E{SMP(float, SM_R1), WSP(bf16, WS_VT)};
          pg8::gemm_phase<EpiVt, pg8::StaticOrder, GEMM_ALIGN, GEMM_SP2, true>(F.lds, g, S, E);
          }
    } SEAM(1);

    if (IN(2)) {
        for (int bg = F.vcu; bg < NB * 64; bg += F.G) s5_block(F, bg >> 6, bg & 63);
        if (F.wave == 7 && F.vcu < NHEAD) p2_meta_attn(F, F.vcu);
        LAS bf16* P = (LAS bf16*)(F.lds + F.wave * 9216);
        { constexpr int NGRP = NB * NHEAD * 32;
          v4u kp[9]; float bp[2]; bf16x8 qf[2]; int gi = F.vcu;
          if (gi < NGRP) { na_prefetch(F, gi, kp, bp); na_commit(F, kp, bp); na_qload(F, gi, qf); }
          __syncthreads();
          for (; gi < NGRP; gi += F.G) { const bool hn = gi + F.G < NGRP;
              if (hn) na_prefetch(F, gi + F.G, kp, bp);
              na_task(F, gi, P, kp, bp, qf, hn);
              __syncthreads(); } }
    } SEAM(2);

    if (IN(3)) {
        p3a_meta(F); VM_WAIT(); __syncthreads();
        pg8::Gemm g{OUTP(bf16, OUT_YG), WSP(bf16, WS_WGLU), M, 1024, 1024}; pg8::StaticOrder S; S.init(M, 1024, F.G, bid);
        EpiGlu E{OUTP(bf16, OUT_YG), OUTP(bf16, OUT_SGLU)};
        pg8::gemm_phase<EpiGlu, pg8::StaticOrder, GEMM_ALIGN, GEMM_SP2>(F.lds, g, S, E);
    } SEAM(3);

    if (IN(4)) {
        p3b_meta(F); VM_WAIT(); __syncthreads();
        { pg8::Gemm g{WSP(bf16, WS_O), OUTP(bf16, OUT_WNA8), M, DM, 512}; pg8::StaticOrder S; S.init(M, DM, F.G, bid);
          EpiMix<false> E{WSP(unsigned char, WS_SGNA), WSP(bf16, WS_MIX), 1.0f / (255.f * 1024.f)};
          pg8::gemm_phase<EpiMix<false>, pg8::StaticOrder, GEMM_ALIGN, GEMM_SP2, true>(F.lds, g, S, E);
          }
        { pg8::Gemm g{OUTP(bf16, OUT_SGLU), WSP(bf16, WS_WSSM), M, DM, 1024}; pg8::StaticOrder S; S.init(M, DM, F.G, bid);
          EpiMix<true> E{WSP(unsigned char, WS_SGSSM), WSP(bf16, WS_MIX), 1.0f / 255.f};
          pg8::gemm_phase<EpiMix<true>, pg8::StaticOrder, GEMM_ALIGN, GEMM_SP2>(F.lds, g, S, E); }
    } SEAM(4);

    if (IN(5)) {
        p3c_meta(F); VM_WAIT(); __syncthreads();
        pg8::Gemm g{WSP(bf16, WS_MIX), WSP(bf16, WS_WOUT), M, DM, DM}; pg8::StaticOrder S; S.init(M, DM, F.G, bid);
        EpiRes<true> E{WSP(bf16, WS_XB), WSP(bf16, WS_H2B), (float*)(F.ws + WS_CTL + CTL_ROWSQ2)};
        pg8::gemm_phase<EpiRes<true>, pg8::StaticOrder, GEMM_ALIGN, GEMM_SP2>(F.lds, g, S, E);
    } SEAM(5);

    if (IN(6)) {
        p4_meta(F); VM_WAIT(); __syncthreads();
        pg8::Gemm g{WSP(bf16, WS_H2B), WSP(bf16, WS_WUP), M, 2 * DFF, DM}; pg8::StaticOrder S; S.init(M, 2 * DFF, F.G, bid);
        EpiUp E{(const float*)(F.ws + WS_CTL + CTL_ROWSQ2), F.in[IN_CONVW], F.in[IN_CONVB], WSP(bf16, WS_ACT), WSP(float, WS_EA), WSP(float, WS_EP), WSP(float, WS_EG), F.lds + RING_BYTES};
        pg8::gemm_phase<EpiUp, pg8::StaticOrder, GEMM_ALIGN, GEMM_SP2>(F.lds, g, S, E);
    } SEAM(6);

    if (IN(8)) {
        pg8::Gemm g{WSP(bf16, WS_ACT), WSP(bf16, WS_WDOWN), M, DM, DFF}; pg8::StaticOrder S; S.init(M, DM, F.G, bid);
        { pg8::Unit u; int lastpm = -1; for (int i = 0; S.next(i, u); ++i) if (u.pm != lastpm) { p5_fixup_panel(F, u.pm); lastpm = u.pm; } }
        VM_WAIT(); __syncthreads();
        EpiRes<false> E{WSP(bf16, WS_H2B), WSP(bf16, WS_H3B), (float*)(F.ws + WS_CTL + CTL_ROWSQ3)};
        pg8::gemm_phase<EpiRes<false>, pg8::StaticOrder, GEMM_ALIGN, GEMM_SP2>(F.lds, g, S, E);
    } SEAM(8);

    if (IN(9)) { p7_final(F); }

#undef IN
#undef SEAM
}

extern "C" void kernel_launch(void* const* d_in, const int* in_sizes, int n_in, void* d_out, int out_size, void* d_ws, size_t ws_size, hipStream_t stream) {
    static int grid = 0;
    if (grid == 0) {
        if (n_in != 23 || out_size != M * DM || ws_size < WS_END) { fprintf(stderr, "kernel_launch: unexpected shapes (n_in %d out %d ws %zu)\n", n_in, out_size, ws_size); grid = -1; return; }
        int dev = 0, cus = 0, per_cu = 0;
        if (hipGetDevice(&dev) != hipSuccess || hipDeviceGetAttribute(&cus, hipDeviceAttributeMultiprocessorCount, dev) != hipSuccess) { grid = -1; return; }
        if (hipFuncSetAttribute((const void*)skel_fwd, hipFuncAttributeMaxDynamicSharedMemorySize, LDS_BYTES) != hipSuccess) { fprintf(stderr, "kernel_launch: hipFuncSetAttribute failed\n"); grid = -1; return; }
        if (hipOccupancyMaxActiveBlocksPerMultiprocessor(&per_cu, (const void*)skel_fwd, NWAVES * 64, LDS_BYTES) != hipSuccess || per_cu < 1) fprintf(stderr, "kernel_launch: occupancy query reports %d\n", per_cu);
        (void)hipGetLastError();
        grid = cus;
    }
    if (grid < 0) return;
    if (hipMemsetAsync((char*)d_ws + WS_CTL, 0, CTL_ZERO_BYTES, stream) != hipSuccess) return;
    Args a{};
    for (int i = 0; i < 23; ++i) a.in[i] = (const float*)d_in[i];
    a.out = (float*)d_out; a.ws = (unsigned char*)d_ws;
    const int nl = MK_N_LAUNCHES;
    for (int li = 0; li < nl; ++li) {
        a.ph_lo = (MK_N_LAUNCHES == 1) ? 0 : li; a.ph_hi = (MK_N_LAUNCHES == 1) ? N_PHASES : li + 1; a.li = li;
        hipLaunchKernelGGL(skel_fwd, dim3(grid), dim3(NWAVES * 64), LDS_BYTES, stream, a);
        const hipError_t le = hipPeekAtLastError();
        if (le != hipSuccess) { fprintf(stderr, "kernel_launch: launch %d failed: %s\n", li, hipGetErrorName(le)); break; }
    }
}
```

```cpp
#include <hip/hip_runtime.h>
#include <cstdio>
#include <cstdint>
#define MK_N_LAUNCHES 1
namespace pg8 {
#define PG8_LAS __attribute__((address_space(3)))
typedef unsigned short bf16_t;
typedef short bf16x8 __attribute__((ext_vector_type(8)));
typedef float f32x4 __attribute__((ext_vector_type(4)));
typedef unsigned u32x4 __attribute__((ext_vector_type(4)));
constexpr int BM = 256, BK = 64, HALF = 128, HTB = HALF * BK * 2  , STAGE_BYTES = 8 * HTB, NXCD = 8, WGM = 8;

__host__ __device__ __forceinline__ int lds_byte(int r, int c) { const int st = (r >> 4) * 2 + (c >> 5), rr = r & 15, cc = c & 31, ob = rr * 64 + cc * 2; return st * 1024 + (ob ^ (((ob >> 9) & 1) << 5)); }
__host__ __device__ __forceinline__ void stage_rc(int b, int& R, int& C) { const int st = b / 1024, sb = b % 1024, swz = sb ^ (((sb >> 9) & 1) << 5); R = (st >> 1) * 16 + swz / 64; C = (st & 1) * 32 + (swz % 64) / 2; }
__host__ __device__ __forceinline__ int perm32(int rho) { const int n = rho >> 4, i = rho & 15; return 8 * (i >> 2) + 4 * n + (i & 3); }

struct Unit { int pm, pn, kind; };
struct Gemm { const bf16_t* A; const bf16_t* Bt; int M, N, K; const bf16_t* A2; const bf16_t* Bt2; };

struct StaticOrder {
    int nM, nN, nwg, G, c;
    __host__ __device__ void init(int M, int N, int G_, int c_) { nM = M / BM; nN = N / BM; nwg = nM * nN; G = G_; c = c_; }
    __host__ __device__ bool next(int i, Unit& u) const {
        const long L = (long)i * G + c; if (L >= nwg) return false;
        int wgid = (int)L; { const int q = nwg / NXCD, r = nwg % NXCD, xcd = wgid % NXCD, off = wgid / NXCD; wgid = (xcd < r ? xcd * (q + 1) : r * (q + 1) + (xcd - r) * q) + off; }
        const int nig = WGM * nN, gid = wgid / nig, fm = gid * WGM, gsz = (nM - fm) < WGM ? (nM - fm) : WGM;
        u.pm = fm + ((wgid % nig) % gsz); u.pn = (wgid % nig) / gsz; u.kind = 0; return true;
    }
    __device__ __forceinline__ void a_ready(const Unit&) const {}
    __device__ __forceinline__ void done(const Unit&) const {}
};

struct DualOrder {
    StaticOrder s0, s1; int c0;
    __host__ __device__ void init(int M0, int N0, int M1, int N1, int G, int c) { s0.init(M0, N0, G, c); s1.init(M1, N1, G, c); c0 = c < s0.nwg ? (s0.nwg - c + G - 1) / G : 0; }
    __host__ __device__ bool next(int i, Unit& u) const { if (i < c0) { const bool ok = s0.next(i, u); u.kind = 0; return ok; } const bool ok = s1.next(i - c0, u); u.kind = 1; return ok; }
    __device__ __forceinline__ void a_ready(const Unit&) const {}
    __device__ __forceinline__ void done(const Unit&) const {}
};
__device__ __forceinline__ unsigned cvt_pk_bf16(float lo, float hi) { unsigned r; asm volatile("v_cvt_pk_bf16_f32 %0, %1, %2" : "=v"(r) : "v"(lo), "v"(hi)); return r; }
typedef float f32x2 __attribute__((ext_vector_type(2)));
typedef int v8i32 __attribute__((ext_vector_type(8)));
typedef int i32x4_ __attribute__((ext_vector_type(4)));
template <class Epi, class Sched, bool ALIGN_EPI = false, bool SP2 = false, bool F8 = false>
__device__ __forceinline__ void gemm_phase(PG8_LAS unsigned char* lds, const Gemm g, const Sched& S, const Epi& E) {
    const int tid = threadIdx.x, wid = __builtin_amdgcn_readfirstlane(tid >> 6), lane = tid & 63, wr = wid >> 2, wc = wid & 3, fr = lane & 15, fq = lane >> 4;
    const int K = g.K, nt = K / BK;
    unsigned voffA[2], voffB[2];
#pragma unroll
    for (int i = 0; i < 2; ++i) { int R, C; stage_rc(tid * 16 + i * 8192, R, C); const int Rb = Epi::PERM ? ((R & ~31) + perm32(R & 31)) : R;
        const int Ra = Epi::APERM ? ((R & ~63) + 4 * (R & 15) + ((R >> 4) & 3)) : R;
        voffA[i] = (unsigned)(Ra * K + C) * 2u; voffB[i] = (unsigned)(Rb * K + C) * 2u; }
    const size_t kstep = (size_t)(BK * 2);
    const size_t hstep = (size_t)HALF * K * 2;
    const size_t tstep = 2 * hstep;
    const unsigned ldsw = (unsigned)wid * 1024u;
    const int aoff = lds_byte(wr * 64 + fr, fq * 8), boff = lds_byte(wc * 32 + fr, fq * 8);
#define PG8_SA(b, h) (((b) * 2 + (h)) * HTB)
#define PG8_SB(b, h) ((4 + (b) * 2 + (h)) * HTB)
#define PG8_STAGE(bufoff, gbase, voff) do { _Pragma("unroll") for (int _i = 0; _i < 2; ++_i) \
        __builtin_amdgcn_global_load_lds((const unsigned*)((const char*)(gbase) + (voff)[_i]), (PG8_LAS unsigned*)(lds + (bufoff) + ldsw + _i * 8192), 16, 0, 0); } while (0)
#define PG8_LDA(dst, b, h) do { _Pragma("unroll") for (int m = 0; m < 4; ++m) _Pragma("unroll") for (int k = 0; k < 2; ++k) dst[m][k] = *(const PG8_LAS bf16x8*)(lds + PG8_SA(b, h) + aoff + m * 2048 + k * 1024); } while (0)
#define PG8_LDB(dst, b, h) do { _Pragma("unroll") for (int n = 0; n < 2; ++n) _Pragma("unroll") for (int k = 0; k < 2; ++k) dst[n][k] = *(const PG8_LAS bf16x8*)(lds + PG8_SB(b, h) + boff + n * 2048 + k * 1024); } while (0)
#define PG8_CAT8(x, y) (__builtin_shufflevector(__builtin_bit_cast(i32x4_, x), __builtin_bit_cast(i32x4_, y), 0, 1, 2, 3, 4, 5, 6, 7))
#define PG8_MMA(ai, bj, At, Bt) do { __builtin_amdgcn_s_setprio(1); \
        if constexpr (F8) { _Pragma("unroll") for (int m = 0; m < 4; ++m) _Pragma("unroll") for (int n = 0; n < 2; ++n) { const v8i32 b8_ = PG8_CAT8(Bt[n][0], Bt[n][1]), a8_ = PG8_CAT8(At[m][0], At[m][1]); \
            asm volatile("v_mfma_f32_16x16x128_f8f6f4 %0, %1, %2, %0" : "+v"(acc[ai][bj][m][n]) : "v"(b8_), "v"(a8_)); } } \
        else { _Pragma("unroll") for (int m = 0; m < 4; ++m) _Pragma("unroll") for (int n = 0; n < 2; ++n) _Pragma("unroll") for (int k = 0; k < 2; ++k) \
            acc[ai][bj][m][n] = __builtin_amdgcn_mfma_f32_16x16x32_bf16(Bt[n][k], At[m][k], acc[ai][bj][m][n], 0, 0, 0); } __builtin_amdgcn_s_setprio(0); } while (0)
#define PG8_WAIT_V(n) asm volatile("s_waitcnt vmcnt(" #n ")" ::: "memory")
#define PG8_WAIT_L(n) asm volatile("s_waitcnt lgkmcnt(" #n ")" ::: "memory")
#define PG8_BAR __builtin_amdgcn_s_barrier()
#define PG8_SCHED __builtin_amdgcn_sched_barrier(0)
    Unit cur, nxt; int ui = 0;
    if (!S.next(0, cur)) return;
    f32x4 acc[2][2][4][2];
#pragma unroll
    for (int a = 0; a < 2; ++a)
#pragma unroll
        for (int b = 0; b < 2; ++b)
#pragma unroll
            for (int m = 0; m < 4; ++m)
#pragma unroll
                for (int n = 0; n < 2; ++n) acc[a][b][m][n] = (f32x4){0.f, 0.f, 0.f, 0.f};
    bf16x8 At[4][2], B0[2][2], B1[2][2];
    const char* cA = (const char*)(cur.kind ? g.A2 : g.A) + (size_t)cur.pm * tstep; const char* cB = (const char*)(cur.kind ? g.Bt2 : g.Bt) + (size_t)cur.pn * tstep;
    S.a_ready(cur);
    if constexpr (SP2) {
        PG8_STAGE(PG8_SB(0, 0), cB, voffB); PG8_STAGE(PG8_SB(0, 1), cB + hstep, voffB); PG8_STAGE(PG8_SA(0, 0), cA, voffA); PG8_STAGE(PG8_SA(0, 1), cA + hstep, voffA);
        if (wr == 1) PG8_BAR;
        PG8_WAIT_V(2); PG8_BAR;
        PG8_STAGE(PG8_SB(1, 0), cB + kstep, voffB); PG8_STAGE(PG8_SA(1, 0), cA + kstep, voffA); PG8_STAGE(PG8_SB(1, 1), cB + hstep + kstep, voffB);
        PG8_WAIT_V(6); PG8_BAR;
    } else {
        PG8_STAGE(PG8_SB(0, 0), cB, voffB); PG8_STAGE(PG8_SA(0, 0), cA, voffA); PG8_STAGE(PG8_SB(0, 1), cB + hstep, voffB); PG8_STAGE(PG8_SA(0, 1), cA + hstep, voffA);
        if (wr == 1) PG8_BAR;
        PG8_WAIT_V(4); PG8_BAR;
        PG8_STAGE(PG8_SB(1, 0), cB + kstep, voffB); PG8_STAGE(PG8_SA(1, 0), cA + kstep, voffA); PG8_STAGE(PG8_SB(1, 1), cB + hstep + kstep, voffB);
        PG8_WAIT_V(6); PG8_BAR;
    }
    for (;;) {
        const bool has_next = S.next(ui + 1, nxt);
        const char* nA = has_next ? (const char*)(nxt.kind ? g.A2 : g.A) + (size_t)nxt.pm * tstep : cA; const char* nB = has_next ? (const char*)(nxt.kind ? g.Bt2 : g.Bt) + (size_t)nxt.pn * tstep : cB;
        for (int t = 0; t < nt; t += 2) {
            const bool last = (t == nt - 2);
            const char* a1 = cA + (size_t)(t + 1) * kstep;
            const char* a2 = last ? nA : cA + (size_t)(t + 2) * kstep; const char* b2 = last ? nB : cB + (size_t)(t + 2) * kstep;
            const char* a3 = a2 + kstep; const char* b3 = b2 + kstep;
            if (last && has_next) S.a_ready(nxt);
            if constexpr (SP2) {
            PG8_LDB(B0, 0, 0); PG8_LDB(B1, 0, 1); PG8_SCHED; PG8_LDA(At, 0, 0); PG8_STAGE(PG8_SA(1, 1), a1 + hstep, voffA);
            PG8_WAIT_V(8); PG8_WAIT_L(0); PG8_BAR; PG8_MMA(0, 0, At, B0); PG8_MMA(0, 1, At, B1); PG8_BAR; PG8_SCHED;
            PG8_LDA(At, 0, 1); PG8_STAGE(PG8_SB(0, 0), b2, voffB); PG8_STAGE(PG8_SB(0, 1), b2 + hstep, voffB); PG8_STAGE(PG8_SA(0, 0), a2, voffA);
            PG8_WAIT_V(8); PG8_WAIT_L(0); PG8_BAR; PG8_MMA(1, 0, At, B0); PG8_MMA(1, 1, At, B1); PG8_BAR; PG8_SCHED;
            PG8_LDB(B0, 1, 0); PG8_LDB(B1, 1, 1); PG8_SCHED; PG8_LDA(At, 1, 0); PG8_STAGE(PG8_SA(0, 1), a2 + hstep, voffA);
            PG8_WAIT_V(8); PG8_WAIT_L(0); PG8_BAR; PG8_MMA(0, 0, At, B0); PG8_MMA(0, 1, At, B1); PG8_BAR; PG8_SCHED;
            PG8_LDA(At, 1, 1); PG8_STAGE(PG8_SB(1, 0), b3, voffB); PG8_STAGE(PG8_SB(1, 1), b3 + hstep, voffB); PG8_STAGE(PG8_SA(1, 0), a3, voffA);
            PG8_WAIT_V(8); PG8_WAIT_L(0); PG8_BAR; PG8_MMA(1, 0, At, B0); PG8_MMA(1, 1, At, B1); PG8_BAR; PG8_SCHED;
            } else {
            PG8_LDB(B0, 0, 0); PG8_SCHED; PG8_LDA(At, 0, 0); PG8_STAGE(PG8_SA(1, 1), a1 + hstep, voffA);
            PG8_WAIT_L(8); PG8_BAR; PG8_WAIT_L(0); PG8_MMA(0, 0, At, B0); PG8_BAR; PG8_SCHED;
            PG8_LDB(B1, 0, 1); PG8_STAGE(PG8_SB(0, 0), b2, voffB);
            PG8_BAR; PG8_WAIT_L(0); PG8_MMA(0, 1, At, B1); PG8_BAR;
            PG8_LDA(At, 0, 1); PG8_STAGE(PG8_SA(0, 0), a2, voffA);
            PG8_BAR; PG8_WAIT_L(0); PG8_MMA(1, 0, At, B0); PG8_BAR; PG8_SCHED;
            PG8_STAGE(PG8_SB(0, 1), b2 + hstep, voffB);
            PG8_WAIT_V(6); PG8_BAR; PG8_MMA(1, 1, At, B1); PG8_BAR;
            PG8_LDB(B0, 1, 0); PG8_SCHED; PG8_LDA(At, 1, 0); PG8_STAGE(PG8_SA(0, 1), a2 + hstep, voffA);
            PG8_WAIT_L(8); PG8_BAR; PG8_WAIT_L(0); PG8_MMA(0, 0, At, B0); PG8_BAR; PG8_SCHED;
            PG8_LDB(B1, 1, 1); PG8_STAGE(PG8_SB(1, 0), b3, voffB);
            PG8_BAR; PG8_WAIT_L(0); PG8_MMA(0, 1, At, B1); PG8_BAR;
            PG8_LDA(At, 1, 1); PG8_STAGE(PG8_SA(1, 0), a3, voffA);
            PG8_BAR; PG8_WAIT_L(0); PG8_MMA(1, 0, At, B0); PG8_BAR; PG8_SCHED;
            PG8_STAGE(PG8_SB(1, 1), b3 + hstep, voffB);
            PG8_WAIT_V(6); PG8_BAR; PG8_MMA(1, 1, At, B1); PG8_BAR;
            }
        }
        if constexpr (F8) asm volatile("s_nop 15\n\ts_nop 15\n\ts_nop 15" ::: "memory");
        if constexpr (ALIGN_EPI) { if (wr == 0) PG8_BAR; }
        if constexpr (!Epi::AFTER_DRAIN) { E(acc, cur, wr, wc, fr, fq); S.done(cur); }
        if (!has_next) break;
#pragma unroll
        for (int a = 0; a < 2; ++a)
#pragma unroll
            for (int b = 0; b < 2; ++b)
#pragma unroll
                for (int m = 0; m < 4; ++m)
#pragma unroll
                    for (int n = 0; n < 2; ++n) acc[a][b][m][n] = (f32x4){0.f, 0.f, 0.f, 0.f};
        cur = nxt; cA = nA; cB = nB; ++ui;
        if constexpr (ALIGN_EPI) { if (wr == 1) PG8_BAR; }
    }
    PG8_WAIT_V(0);
    if constexpr (!ALIGN_EPI) { if (wr == 0) PG8_BAR; }
    PG8_BAR;
    if constexpr (Epi::AFTER_DRAIN) { E.fused(acc, cur, wr, wc, fr, fq, lds, wid, lane); S.done(cur); }
#undef PG8_SA
#undef PG8_SB
#undef PG8_STAGE
#undef PG8_LDA
#undef PG8_LDB
#undef PG8_MMA
#undef PG8_CAT8
#undef PG8_WAIT_V
#undef PG8_WAIT_L
#undef PG8_BAR
#undef PG8_SCHED
}
}
#define GAS __attribute__((address_space(1)))
#define LAS __attribute__((address_space(3)))
typedef unsigned short bf16;
typedef unsigned v4u __attribute__((ext_vector_type(4)));
typedef float f32x4 __attribute__((ext_vector_type(4)));
typedef short bf16x8 __attribute__((ext_vector_type(8)));
typedef GAS unsigned gu32;
typedef GAS unsigned long long gu64;
#define RLX_AGENT __ATOMIC_RELAXED, __HIP_MEMORY_SCOPE_AGENT
#define LDS_WAIT() asm volatile("s_waitcnt lgkmcnt(0)" ::: "memory")
#define VM_WAIT() asm volatile("s_waitcnt vmcnt(0)" ::: "memory")
__device__ __forceinline__ unsigned long long rt() { return __builtin_amdgcn_s_memrealtime(); }
__device__ __forceinline__ unsigned f2bf(float f) { unsigned u = __builtin_bit_cast(unsigned, f); return (u + 0x7fffu + ((u >> 16) & 1u)) >> 16; }
__device__ __forceinline__ unsigned pk2(float lo, float hi) { return f2bf(lo) | (f2bf(hi) << 16); }
#define XB_TMO      128
#define XB_XCNT(j)  (256  + 64 * (j))
#define XB_XSUB(j)  (1280 + 64 * (j))
#define XB_XGEN(j)  (2304 + 64 * (j))
#define XB_TOP      3328
#define XB_TOPGEN   3392
#define XCD_BAR_WORDS 3456
#define XB_SPIN_CAP (1u << 18)

__device__ __forceinline__ unsigned xb_ld(unsigned* p)              { return __hip_atomic_load(p, __ATOMIC_RELAXED, __HIP_MEMORY_SCOPE_AGENT); }
__device__ __forceinline__ unsigned xb_add(unsigned* p, unsigned v) { return __hip_atomic_fetch_add(p, v, __ATOMIC_RELAXED, __HIP_MEMORY_SCOPE_AGENT); }
__device__ __forceinline__ unsigned xb_xcc_id() { return (unsigned)__builtin_amdgcn_s_getreg((3 << 11) | 20) & 0xFu; }
#define XB_SPIN(cond, bar) do { unsigned _sp = 0; while (cond) { __builtin_amdgcn_s_sleep(1); \
    if ((++_sp & 255u) == 0u) { if (xb_ld(&(bar)[XB_TMO])) break; if (_sp > XB_SPIN_CAP) { atomicAdd(&(bar)[XB_TMO], 1u); break; } } } } while (0)

struct XcdBarrier {
    unsigned* bar; unsigned x;
    volatile LAS unsigned* st;
};

__device__ __forceinline__ XcdBarrier xcd_barrier_post(unsigned* bar, volatile LAS unsigned* st) {
    XcdBarrier b; b.bar = bar; b.x = xb_xcc_id(); b.st = st;
    if (threadIdx.x == 0) (void)xb_add(&bar[XB_XCNT(b.x)], 1u);
    return b;
}
__device__ __forceinline__ void xcd_barrier_complete(unsigned* bar, unsigned x, unsigned& nloc, unsigned& nx) {
    const unsigned G = gridDim.x * gridDim.y * gridDim.z;
    unsigned sum, cnt, mine, sp = 0u;
    for (;;) {
        sum = 0u; cnt = 0u; mine = 0u;
#pragma unroll
        for (unsigned j = 0; j < 16; ++j) { const unsigned c = xb_ld(&bar[XB_XCNT(j)]); sum += c; cnt += (c > 0u) ? 1u : 0u; mine = (j == x) ? c : mine; }
        if (sum == G) break;
        __builtin_amdgcn_s_sleep(1);
        if ((++sp & 255u) == 0u) { if (xb_ld(&bar[XB_TMO])) break; if (sp > XB_SPIN_CAP) { atomicAdd(&bar[XB_TMO], 1u); break; } }
    }
    nloc = mine > 0u ? mine : 1u; nx = cnt > 0u ? cnt : 1u;
}

__device__ __forceinline__ void xcd_barrier(const XcdBarrier& b) {
    asm volatile("s_waitcnt vmcnt(0)" ::: "memory");
    __syncthreads();
    if (threadIdx.x == 0) {
        unsigned* bar = b.bar;
        __builtin_amdgcn_s_waitcnt(0);
        unsigned nloc = b.st[0], nx = b.st[1];
        if (nloc == 0u) { xcd_barrier_complete(bar, b.x, nloc, nx); b.st[0] = nloc; b.st[1] = nx; }
        const unsigned old = xb_add(&bar[XB_XSUB(b.x)], 1u);
        const unsigned gen = old / nloc;
        if (old + 1u == (gen + 1u) * nloc) {
            __builtin_amdgcn_fence(__ATOMIC_RELEASE, "agent");
            asm volatile("s_waitcnt vmcnt(0)" ::: "memory");
            const unsigned og = xb_add(&bar[XB_TOP], 1u);
            const unsigned tg = og / nx;
            if (og + 1u == (tg + 1u) * nx) xb_add(&bar[XB_TOPGEN], 1u);
            else XB_SPIN(xb_ld(&bar[XB_TOPGEN]) == tg, bar);
            __builtin_amdgcn_fence(__ATOMIC_ACQUIRE, "agent");
            xb_add(&bar[XB_XGEN(b.x)], 1u);
            asm volatile("s_waitcnt vmcnt(0)" ::: "memory");
        } else {
            XB_SPIN(xb_ld(&bar[XB_XGEN(b.x)]) == gen, bar);
            __builtin_amdgcn_fence(__ATOMIC_ACQUIRE, "agent");
            asm volatile("s_waitcnt vmcnt(0)" ::: "memory");
        }
    }
    __syncthreads();
}

constexpr int NB = 4, SEQ = 4096, DM = 2048, LPOS = 4112, M = NB * SEQ;
constexpr int DFF = 5632, NHEAD = 16, HD = 64;
constexpr int NIN = 8192, NMAIN = 7168;
constexpr int NCH = 257;
constexpr float EPS = 1e-6f;
constexpr int NWAVES = 8;

constexpr size_t MiB = 1u << 20;
constexpr size_t WS_CTL = 0, CTL_ZERO_BYTES = 1 * MiB;
constexpr size_t WS_WIN = 1 * MiB, WS_WUP = 33 * MiB, WS_WDOWN = 77 * MiB, WS_WOUT = 99 * MiB, WS_WNA = 107 * MiB, WS_WSSM = 111 * MiB, WS_WGLU = 115 * MiB;
constexpr size_t WS_Q = 117 * MiB, WS_K = 149 * MiB, WS_VT = 181 * MiB, WS_U = 213 * MiB, WS_O = 247 * MiB;
constexpr size_t WS_MIX = 117 * MiB;
constexpr size_t WS_ACT = 117 * MiB;
constexpr size_t WS_SGNA = 293 * MiB, WS_SGSSM = 357 * MiB;
constexpr size_t WS_H2B = 293 * MiB;
constexpr size_t WS_EA = 357 * MiB, WS_EP = 369 * MiB, WS_EG = 381 * MiB;
constexpr size_t WS_XB = 421 * MiB;
constexpr size_t OUT_WV8 = 22 * MiB;
constexpr size_t OUT_W8 = 64 * MiB;
constexpr size_t OUT_WNA8 = 24 * MiB;
constexpr size_t OUT_WG8 = 26 * MiB, OUT_XB8 = 32 * MiB;
constexpr size_t OUT_YG = 32 * MiB, OUT_SGLU = 64 * MiB;
constexpr size_t WS_H3B = 421 * MiB;
constexpr size_t WS_SMALL = 485 * MiB, WS_END = 512 * MiB;
constexpr size_t SM_R1 = 0, SM_R1M = 192 * 1024, SM_Q15 = 196 * 1024, SM_SGNA15 = 200 * 1024, SM_SGSSM15 = 208 * 1024;
constexpr size_t SM_XBM = 256 * 1024, SM_KM = 320 * 1024, SM_VMT = 352 * 1024, SM_AYG15 = 416 * 1024, SM_AO15 = 448 * 1024, SM_AS15 = 480 * 1024;
constexpr size_t SM_AMIX15 = 512 * 1024, SM_AH2B15 = 576 * 1024, SM_A15 = 640 * 1024, SM_LAM16 = 768 * 1024;
constexpr size_t CTL_ROWSQ2 = 256 * 1024, CTL_ROWSQ3 = 320 * 1024, CTL_ROWSQM = 384 * 1024;
constexpr int CW_BAR = 4096;
constexpr size_t OUT_P = 0, OUT_R = 8 * MiB, OUT_KL = 16 * MiB, OUT_CP = 18 * MiB, OUT_L5 = 20 * MiB;

constexpr int RING_BYTES = 131072;
constexpr int MISC_OFF = 159744 - 256;
constexpr int LDS_BYTES = 159744;
static_assert(MISC_OFF + 128 <= LDS_BYTES, "LDS map");

typedef float f32x2 __attribute__((ext_vector_type(2)));
typedef unsigned v2u __attribute__((ext_vector_type(2)));
struct Frame {
    LAS unsigned char* lds;
    int tid, lane, wave, vcu, G, gw, NGW;
    const float* in[23];
    float* out; unsigned char* ws;
};
#define IN_X 0
#define IN_META 1
#define IN_G1 2
#define IN_WIN 3
#define IN_RPB 4
#define IN_LAMRE 5
#define IN_LAMIM 6
#define IN_LOGSTEP 7
#define IN_BRE 8
#define IN_BIM 9
#define IN_CRE 10
#define IN_CIM 11
#define IN_SSMD 12
#define IN_WGLU 13
#define IN_WNA 14
#define IN_WSSM 15
#define IN_WOUT 16
#define IN_G2 17
#define IN_WUP 18
#define IN_CONVW 19
#define IN_CONVB 20
#define IN_WDOWN 21
#define IN_GF 22
#define WSP(T, off) ((T*)(F.ws + (off)))
#define SMP(T, off) ((T*)(F.ws + WS_SMALL + (off)))
#define OUTP(T, off) ((T*)((unsigned char*)F.out + (off)))

__device__ __forceinline__ float wave_sum(float v) {
#pragma unroll
    for (int o = 1; o < 64; o <<= 1) v += __shfl_xor(v, o);
    return v;
}
typedef __bf16 bf16x2_t __attribute__((ext_vector_type(2)));
__device__ __forceinline__ unsigned cvtpk(float lo, float hi) { f32x2 v = {lo, hi}; bf16x2_t b = __builtin_convertvector(v, bf16x2_t); return __builtin_bit_cast(unsigned, b); }
__device__ __forceinline__ float bf2f(bf16 h) { return __builtin_bit_cast(float, (unsigned)h << 16); }
__device__ __forceinline__ float sigmoidf_(float x) { return __builtin_amdgcn_rcpf(1.0f + __expf(-x)); }
__device__ __forceinline__ float gelu_tanh(float x) { const float z = x * __builtin_fmaf(x * x, -0.10294324f, -2.3022082f); return x * __builtin_amdgcn_rcpf(1.0f + __builtin_amdgcn_exp2f(z)); }
__device__ __forceinline__ unsigned pk4_fp8(float a, float b, float c, float d) { unsigned w = __builtin_amdgcn_cvt_pk_fp8_f32(a, b, 0, false); return __builtin_amdgcn_cvt_pk_fp8_f32(c, d, w, true); }
template <int CTRL> __device__ __forceinline__ float dpp0(float x) { return __builtin_bit_cast(float, __builtin_amdgcn_update_dpp(0, __builtin_bit_cast(int, x), CTRL, 0xf, 0xf, true)); }
__device__ __forceinline__ bf16x8 ldfrag(const bf16* base, int ld, int lane) { return *(const bf16x8*)(base + (size_t)(lane & 15) * ld + 8 * (lane >> 4)); }
__device__ __forceinline__ bf16x8 ldfrag_lds(const LAS bf16* base, int ld, int lane) { return *(const LAS bf16x8*)(base + (lane & 15) * ld + 8 * (lane >> 4)); }
#define MFMA16(a, b, c) __builtin_amdgcn_mfma_f32_16x16x32_bf16((a), (b), (c), 0, 0, 0)
__device__ __forceinline__ bf16x8 dq8(v2u w) {
    const f32x2 a = __builtin_amdgcn_cvt_pk_f32_fp8((int)w.x, false), b = __builtin_amdgcn_cvt_pk_f32_fp8((int)w.x, true), c = __builtin_amdgcn_cvt_pk_f32_fp8((int)w.y, false), d = __builtin_amdgcn_cvt_pk_f32_fp8((int)w.y, true);
    v4u o; o.x = cvtpk(a[0], a[1]); o.y = cvtpk(b[0], b[1]); o.z = cvtpk(c[0], c[1]); o.w = cvtpk(d[0], d[1]); return __builtin_bit_cast(bf16x8, o); }
template <int K> __device__ __forceinline__ f32x4 meta_nt16_f8(Frame& F, const bf16* A, int lda, const unsigned char* Bt8, int ldb) {
    constexpr int NS = K / 8 / 32;
    const int lane = F.lane;
    const bf16* ap = A + (size_t)(lane & 15) * lda + 8 * (lane >> 4) + F.wave * (K / 8); const unsigned char* bp = Bt8 + (size_t)(lane & 15) * ldb + 8 * (lane >> 4) + F.wave * (K / 8);
    bf16x8 a[NS]; v2u b[NS];
#pragma unroll
    for (int i = 0; i < NS; ++i) { a[i] = *(const bf16x8*)(ap + 32 * i); b[i] = *(const v2u*)(bp + 32 * i); }
    f32x4 acc = {0.f, 0.f, 0.f, 0.f};
#pragma unroll
    for (int i = 0; i < NS; ++i) acc = MFMA16(a[i], dq8(b[i]), acc);
    LAS f32x4* red = (LAS f32x4*)F.lds;
    red[F.wave * 64 + lane] = acc;
    __syncthreads();
    f32x4 sum = {0.f, 0.f, 0.f, 0.f};
    if (F.wave == 0) {
#pragma unroll
        for (int w = 0; w < 8; ++w) sum = sum + red[w * 64 + lane]; }
    __syncthreads();
    return sum;
}
template <int K> __device__ __forceinline__ f32x4 meta_nt16_pair(Frame& F, const bf16* A, int lda, const void* Bt, int ldb, bool f8, f32x4* other = nullptr) {
    constexpr int NS = K / 4 / 32;
    const int lane = F.lane, kq = F.wave & 3;
    const bf16* ap = A + (size_t)(lane & 15) * lda + 8 * (lane >> 4) + kq * (K / 4);
    bf16x8 a[NS], b[NS];
#pragma unroll
    for (int i = 0; i < NS; ++i) a[i] = *(const bf16x8*)(ap + 32 * i);
    if (f8) { const unsigned char* bp = (const unsigned char*)Bt + (size_t)(lane & 15) * ldb + 8 * (lane >> 4) + kq * (K / 4); v2u q[NS];
#pragma unroll
        for (int i = 0; i < NS; ++i) q[i] = *(const v2u*)(bp + 32 * i);
#pragma unroll
        for (int i = 0; i < NS; ++i) b[i] = dq8(q[i]); }
    else { const bf16* bp = (const bf16*)Bt + (size_t)(lane & 15) * ldb + 8 * (lane >> 4) + kq * (K / 4);
#pragma unroll
        for (int i = 0; i < NS; ++i) b[i] = *(const bf16x8*)(bp + 32 * i); }
    f32x4 acc = {0.f, 0.f, 0.f, 0.f};
#pragma unroll
    for (int i = 0; i < NS; ++i) acc = MFMA16(a[i], b[i], acc);
    LAS f32x4* red = (LAS f32x4*)F.lds;
    red[F.wave * 64 + lane] = acc;
    __syncthreads();
    f32x4 sum = {0.f, 0.f, 0.f, 0.f};
    if (kq == 0) {
#pragma unroll
        for (int w = 0; w < 4; ++w) sum = sum + red[(F.wave + w) * 64 + lane]; }
    if (other && F.wave == 0) { f32x4 s2 = {0.f, 0.f, 0.f, 0.f};
#pragma unroll
        for (int w = 4; w < 8; ++w) s2 = s2 + red[w * 64 + lane];
        *other = s2; }
    __syncthreads();
    return sum;
}
template <int K> __device__ __forceinline__ f32x4 meta_nt16(Frame& F, const bf16* A, int lda, const bf16* Bt, int ldb) {
    constexpr int NS = K / 8 / 32;
    const int lane = F.lane;
    const bf16* ap = A + (size_t)(lane & 15) * lda + 8 * (lane >> 4) + F.wave * (K / 8); const bf16* bp = Bt + (size_t)(lane & 15) * ldb + 8 * (lane >> 4) + F.wave * (K / 8);
    bf16x8 a[NS], b[NS];
#pragma unroll
    for (int i = 0; i < NS; ++i) { a[i] = *(const bf16x8*)(ap + 32 * i); b[i] = *(const bf16x8*)(bp + 32 * i); }
    f32x4 acc = {0.f, 0.f, 0.f, 0.f};
#pragma unroll
    for (int i = 0; i < NS; ++i) acc = MFMA16(a[i], b[i], acc);
    LAS f32x4* red = (LAS f32x4*)F.lds;
    red[F.wave * 64 + lane] = acc;
    __syncthreads();
    f32x4 sum = {0.f, 0.f, 0.f, 0.f};
    if (F.wave == 0) {
#pragma unroll
        for (int w = 0; w < 8; ++w) sum = sum + red[w * 64 + lane]; }
    __syncthreads();
    return sum;
}

constexpr int P0_TP = 264;
__device__ __forceinline__ void p0_transpose_item(const float* W, int K, int N, bf16* WT, int dest_row0, const float* kscale, LAS bf16* TT, int kb, int nb, int lane, int wave, unsigned char* W8 = nullptr, int dest8_row0 = 0, bool keep16 = false) {
    const int k0 = 256 * kb + 32 * wave, n0 = 128 * nb, kr = lane >> 5, n4 = (lane & 31) * 4;
    f32x4 v[16]; unsigned loff = (unsigned)(kr * 16 * N + n4) * 4u; asm volatile("" : "+v"(loff));
#pragma unroll
    for (int i = 0; i < 16; ++i) v[i] = __builtin_nontemporal_load((const f32x4*)((const char*)(W + (size_t)(k0 + i) * N + n0) + loff));
    if (kscale) {
#pragma unroll
        for (int i = 0; i < 16; ++i) v[i] = v[i] * kscale[k0 + 16 * kr + i]; }
    LAS unsigned* TT32 = (LAS unsigned*)TT;
#pragma unroll
    for (int p8 = 0; p8 < 8; ++p8) { const int kd = 16 * wave + ((8 * kr + p8) ^ (4 * (lane & 3)));
#pragma unroll
        for (int cc = 0; cc < 4; ++cc) TT32[(n4 + cc) * (P0_TP / 2) + kd] = cvtpk(v[2 * p8][cc], v[2 * p8 + 1][cc]); }
    __syncthreads();
    const int c = lane & 31, nr = lane >> 5;
#pragma unroll
    for (int j = 0; j < 8; ++j) { const int n = 16 * wave + 2 * j + nr; const v4u w = *(const LAS v4u*)(TT + n * P0_TP + 8 * (c ^ ((n >> 2) & 3)));
        if (!W8 || keep16) *(v4u*)(WT + (size_t)(dest_row0 + n) * K + 256 * kb + 8 * c) = w;
        if (W8) { v2u q;
            q.x = pk4_fp8(64.f * __builtin_bit_cast(float, w.x << 16), 64.f * __builtin_bit_cast(float, w.x & 0xffff0000u), 64.f * __builtin_bit_cast(float, w.y << 16), 64.f * __builtin_bit_cast(float, w.y & 0xffff0000u));
            q.y = pk4_fp8(64.f * __builtin_bit_cast(float, w.z << 16), 64.f * __builtin_bit_cast(float, w.z & 0xffff0000u), 64.f * __builtin_bit_cast(float, w.w << 16), 64.f * __builtin_bit_cast(float, w.w & 0xffff0000u));
            *(v2u*)(W8 + (size_t)(dest8_row0 + n) * K + 256 * kb + 8 * c) = q; } }
    __syncthreads();
}
__device__ __forceinline__ void p0_row(const float* xrow, bf16* orow, float* rout, int lane, unsigned* o8row = nullptr) {
    const f32x4* xr = (const f32x4*)xrow + lane;
    f32x4 v[8]; float s = 0.f;
#pragma unroll
    for (int j = 0; j < 8; ++j) { v[j] = __builtin_nontemporal_load(xr + 64 * j); s += (v[j].x * v[j].x + v[j].y * v[j].y) + (v[j].z * v[j].z + v[j].w * v[j].w); }
    s = wave_sum(s);
    if (lane == 0) *rout = 1.0f / sqrtf(s * (1.0f / DM) + EPS);
    unsigned long long* o8 = (unsigned long long*)orow + lane;
#pragma unroll
    for (int j = 0; j < 8; ++j) o8[64 * j] = (unsigned long long)pk2(v[j].x, v[j].y) | ((unsigned long long)pk2(v[j].z, v[j].w) << 32);
    if (o8row) {
#pragma unroll
        for (int j = 0; j < 8; ++j) o8row[64 * j + lane] = pk4_fp8(v[j].x, v[j].y, v[j].z, v[j].w); }
}
__device__ __forceinline__ void sincos_d(double x, double& s, double& c) {
    const double TWO_PI = 6.283185307179586476925286766559;
    const double k = __builtin_rint(x / TWO_PI); double r = x - k * TWO_PI; r *= 0.25;
    const double r2 = r * r;
    double sn = r * (1.0 + r2 * (-1.0 / 6 + r2 * (1.0 / 120 + r2 * (-1.0 / 5040 + r2 * (1.0 / 362880 + r2 * (-1.0 / 39916800 + r2 * (1.0 / 6227020800.0)))))));
    double cs = 1.0 + r2 * (-0.5 + r2 * (1.0 / 24 + r2 * (-1.0 / 720 + r2 * (1.0 / 40320 + r2 * (-1.0 / 3628800 + r2 * (1.0 / 479001600.0 + r2 * (-1.0 / 87178291200.0)))))));
#pragma unroll
    for (int i = 0; i < 2; ++i) { const double s2 = 2.0 * sn * cs, c2 = cs * cs - sn * sn; sn = s2; cs = c2; }
    s = sn; c = cs;
}
__device__ __forceinline__ void cpow_(float lre, float lim, float step, int k, float& pr, float& pi) {
    const float mag = expf(lre * step * (float)k); double sd, cd; sincos_d((double)lim * (double)step * (double)k, sd, cd); pr = mag * (float)cd; pi = mag * (float)sd;
}
__device__ __forceinline__ void p0_s5_tables(Frame& F, int dir, int g, int half) {
    LAS float* LP = (LAS float*)F.lds;
    LAS float* BB = LP + 17 * 64 * 2;
    LAS float* CC = BB + 64 * 16 * 2;
    LAS float* KK = CC + 16 * 64 * 2;
    const int t = F.tid, dg = dir * 64 + g, lane = F.lane;
    unsigned char* ob = (unsigned char*)F.out;
    const float step = expf(F.in[IN_LOGSTEP][dg]);
    for (int e = t; e < 64 * (half ? 38 : 17); e += 512) { const int n = e & 63, idx = e >> 6;
        const float lre = F.in[IN_LAMRE][dg * 64 + n], lim = F.in[IN_LAMIM][dg * 64 + n];
        const int k = idx <= 16 ? idx : (idx < 22 ? (16 << (idx - 17)) : 16 * (dir ? 15 - (idx - 22) : (idx - 22)));
        float pr, pi; cpow_(lre, lim, step, k, pr, pi);
        if (idx <= 16) { LP[(idx * 64 + n) * 2] = pr; LP[(idx * 64 + n) * 2 + 1] = pi; }
        else if (idx < 22) { float* L5 = (float*)(ob + OUT_L5 + (size_t)dg * 2560); L5[((idx - 17) * 64 + n) * 2] = pr; L5[((idx - 17) * 64 + n) * 2 + 1] = pi; }
        else { float* CP = (float*)(ob + OUT_CP + (size_t)dg * 9216); CP[(idx - 22) * 130 + 2 * n] = pr; CP[(idx - 22) * 130 + 2 * n + 1] = pi; } }
    for (int e = t; e < 1024; e += 512) { const int c = e >> 6, n = e & 63; CC[e * 2] = F.in[IN_CRE][(dg * 16 + c) * 64 + n]; CC[e * 2 + 1] = F.in[IN_CIM][(dg * 16 + c) * 64 + n]; }
    __syncthreads();
    for (int e = t; e < 1024; e += 512) { const int n = e >> 4, c = e & 15;
        const float lre = F.in[IN_LAMRE][dg * 64 + n], lim = F.in[IN_LAMIM][dg * 64 + n], l1r = LP[(64 + n) * 2], l1i = LP[(64 + n) * 2 + 1];
        const float ar = l1r - 1.f, ai = l1i, den = 1.0f / (lre * lre + lim * lim), fr_ = (ar * lre + ai * lim) * den, fi_ = (ai * lre - ar * lim) * den;
        const float br = F.in[IN_BRE][(dg * 64 + n) * 16 + c], bi = F.in[IN_BIM][(dg * 64 + n) * 16 + c];
        BB[e * 2] = fr_ * br - fi_ * bi; BB[e * 2 + 1] = fr_ * bi + fi_ * br; }
    __syncthreads();
    if (!half) {
        bf16* P = (bf16*)(ob + OUT_P) + (size_t)dg * 128 * 256;
        for (int e = t; e < 128 * 256; e += 512) { const int rho = e >> 8, k = e & 255, part = (rho >> 5) & 1, n = (rho & 31) + 32 * (rho >> 6), j = k >> 4, cp = k & 15, ex = dir ? j : 15 - j;
            const float lr = LP[(ex * 64 + n) * 2], li = LP[(ex * 64 + n) * 2 + 1], br = BB[(n * 16 + cp) * 2], bi = BB[(n * 16 + cp) * 2 + 1];
            P[e] = (bf16)f2bf(part ? (lr * bi + li * br) : (lr * br - li * bi)); }
    } else {
#pragma unroll
        for (int dd = 0; dd < 2; ++dd) { const int d = 2 * F.wave + dd, c = lane & 15; f32x4 acc = {0.f, 0.f, 0.f, 0.f};
            for (int tt = 0; tt < 32; ++tt) { const int k = 4 * tt + (lane >> 4), part = k >> 6, n = k & 63;
                const float cr = CC[(c * 64 + n) * 2], ci = CC[(c * 64 + n) * 2 + 1], lr = LP[(d * 64 + n) * 2], li = LP[(d * 64 + n) * 2 + 1];
                const float av = part ? -(cr * li + ci * lr) : (cr * lr - ci * li), bv = BB[(n * 16 + c) * 2 + part];
                acc = __builtin_amdgcn_mfma_f32_16x16x4f32(av, bv, acc, 0, 0, 0); }
#pragma unroll
            for (int r = 0; r < 4; ++r) KK[(d * 16 + 4 * (lane >> 4) + r) * 16 + c] = acc[r]; }
        bf16* R = (bf16*)(ob + OUT_R) + (size_t)dg * 256 * 128;
        for (int e = t; e < 256 * 128; e += 512) { const int row = e >> 7, kk = e & 127, q = (kk >> 3) ^ (row & 15), j = kk & 7, rt = q >> 2, s = (q >> 1) & 1, hh = q & 1, sig = 16 * s + 8 * (j >> 2) + 4 * hh + (j & 3);
            const int part = rt & 1, n = 32 * (rt >> 1) + sig, i = row >> 4, c = row & 15, ex = dir ? 16 - i : i + 1;
            const float cr = CC[(c * 64 + n) * 2], ci = CC[(c * 64 + n) * 2 + 1], lr = LP[(ex * 64 + n) * 2], li = LP[(ex * 64 + n) * 2 + 1];
            R[e] = (bf16)f2bf(part ? -(cr * li + ci * lr) : (cr * lr - ci * li)); }
        __syncthreads();
        bf16* KL = (bf16*)(ob + OUT_KL + (size_t)dg * 9216);
        for (int e = t; e < 17 * 256; e += 512) { const int d = (e >> 8) - 1, c = (e >> 4) & 15, cp = e & 15; float v = 0.f;
            if (d >= 0) { v = KK[(d * 16 + c) * 16 + cp]; if (dir == 0 && d == 0 && c == cp) v += F.in[IN_SSMD][g * 16 + c]; }
            KL[e] = (bf16)f2bf(v); }
    }
    __syncthreads();
}
__device__ __forceinline__ void p0_prologue(Frame& F) {
    for (int v = F.vcu; v < 256; v += F.G) p0_s5_tables(F, (v >> 1) >> 6, (v >> 1) & 63, v & 1);
    LAS bf16* scr = (LAS bf16*)F.lds;
    const int gw = F.gw, NGW = F.NGW;
    constexpr int I_IN = 8 * 64, I_UP = 8 * 88, I_DOWN = 22 * 16, I_OUT = 8 * 16, I_NA = 4 * 16, I_SSM = 4 * 16, I_GLU = 4 * 8;
    constexpr int NITEMS = I_IN + I_UP + I_DOWN + I_OUT + I_NA + I_SSM + I_GLU;
    for (int it = F.vcu; it < NITEMS; it += F.G) {
        int r = it;
        if (r < I_IN) { const int kb = r % 8, nb = r / 8, n0 = nb * 128;
            const int dest = n0 < 2048 ? n0 : (n0 < 3072 ? 7168 + (n0 - 2048) : (n0 < 4096 ? 2048 + (n0 - 3072) : 3072 + (n0 - 4096)));
            p0_transpose_item(F.in[IN_WIN], DM, NIN, WSP(bf16, WS_WIN), dest, F.in[IN_G1], scr, kb, nb, F.lane, F.wave, (n0 < 2048 || n0 >= 4096) ? OUTP(unsigned char, OUT_W8) : (n0 < 3072 ? OUTP(unsigned char, OUT_WV8) : nullptr), n0 < 2048 ? n0 : (n0 >= 4096 ? n0 - 2048 : n0 - 2048)); continue; } r -= I_IN;
        if (r < I_UP) { const int kb = r % 8, nb = r / 8, n0 = nb * 128; const int isg = n0 >= DFF, j0 = isg ? n0 - DFF : n0;
            const int dest = 256 * (j0 >> 7) + (isg ? 128 : 0) + (j0 & 127);
            p0_transpose_item(F.in[IN_WUP], DM, 2 * DFF, WSP(bf16, WS_WUP), dest, F.in[IN_G2], scr, kb, nb, F.lane, F.wave); continue; } r -= I_UP;
        if (r < I_DOWN) { p0_transpose_item(F.in[IN_WDOWN], DFF, DM, WSP(bf16, WS_WDOWN), (r / 22) * 128, nullptr, scr, r % 22, r / 22, F.lane, F.wave); continue; } r -= I_DOWN;
        if (r < I_OUT) { p0_transpose_item(F.in[IN_WOUT], DM, DM, WSP(bf16, WS_WOUT), (r / 8) * 128, nullptr, scr, r % 8, r / 8, F.lane, F.wave); continue; } r -= I_OUT;
        if (r < I_NA) { p0_transpose_item(F.in[IN_WNA], 1024, DM, WSP(bf16, WS_WNA), (r / 4) * 128, nullptr, scr, r % 4, r / 4, F.lane, F.wave, OUTP(unsigned char, OUT_WNA8), (r / 4) * 128); continue; } r -= I_NA;
        if (r < I_SSM) { p0_transpose_item(F.in[IN_WSSM], 1024, DM, WSP(bf16, WS_WSSM), (r / 4) * 128, nullptr, scr, r % 4, r / 4, F.lane, F.wave); continue; } r -= I_SSM;
        p0_transpose_item(F.in[IN_WGLU], 1024, 1024, WSP(bf16, WS_WGLU), (r / 4) * 128, nullptr, scr, r % 4, r / 4, F.lane, F.wave);
    }
    for (int m = gw; m < M; m += NGW) p0_row(F.in[IN_X] + (size_t)m * DM, WSP(bf16, WS_XB) + (size_t)m * DM, SMP(float, SM_R1) + m, F.lane, OUTP(unsigned, OUT_XB8) + (size_t)m * (DM / 4));
    if (gw < 16) p0_row(F.in[IN_META] + (size_t)gw * DM, SMP(bf16, SM_XBM) + (size_t)gw * DM, SMP(float, SM_R1M) + gw, F.lane);
}

typedef float f32x4 __attribute__((ext_vector_type(4)));
__device__ __forceinline__ v4u pack8(f32x4 v0, f32x4 v1) { v4u w; w.x = cvtpk(v0[0], v0[1]); w.y = cvtpk(v0[2], v0[3]); w.z = cvtpk(v1[0], v1[1]); w.w = cvtpk(v1[2], v1[3]); return w; }
__device__ __forceinline__ void unpack8(v4u w, f32x4& v0, f32x4& v1) {
    v0[0] = __builtin_bit_cast(float, w.x << 16); v0[1] = __builtin_bit_cast(float, w.x & 0xffff0000u); v0[2] = __builtin_bit_cast(float, w.y << 16); v0[3] = __builtin_bit_cast(float, w.y & 0xffff0000u);
    v1[0] = __builtin_bit_cast(float, w.z << 16); v1[1] = __builtin_bit_cast(float, w.z & 0xffff0000u); v1[2] = __builtin_bit_cast(float, w.w << 16); v1[3] = __builtin_bit_cast(float, w.w & 0xffff0000u); }
__device__ __forceinline__ unsigned q8(f32x4 v) { const unsigned a = (unsigned)(sigmoidf_(v[0]) * 255.f + 0.5f), b = (unsigned)(sigmoidf_(v[1]) * 255.f + 0.5f), c = (unsigned)(sigmoidf_(v[2]) * 255.f + 0.5f), d = (unsigned)(sigmoidf_(v[3]) * 255.f + 0.5f);
    return a | (b << 8) | (c << 16) | (d << 24); }
__device__ __forceinline__ unsigned q8n(f32x4 a, float ns) { unsigned q[4];
#pragma unroll
    for (int i = 0; i < 4; ++i) q[i] = (unsigned)__builtin_fmaf(__builtin_amdgcn_rcpf(1.0f + __builtin_amdgcn_exp2f(a[i] * ns)), 255.f, 0.5f);
    return q[0] | (q[1] << 8) | (q[2] << 16) | (q[3] << 24); }
__device__ __forceinline__ f32x4 uq8(unsigned w) { f32x4 o; o[0] = (float)(w & 0xffu); o[1] = (float)((w >> 8) & 0xffu); o[2] = (float)((w >> 16) & 0xffu); o[3] = (float)(w >> 24); return o; }
__device__ __forceinline__ f32x4 sig4(f32x4 v) { f32x4 o; o[0] = sigmoidf_(v[0]); o[1] = sigmoidf_(v[1]); o[2] = sigmoidf_(v[2]); o[3] = sigmoidf_(v[3]); return o; }

struct EpiG1 {
    static constexpr bool PERM = true, AFTER_DRAIN = false, APERM = false;
    const float* r1; bf16 *Q, *K, *U; unsigned char *SGNA, *SGSSM; int pn0;
    __device__ __forceinline__ void operator()(const f32x4 (&acc)[2][2][4][2], const pg8::Unit& u0, int wr, int wc, int fr, int fq) const {
        const pg8::Unit u{u0.pm, u0.pn + pn0, 0};
        const int seg = u.pn < 4 ? 0 : (u.pn < 8 ? 1 : (u.pn < 12 ? 2 : (u.pn < 20 ? 3 : 4)));
        float rsv[2][4];
#pragma unroll
        for (int ai = 0; ai < 2; ++ai)
#pragma unroll
            for (int m = 0; m < 4; ++m) rsv[ai][m] = r1[u.pm * 256 + ai * 128 + wr * 64 + m * 16 + fr];
#pragma unroll
        for (int ai = 0; ai < 2; ++ai)
#pragma unroll
            for (int m = 0; m < 4; ++m) { const int row = u.pm * 256 + ai * 128 + wr * 64 + m * 16 + fr; const float rs = rsv[ai][m]; unsigned gq[4];
#pragma unroll
                for (int bj = 0; bj < 2; ++bj) { const int c0 = u.pn * 256 + bj * 128 + wc * 32 + 8 * fq; f32x4 v0 = acc[ai][bj][m][0] * rs, v1 = acc[ai][bj][m][1] * rs;
                    if (seg == 0) { v0 = v0 * 0.125f; v1 = v1 * 0.125f; *(v4u*)(Q + (size_t)row * 1024 + c0) = pack8(v0, v1); }
                    else if (seg == 1) { const int c = c0 - 1024, hh = c >> 6, d0 = c & 63, bb = row >> 12, tt = row & 4095;
                        *(v4u*)(K + ((((((size_t)(bb * 16 + hh) * 64 + (tt >> 6)) * 8 + ((tt & 63) >> 3)) * 2 + (d0 >> 5)) * 4 + ((d0 >> 3) & 3)) * 8 + (tt & 7)) * 8) = pack8(v0, v1); }
                    else if (seg == 2) { const int cu = c0 - 2048, g = cu >> 4, b = row >> 12, t = row & 4095; *(v4u*)(U + ((size_t)(b * 64 + g) * LPOS + 16 + t) * 16 + (cu & 15)) = pack8(v0, v1); }
                    else { gq[2 * bj] = q8(v0); gq[2 * bj + 1] = q8(v1); } }
                if (seg >= 3) { v4u w; w.x = gq[0]; w.y = gq[1]; w.z = gq[2]; w.w = gq[3]; *(v4u*)((seg == 3 ? SGNA + (u.pn - 12) * 256 : SGSSM + (u.pn - 20) * 256) + (size_t)row * 2048 + 64 * wc + 16 * fq) = w; } }
    }
};
struct EpiQKG {
    static constexpr bool PERM = true, AFTER_DRAIN = false, APERM = false;
    const float* r1; bf16 *Q, *K; unsigned char *SGNA, *SGSSM;
    __device__ __forceinline__ void operator()(const f32x4 (&acc)[2][2][4][2], const pg8::Unit& u, int wr, int wc, int fr, int fq) const {
        float rsv[2][4];
#pragma unroll
        for (int ai = 0; ai < 2; ++ai)
#pragma unroll
            for (int m = 0; m < 4; ++m) rsv[ai][m] = r1[u.pm * 256 + ai * 128 + wr * 64 + m * 16 + fr];
        if (u.pn >= 8) {
            unsigned char* dst = (u.pn < 16 ? SGNA + (u.pn - 8) * 256 : SGSSM + (u.pn - 16) * 256) + 64 * wc + 16 * fq;
#pragma unroll
            for (int ai = 0; ai < 2; ++ai)
#pragma unroll
                for (int m = 0; m < 4; ++m) { const int row = u.pm * 256 + ai * 128 + wr * 64 + m * 16 + fr; const float ns = rsv[ai][m] * (-1.4426950408889634f / 64.f);
                    v4u w; w.x = q8n(acc[ai][0][m][0], ns); w.y = q8n(acc[ai][0][m][1], ns); w.z = q8n(acc[ai][1][m][0], ns); w.w = q8n(acc[ai][1][m][1], ns);
                    *(v4u*)(dst + (size_t)row * 2048) = w; }
        } else {
#pragma unroll
            for (int ai = 0; ai < 2; ++ai)
#pragma unroll
                for (int m = 0; m < 4; ++m) { const int row = u.pm * 256 + ai * 128 + wr * 64 + m * 16 + fr; const float rs = rsv[ai][m] * (1.0f / 64.f);
#pragma unroll
                    for (int bj = 0; bj < 2; ++bj) { const int c0 = u.pn * 256 + bj * 128 + wc * 32 + 8 * fq;
                        if (u.pn < 4) { const float qs = rs * 0.125f; *(v4u*)(Q + (size_t)row * 1024 + c0) = pack8(acc[ai][bj][m][0] * qs, acc[ai][bj][m][1] * qs); }
                        else { const int c = c0 - 1024, hh = c >> 6, d0 = c & 63, bb = row >> 12, tt = row & 4095;
                            *(v4u*)(K + ((((((size_t)(bb * 16 + hh) * 64 + (tt >> 6)) * 8 + ((tt & 63) >> 3)) * 2 + (d0 >> 5)) * 4 + ((d0 >> 3) & 3)) * 8 + (tt & 7)) * 8) = pack8(acc[ai][bj][m][0] * rs, acc[ai][bj][m][1] * rs); } } }
        }
    }
};
struct EpiGate {
    static constexpr bool PERM = true, AFTER_DRAIN = false, APERM = false;
    const float* r1; unsigned char *SGNA, *SGSSM;
    __device__ __forceinline__ void operator()(const f32x4 (&acc)[2][2][4][2], const pg8::Unit& u, int wr, int wc, int fr, int fq) const {
        float rsv[2][4];
#pragma unroll
        for (int ai = 0; ai < 2; ++ai)
#pragma unroll
            for (int m = 0; m < 4; ++m) rsv[ai][m] = r1[u.pm * 256 + ai * 128 + wr * 64 + m * 16 + fr];
        unsigned char* dst = (u.pn < 8 ? SGNA + u.pn * 256 : SGSSM + (u.pn - 8) * 256) + 64 * wc + 16 * fq;
#pragma unroll
        for (int ai = 0; ai < 2; ++ai)
#pragma unroll
            for (int m = 0; m < 4; ++m) { const int row = u.pm * 256 + ai * 128 + wr * 64 + m * 16 + fr; const float ns = rsv[ai][m] * (-1.4426950408889634f / 64.f);
                v4u w; w.x = q8n(acc[ai][0][m][0], ns); w.y = q8n(acc[ai][0][m][1], ns); w.z = q8n(acc[ai][1][m][0], ns); w.w = q8n(acc[ai][1][m][1], ns);
                *(v4u*)(dst + (size_t)row * 2048) = w; }
    }
};
struct EpiVt {
    static constexpr bool PERM = true, AFTER_DRAIN = false, APERM = false;
    const float* r1; bf16* VT;
    __device__ __forceinline__ void operator()(const f32x4 (&acc)[2][2][4][2], const pg8::Unit& u, int wr, int wc, int fr, int fq) const {
#pragma unroll
        for (int bj = 0; bj < 2; ++bj) { const int c0 = u.pn * 256 + bj * 128 + wc * 32 + 8 * fq; const f32x4 s0 = *(const f32x4*)(r1 + c0) * (1.0f / 64.f), s1 = *(const f32x4*)(r1 + c0 + 4) * (1.0f / 64.f);
#pragma unroll
            for (int ai = 0; ai < 2; ++ai)
#pragma unroll
                for (int m = 0; m < 4; ++m) { const int row = u.pm * 256 + ai * 128 + wr * 64 + m * 16 + fr, bb = c0 >> 12, tt = c0 & 4095;
                    *(v4u*)(VT + (((((size_t)(bb * 16 + (row >> 6)) * 64 + (tt >> 6)) * 4 + ((row >> 2) & 3)) * 8 + ((tt & 63) >> 3)) * 16 + (((row >> 4) & 3) * 4 + (row & 3))) * 8) = pack8(acc[ai][bj][m][0] * s0, acc[ai][bj][m][1] * s1); } }
    }
};
struct EpiP1 {
    static constexpr bool PERM = true, AFTER_DRAIN = false, APERM = false;
    EpiQKG e0; EpiVt e1;
    __device__ __forceinline__ void operator()(const f32x4 (&acc)[2][2][4][2], const pg8::Unit& u, int wr, int wc, int fr, int fq) const { if (u.kind == 0) e0(acc, u, wr, wc, fr, fq); else e1(acc, u, wr, wc, fr, fq); }
};
struct EpiGlu {
    static constexpr bool PERM = true, AFTER_DRAIN = false, APERM = false;
    const bf16* YG; bf16* S;
    __device__ __forceinline__ void operator()(const f32x4 (&acc)[2][2][4][2], const pg8::Unit& u, int wr, int wc, int fr, int fq) const {
#pragma unroll
        for (int ai = 0; ai < 2; ++ai)
#pragma unroll
            for (int m = 0; m < 4; ++m) { const int row = u.pm * 256 + ai * 128 + wr * 64 + m * 16 + fr;
#pragma unroll
                for (int bj = 0; bj < 2; ++bj) { const int c0 = u.pn * 256 + bj * 128 + wc * 32 + 8 * fq; f32x4 y0, y1; unpack8(*(const v4u*)(YG + (size_t)row * 1024 + c0), y0, y1);
                    *(v4u*)(S + (size_t)row * 1024 + c0) = pack8(y0 * sig4(acc[ai][bj][m][0]), y1 * sig4(acc[ai][bj][m][1])); } }
    }
};
template <bool ADD> struct EpiMix {
    static constexpr bool PERM = true, AFTER_DRAIN = false, APERM = false;
    const unsigned char* GATE; bf16* MIX; float asc;
    __device__ __forceinline__ void operator()(const f32x4 (&acc)[2][2][4][2], const pg8::Unit& u, int wr, int wc, int fr, int fq) const {
#pragma unroll
        for (int ai = 0; ai < 2; ++ai)
#pragma unroll
            for (int m = 0; m < 4; ++m) { const int row = u.pm * 256 + ai * 128 + wr * 64 + m * 16 + fr;
                const v4u gw = *(const v4u*)(GATE + (size_t)row * 2048 + u.pn * 256 + 64 * wc + 16 * fq);
#pragma unroll
                for (int bj = 0; bj < 2; ++bj) { const int c0 = u.pn * 256 + bj * 128 + wc * 32 + 8 * fq;
                    f32x4 v0 = uq8(bj ? gw.z : gw.x) * (acc[ai][bj][m][0] * asc), v1 = uq8(bj ? gw.w : gw.y) * (acc[ai][bj][m][1] * asc);
                    if (ADD) { f32x4 p0, p1; unpack8(*(const v4u*)(MIX + (size_t)row * 2048 + c0), p0, p1); v0 = v0 + p0; v1 = v1 + p1; }
                    *(v4u*)(MIX + (size_t)row * 2048 + c0) = pack8(v0, v1); } }
    }
};

template <bool H2> struct EpiRes {
    static constexpr bool PERM = true, AFTER_DRAIN = false, APERM = false;
    const bf16* baseb; bf16* outb; float* rowsq;
    __device__ __forceinline__ void operator()(const f32x4 (&acc)[2][2][4][2], const pg8::Unit& u, int wr, int wc, int fr, int fq) const {
#pragma unroll
        for (int ai = 0; ai < 2; ++ai)
#pragma unroll
            for (int m = 0; m < 4; ++m) { const int row = u.pm * 256 + ai * 128 + wr * 64 + m * 16 + fr; float ss = 0.f;
#pragma unroll
                for (int bj = 0; bj < 2; ++bj) { const size_t off = (size_t)row * 2048 + u.pn * 256 + bj * 128 + wc * 32 + 8 * fq;
                    f32x4 v0, v1; unpack8(*(const v4u*)(baseb + off), v0, v1);
                    v0 = v0 + acc[ai][bj][m][0]; v1 = v1 + acc[ai][bj][m][1];
                    *(v4u*)(outb + off) = pack8(v0, v1);
                    ss += (v0[0] * v0[0] + v0[1] * v0[1]) + (v0[2] * v0[2] + v0[3] * v0[3]) + (v1[0] * v1[0] + v1[1] * v1[1]) + (v1[2] * v1[2] + v1[3] * v1[3]); }
                ss += __shfl_xor(ss, 16); ss += __shfl_xor(ss, 32);
                if (fq == 0) atomicAdd(rowsq + row, ss); }
    }
};
struct EpiUp {
    static constexpr bool PERM = true, AFTER_DRAIN = false, APERM = true;
    const float* rowsq; const float* convw; const float* convb; bf16* ACT; float *EA, *EP, *EG; LAS unsigned char* ex;
    __device__ __forceinline__ void operator()(const f32x4 (&acc)[2][2][4][2], const pg8::Unit& u, int wr, int wc, int fr, int fq) const {
        const int ja0 = u.pn * 128 + wc * 32 + 8 * fq;
        LAS f32x4* EX = (LAS f32x4*)ex;
        float r2[2][4];
#pragma unroll
        for (int ai = 0; ai < 2; ++ai) { const f32x4 rq = *(const f32x4*)(rowsq + u.pm * 256 + ai * 128 + wr * 64 + 4 * fr);
#pragma unroll
            for (int m = 0; m < 4; ++m) r2[ai][m] = __builtin_amdgcn_rsqf(rq[m] * (1.0f / DM) + EPS); }
#pragma unroll
        for (int ai = 0; ai < 2; ++ai)
#pragma unroll
            for (int n = 0; n < 2; ++n) { const int e = (((2 * ai + wr) * 2) * 4 + wc) * 8 + fq * 2 + n;
                if (fr == 0) EX[e] = acc[ai][0][0][n] * r2[ai][0];
                if (fr == 15) EX[e + 32] = acc[ai][0][3][n] * r2[ai][3]; }
        __syncthreads();
#pragma unroll
        for (int ai = 0; ai < 2; ++ai) {
            const int row0 = u.pm * 256 + ai * 128 + wr * 64 + 4 * fr, blk = 2 * ai + wr;
            const bool has_up = blk > 0, has_dn = blk < 3;
            v2u wq[2][4];
#pragma unroll
            for (int n = 0; n < 2; ++n) {
                const int ja = ja0 + 4 * n;
                const f32x4 w0 = *(const f32x4*)(convw + ja), w1 = *(const f32x4*)(convw + DFF + ja), w2 = *(const f32x4*)(convw + 2 * DFF + ja), cb = *(const f32x4*)(convb + ja);
                f32x4 upn = {0.f, 0.f, 0.f, 0.f}, dnn = {0.f, 0.f, 0.f, 0.f};
                if (has_up) upn = EX[((((blk - 1) * 2 + 1) * 4 + wc) * 8) + fq * 2 + n];
                if (has_dn) dnn = EX[((((blk + 1) * 2) * 4 + wc) * 8) + fq * 2 + n];
                f32x4 av[4], gv[4], cv[4];
#pragma unroll
                for (int m = 0; m < 4; ++m) { av[m] = acc[ai][0][m][n] * r2[ai][m]; gv[m] = acc[ai][1][m][n] * r2[ai][m]; }
#pragma unroll
                for (int i = 0; i < 4; ++i) {
                    float up0 = dpp0<0x111>(av[3][i]), dn3 = dpp0<0x101>(av[0][i]);
                    if (fr == 0) up0 = upn[i];
                    if (fr == 15) dn3 = dnn[i];
                    cv[0][i] = __builtin_fmaf(w2[i], av[1][i], __builtin_fmaf(w0[i], up0, __builtin_fmaf(w1[i], av[0][i], cb[i])));
                    cv[1][i] = __builtin_fmaf(w2[i], av[2][i], __builtin_fmaf(w0[i], av[0][i], __builtin_fmaf(w1[i], av[1][i], cb[i])));
                    cv[2][i] = __builtin_fmaf(w2[i], av[3][i], __builtin_fmaf(w0[i], av[1][i], __builtin_fmaf(w1[i], av[2][i], cb[i])));
                    cv[3][i] = __builtin_fmaf(w2[i], dn3, __builtin_fmaf(w0[i], av[2][i], __builtin_fmaf(w1[i], av[3][i], cb[i])));
                }
                if (!has_up && fr == 0) { const size_t eo = (size_t)(u.pm * 8) * DFF + ja; *(f32x4*)(EA + eo) = av[0]; *(f32x4*)(EP + eo) = cv[0]; *(f32x4*)(EG + eo) = gv[0]; }
                if (!has_dn && fr == 15) { const size_t eo = (size_t)(u.pm * 8 + 7) * DFF + ja; *(f32x4*)(EA + eo) = av[3]; *(f32x4*)(EP + eo) = cv[3]; *(f32x4*)(EG + eo) = gv[3]; }
#pragma unroll
                for (int m = 0; m < 4; ++m) { wq[n][m].x = cvtpk(gelu_tanh(cv[m][0]) * gv[m][0], gelu_tanh(cv[m][1]) * gv[m][1]); wq[n][m].y = cvtpk(gelu_tanh(cv[m][2]) * gv[m][2], gelu_tanh(cv[m][3]) * gv[m][3]); }
            }
#pragma unroll
            for (int m = 0; m < 4; ++m) { const bool edge = (m == 0 && fr == 0 && !has_up) || (m == 3 && fr == 15 && !has_dn);
                if (!edge) { v4u w; w.x = wq[0][m].x; w.y = wq[0][m].y; w.z = wq[1][m].x; w.w = wq[1][m].y; *(v4u*)(ACT + (size_t)(row0 + m) * DFF + ja0) = w; } }
        }
    }
};


__device__ __forceinline__ void p1_meta(Frame& F) {
    const int lane = F.lane, lr = lane & 15, lg = lane >> 4;
    for (int cb0 = F.vcu; cb0 < 256; cb0 += F.G) {
        const int cb = cb0 + 256 * (F.wave >> 2), c16 = 16 * cb; const bool isu = c16 >= 2048 && c16 < 3072;
        const void* bt = isu ? (const void*)(WSP(bf16, WS_WIN) + (size_t)c16 * DM)
                             : (const void*)(c16 >= 7168 ? OUTP(unsigned char, OUT_WV8) + (size_t)(c16 - 7168) * DM : OUTP(unsigned char, OUT_W8) + (size_t)(c16 < 2048 ? c16 : c16 - 1024) * DM);
        const f32x4 acc = meta_nt16_pair<DM>(F, SMP(bf16, SM_XBM), DM, bt, DM, !isu);
        if ((F.wave & 3) != 0) continue;
        const float* r1m = SMP(float, SM_R1M);
        const int col = 16 * cb + lr; const float wsc = isu ? 1.0f : (1.0f / 64.f);
#pragma unroll
        for (int r = 0; r < 4; ++r) { const int j = 4 * lg + r; const float v = acc[r] * (r1m[j] * wsc);
            if (col < 1024) { if (j == 15) SMP(float, SM_Q15)[col] = v * 0.125f; }
            else if (col < 2048) SMP(bf16, SM_KM)[j * 1024 + (col - 1024)] = (bf16)f2bf(v);
            else if (col < 3072) { const int cu = col - 2048, g = cu >> 4; const bf16 h = (bf16)f2bf(v);
#pragma unroll
                for (int b = 0; b < NB; ++b) WSP(bf16, WS_U)[((size_t)(b * 64 + g) * LPOS + j) * 16 + (cu & 15)] = h; }
            else if (col < 5120) { if (j == 15) SMP(float, SM_SGNA15)[col - 3072] = sigmoidf_(v); }
            else if (col < 7168) { if (j == 15) SMP(float, SM_SGSSM15)[col - 5120] = sigmoidf_(v); }
            else { bf16* vm = SMP(bf16, SM_VMT) + (size_t)(col - 7168) * 32; vm[j] = (bf16)f2bf(v); vm[16 + j] = 0; } }
    }
}
__device__ __forceinline__ void p2_meta_attn(Frame& F, int h) {
    const int lane = F.lane, j = lane & 15, part = lane >> 4;
    const f32x4* q4 = (const f32x4*)(SMP(float, SM_Q15) + h * 64 + 16 * part); const v4u* k4 = (const v4u*)(SMP(bf16, SM_KM) + j * 1024 + h * 64 + 16 * part);
    const f32x4 qa = q4[0], qb = q4[1], qc = q4[2], qd = q4[3]; const v4u ka = k4[0], kb = k4[1];
    f32x4 k0, k1, k2, k3; unpack8(ka, k0, k1); unpack8(kb, k2, k3);
    const f32x4 pr = qa * k0 + qb * k1 + qc * k2 + qd * k3;
    float s = (pr[0] + pr[1]) + (pr[2] + pr[3]);
    s += __shfl_xor(s, 16); s += __shfl_xor(s, 32);
    float mx = s;
#pragma unroll
    for (int o = 1; o < 16; o <<= 1) mx = fmaxf(mx, __shfl_xor(mx, o));
    float p = __expf(s - mx), sum = p;
#pragma unroll
    for (int o = 1; o < 16; o <<= 1) sum += __shfl_xor(sum, o);
    p = p / sum;
    const v4u* v4 = (const v4u*)(SMP(bf16, SM_VMT) + (size_t)(h * 64 + lane) * 32); const v4u va = v4[0], vb = v4[1];
    f32x4 v0, v1, v2, v3; unpack8(va, v0, v1); unpack8(vb, v2, v3);
    float o = 0.f;
#pragma unroll
    for (int k = 0; k < 4; ++k) { o += __shfl(p, k) * v0[k] + __shfl(p, 4 + k) * v1[k] + __shfl(p, 8 + k) * v2[k] + __shfl(p, 12 + k) * v3[k]; }
    const bf16 ob = (bf16)f2bf(o);
#pragma unroll
    for (int b = 0; b < NB; ++b) SMP(bf16, SM_AO15)[b * 1024 + h * 64 + lane] = ob;
}
__device__ __forceinline__ void p3a_meta(Frame& F) {
    const int lane = F.lane, lr = lane & 15, lg = lane >> 4;
    for (int cb = F.vcu; cb < 64; cb += F.G) {
        const f32x4 acc = meta_nt16<1024>(F, SMP(bf16, SM_AYG15), 1024, WSP(bf16, WS_WGLU) + (size_t)(16 * cb) * 1024, 1024);
        if (F.wave != 0) continue;
#pragma unroll
        for (int r = 0; r < 4; ++r) { const int i = 4 * lg + r, col = 16 * cb + lr; const float y = bf2f(SMP(bf16, SM_AYG15)[i * 1024 + col]); SMP(bf16, SM_AS15)[i * 1024 + col] = (bf16)f2bf(y * sigmoidf_(acc[r])); }
    }
}
__device__ __forceinline__ void p3b_meta(Frame& F) {
    const int lane = F.lane, lr = lane & 15, lg = lane >> 4;
    for (int cb = F.vcu; cb < 128; cb += F.G) {
        f32x4 a2 = {0.f, 0.f, 0.f, 0.f};
        const bool hi = (F.wave >> 2) != 0;
        f32x4 a1 = meta_nt16_pair<1024>(F, hi ? SMP(bf16, SM_AS15) : SMP(bf16, SM_AO15), 1024, hi ? (const void*)(WSP(bf16, WS_WSSM) + (size_t)(16 * cb) * 1024) : (const void*)(OUTP(unsigned char, OUT_WNA8) + (size_t)(16 * cb) * 1024), 1024, !hi, &a2);
        if (F.wave != 0) continue;
        a1 = a1 * (1.0f / 64.f);
        const int col = 16 * cb + lr; const float gn = SMP(float, SM_SGNA15)[col], gs = SMP(float, SM_SGSSM15)[col];
#pragma unroll
        for (int r = 0; r < 4; ++r) { const int i = 4 * lg + r; SMP(bf16, SM_AMIX15)[i * 2048 + col] = (bf16)f2bf(gn * a1[r] + gs * a2[r]); }
    }
}
__device__ __forceinline__ void p3c_meta(Frame& F) {
    const int lane = F.lane, lr = lane & 15, lg = lane >> 4;
    for (int cb = F.vcu; cb < 128; cb += F.G) {
        const f32x4 acc = meta_nt16<2048>(F, SMP(bf16, SM_AMIX15), 2048, WSP(bf16, WS_WOUT) + (size_t)(16 * cb) * 2048, 2048);
        if (F.wave != 0) continue;
        const int col = 16 * cb + lr; const float mt = F.in[IN_META][15 * DM + col];
#pragma unroll
        for (int r = 0; r < 4; ++r) { const int i = 4 * lg + r; const float v = mt + acc[r]; SMP(bf16, SM_AH2B15)[i * 2048 + col] = (bf16)f2bf(v);
            float ss = v * v;
#pragma unroll
            for (int o = 1; o < 16; o <<= 1) ss += __shfl_xor(ss, o);
            if (lr == 0 && i < NB) atomicAdd((float*)(F.ws + WS_CTL + CTL_ROWSQM) + i, ss); }
    }
}
__device__ __forceinline__ void p4_meta(Frame& F) {
    const int lane = F.lane, lr = lane & 15, lg = lane >> 4;
    for (int cb0 = F.vcu; cb0 < DFF / 32; cb0 += F.G) {
        const int cb = cb0 + (DFF / 32) * (F.wave >> 2), j0 = 16 * cb, wrow = 256 * (j0 >> 7) + (j0 & 127);
        const f32x4 acc = meta_nt16_pair<2048>(F, SMP(bf16, SM_AH2B15), 2048, WSP(bf16, WS_WUP) + (size_t)wrow * 2048, 2048, false);
        if ((F.wave & 3) != 0) continue;
        if (lg == 0) {
#pragma unroll
            for (int r = 0; r < 4; ++r) { const float r2 = 1.0f / sqrtf(((const float*)(F.ws + WS_CTL + CTL_ROWSQM))[r] * (1.0f / DM) + EPS); SMP(float, SM_A15)[r * DFF + j0 + lr] = acc[r] * r2; } }
    }
}

constexpr int NA_K_OFF = 8 * 9216, NA_RPB_OFF = NA_K_OFF + 9 * 8192;
__device__ __forceinline__ void na_prefetch(Frame& F, int gi, v4u (&k)[9], float (&bs)[2]) {
    const int r0 = (2 * gi) & 63, h = (gi >> 5) & 15, b = gi >> 9, rs0 = min(max(r0 - 4, 0), 56);
    const unsigned char* src = (const unsigned char*)(WSP(bf16, WS_K) + (size_t)((b * 16 + h) * 64 + rs0) * 4096) + F.tid * 16;
#pragma unroll
    for (int i = 0; i < 9; ++i) k[i] = *(const v4u*)(src + i * 8192);
#pragma unroll
    for (int q = 0; q < 2; ++q) { const int e = F.tid + 512 * q, x = (e & 63) - 16; bs[q] = (e < 960 && x >= 0 && x < 31) ? F.in[IN_RPB][(h * 15 + (e >> 6)) * 31 + x] : 0.f; }
}
__device__ __forceinline__ void na_commit(Frame& F, const v4u (&k)[9], const float (&bs)[2]) {
#pragma unroll
    for (int i = 0; i < 9; ++i) *(LAS v4u*)(F.lds + NA_K_OFF + i * 8192 + F.tid * 16) = k[i];
#pragma unroll
    for (int q = 0; q < 2; ++q) { const int e = F.tid + 512 * q; if (e < 960) ((LAS float*)(F.lds + NA_RPB_OFF))[e] = bs[q]; }
}
__device__ __forceinline__ void na_qload(Frame& F, int gi, bf16x8 (&qf)[2]) {
    const int qb = F.wave & 3, r = ((2 * gi) & 63) + (F.wave >> 2), h = (gi >> 5) & 15, b = gi >> 9;
    const bf16* Qp = WSP(bf16, WS_Q) + ((size_t)(b * SEQ + r * 64 + 16 * qb) * 1024 + h * 64);
    qf[0] = ldfrag(Qp, 1024, F.lane); qf[1] = ldfrag(Qp + 32, 1024, F.lane);
}
__device__ __forceinline__ void na_task(Frame& F, int gi, LAS bf16* P  , const v4u (&kpre)[9], const float (&bpre)[2], bf16x8 (&qf)[2], bool has_next) {
    const int qb = F.wave & 3, r0 = (2 * gi) & 63, r = r0 + (F.wave >> 2), h = (gi >> 5) & 15, b = gi >> 9;
    const int lane = F.lane, lr = lane & 15, lg = lane >> 4;
    const int w0 = (qb == 0) ? 0 : (qb == 1) ? 8 : (qb == 2) ? 24 : 32;
    const int rs = min(max(r - 4, 0), 56), rs0 = min(max(r0 - 4, 0), 56);
    const int cq = 16 * qb + lr, cs = min(max(cq - 8, 0), 48);
    const bf16x8 qf0 = qf[0], qf1 = qf[1];
    const LAS float* rpb = (const LAS float*)(F.lds + NA_RPB_OFF) + (rs - r + 7) * 64 + 16 + (w0 + 4 * lg - cq + 15);
    bool vld[2][4];
#pragma unroll
    for (int hf = 0; hf < 2; ++hf)
#pragma unroll
        for (int i = 0; i < 4; ++i) vld[hf][i] = (unsigned)(w0 + 16 * hf + 4 * lg + i - cs) < 16u;
    const LAS unsigned char* Kb = F.lds + NA_K_OFF + (rs - rs0) * 8192 + ((w0 >> 3) + (lr >> 3)) * 1024 + lg * 128 + (lr & 7) * 16;
    const bf16* Km = SMP(bf16, SM_KM) + lr * 1024 + h * 64 + 8 * lg;
    const bf16* Vb = WSP(bf16, WS_VT) + ((size_t)((b * 16 + h) * 64 + rs) * 4096 + ((w0 >> 3) + lg) * 128 + lr * 8);
    const bf16* Vm = SMP(bf16, SM_VMT) + (size_t)(h * 64 + 16 * (lr >> 2) + (lr & 3)) * 32 + 8 * lg;
#define NA_KLD(t, ks) (*(const LAS bf16x8*)(Kb + (((t) >> 1) * 8192 + ((t) & 1) * 2048 + (ks) * 512)))
#define NA_SB() __builtin_amdgcn_sched_barrier(0)
    f32x4 s[17];
#define NA_TILE(t, f0, f1) do { f32x4 a_ = {0.f, 0.f, 0.f, 0.f}; a_ = MFMA16((f0), qf0, a_); a_ = MFMA16((f1), qf1, a_); \
        _Pragma("unroll") for (int i = 0; i < 4; ++i) { float bias = rpb[((t) >> 1) * 64 + 16 * ((t) & 1) + i]; asm volatile("" : "+v"(bias)); s[t][i] = vld[(t) & 1][i] ? a_[i] + bias : -INFINITY; } } while (0)
    bf16x8 ka[8], kb[8]; const bf16x8 km0 = *(const bf16x8*)Km, km1 = *(const bf16x8*)(Km + 32);
#pragma unroll
    for (int t = 0; t < 4; ++t) { ka[2 * t] = NA_KLD(t, 0); ka[2 * t + 1] = NA_KLD(t, 1); }
#pragma unroll
    for (int t = 0; t < 4; ++t) { kb[2 * t] = NA_KLD(t + 4, 0); kb[2 * t + 1] = NA_KLD(t + 4, 1); }
    NA_SB();
#pragma unroll
    for (int t = 0; t < 4; ++t) NA_TILE(t, ka[2 * t], ka[2 * t + 1]);
    NA_SB();
#pragma unroll
    for (int t = 0; t < 4; ++t) { ka[2 * t] = NA_KLD(t + 8, 0); ka[2 * t + 1] = NA_KLD(t + 8, 1); }
    NA_SB();
#pragma unroll
    for (int t = 0; t < 4; ++t) NA_TILE(t + 4, kb[2 * t], kb[2 * t + 1]);
    NA_SB();
#pragma unroll
    for (int t = 0; t < 4; ++t) { kb[2 * t] = NA_KLD(t + 12, 0); kb[2 * t + 1] = NA_KLD(t + 12, 1); }
    NA_SB();
#pragma unroll
    for (int t = 0; t < 4; ++t) NA_TILE(t + 8, ka[2 * t], ka[2 * t + 1]);
    NA_SB();
#pragma unroll
    for (int t = 0; t < 4; ++t) NA_TILE(t + 12, kb[2 * t], kb[2 * t + 1]);
    { f32x4 a_ = {0.f, 0.f, 0.f, 0.f}; a_ = MFMA16(km0, qf0, a_); a_ = MFMA16(km1, qf1, a_); s[16] = a_; }
    LDS_WAIT(); __syncthreads();
    if (has_next) { na_commit(F, kpre, bpre); na_qload(F, gi + F.G, qf); }
    NA_SB();
    bf16x8 va[9], vb[9];
#pragma unroll
    for (int s8 = 0; s8 < 8; ++s8) { va[s8] = *(const bf16x8*)(Vb + s8 * 4096); vb[s8] = *(const bf16x8*)(Vb + 1024 + s8 * 4096); }
    va[8] = *(const bf16x8*)Vm; vb[8] = *(const bf16x8*)(Vm + 4 * 32);
    NA_SB();
    float mx = -INFINITY;
#pragma unroll
    for (int t = 0; t < 17; ++t) mx = fmaxf(mx, fmaxf(fmaxf(s[t][0], s[t][1]), fmaxf(s[t][2], s[t][3])));
    mx = fmaxf(mx, __shfl_xor(mx, 16)); mx = fmaxf(mx, __shfl_xor(mx, 32));
    float sum = 0.f;
#pragma unroll
    for (int t = 0; t < 17; ++t) {
#pragma unroll
        for (int i = 0; i < 4; ++i) { const float p = __expf(s[t][i] - mx); s[t][i] = p; sum += p; } }
    sum += __shfl_xor(sum, 16); sum += __shfl_xor(sum, 32);
    const float inv = 1.0f / sum;
#pragma unroll
    for (int t = 0; t < 17; ++t) { v2u w; w.x = cvtpk(s[t][0] * inv, s[t][1] * inv); w.y = cvtpk(s[t][2] * inv, s[t][3] * inv);
        *(LAS v2u*)(P + lr * 288 + t * 16 + 4 * lg) = w; }
    { v2u z; z.x = 0u; z.y = 0u; *(LAS v2u*)(P + lr * 288 + 272 + 4 * lg) = z; }
    LDS_WAIT(); asm volatile("" ::: "memory");
    unsigned char* Op = WSP(unsigned char, WS_O) + ((size_t)(b * SEQ + r * 64 + 16 * qb + lr) * 1024 + h * 64) + 16 * lg;
    unsigned ow[4];
    bf16x8 pf[9];
#pragma unroll
    for (int s8 = 0; s8 < 9; ++s8) pf[s8] = ldfrag_lds(P + 32 * s8, 288, lane);
#define NA_PV(db, vf) do { f32x4 o_ = {0.f, 0.f, 0.f, 0.f}; _Pragma("unroll") for (int s8 = 0; s8 < 9; ++s8) o_ = MFMA16(vf[s8], pf[s8], o_); \
        ow[db] = pk4_fp8(o_[0] * 16.f, o_[1] * 16.f, o_[2] * 16.f, o_[3] * 16.f); } while (0)
    NA_SB();
    NA_PV(0, va);
    NA_SB();
#pragma unroll
    for (int s8 = 0; s8 < 8; ++s8) va[s8] = *(const bf16x8*)(Vb + 2048 + s8 * 4096);
    va[8] = *(const bf16x8*)(Vm + 8 * 32);
    NA_SB();
    NA_PV(1, vb);
    NA_SB();
#pragma unroll
    for (int s8 = 0; s8 < 8; ++s8) vb[s8] = *(const bf16x8*)(Vb + 3072 + s8 * 4096);
    vb[8] = *(const bf16x8*)(Vm + 12 * 32);
    NA_SB();
    NA_PV(2, va);
    NA_SB();
    NA_PV(3, vb);
    { v4u w0; w0.x = ow[0]; w0.y = ow[1]; w0.z = ow[2]; w0.w = ow[3]; *(v4u*)Op = w0; }
    LDS_WAIT(); asm volatile("" ::: "memory");
#undef NA_KLD
#undef NA_TILE
#undef NA_PV
#undef NA_SB
}

typedef float f32x16 __attribute__((ext_vector_type(16)));
#define MFMA32(a, b, c) __builtin_amdgcn_mfma_f32_32x32x16_bf16((a), (b), (c), 0, 0, 0)
constexpr int S5_PP = 528;
constexpr int S5_A = 0, S5_B = 128 * S5_PP, S5_C = 2 * 128 * S5_PP, S5_TOT = S5_C + 8320, S5_M = S5_C + 17408;
constexpr int S5_L5 = S5_M, S5_X0 = S5_M + 5120, S5_XB0 = S5_X0 + 512, S5_U0 = S5_XB0 + 512;
static_assert(S5_U0 + 512 <= MISC_OFF, "S5 LDS map");
template <int BYTES> __device__ __forceinline__ void s5_copy(LAS unsigned char* dst, const unsigned char* src, int tid) {
    unsigned t16 = (unsigned)tid * 16u; asm volatile("" : "+v"(t16));
    constexpr int NIT = (BYTES + 8191) / 8192; v4u tmp[NIT];
#pragma unroll
    for (int i = 0; i < NIT; ++i) if (BYTES % 8192 == 0 || i < NIT - 1 || t16 + i * 8192u < (unsigned)BYTES) tmp[i] = *(const v4u*)(src + t16 + i * 8192u);
#pragma unroll
    for (int i = 0; i < NIT; ++i) if (BYTES % 8192 == 0 || i < NIT - 1 || t16 + i * 8192u < (unsigned)BYTES) *(LAS v4u*)(dst + t16 + i * 8192u) = tmp[i];
}
__device__ __forceinline__ void s5_copy_p(LAS unsigned char* dst, const unsigned char* src, int tid) {
    unsigned t16 = (unsigned)tid * 16u; asm volatile("" : "+v"(t16));
    v4u tmp[8];
#pragma unroll
    for (int i = 0; i < 8; ++i) tmp[i] = *(const v4u*)(src + t16 + i * 8192u);
#pragma unroll
    for (int i = 0; i < 8; ++i) { const unsigned o = t16 + i * 8192u; *(LAS v4u*)(dst + (o >> 9) * S5_PP + (o & 511)) = tmp[i]; }
}
#define S5_LOAD_UF(uf) bf16x8 uf[16]; { unsigned uo_ = (unsigned)(((1 + 32 * wv + r32) * 256 + 8 * h) * 2); asm volatile("" : "+v"(uo_)); const unsigned char* up_ = (const unsigned char*)Ug + uo_; \
    _Pragma("unroll") for (int ks = 0; ks < 16; ++ks) uf[ks] = *(const bf16x8*)(up_ + 32 * ks); }
template <int CTRL> __device__ __forceinline__ float s5_dpp(float x) { return __builtin_bit_cast(float, __builtin_amdgcn_update_dpp(0, __builtin_bit_cast(int, x), CTRL, 0xf, 0xf, false)); }
#define S5_PIN8(A, B, r0) asm volatile("" : "+v"(A[r0]), "+v"(A[r0 + 1]), "+v"(A[r0 + 2]), "+v"(A[r0 + 3]), "+v"(B[r0]), "+v"(B[r0 + 1]), "+v"(B[r0 + 2]), "+v"(B[r0 + 3]))
#define S5_FENCE(p, reg) do { if (((reg) & 3) == 3) { S5_PIN8(S[2 * (p)], S[2 * (p) + 1], (reg) - 3); if ((reg) < 15) S5_PIN8(S[2 * (p)], S[2 * (p) + 1], (reg) + 1); else if ((p) == 0) S5_PIN8(S[2], S[3], 0); } } while (0)
template <int dir> __device__ __forceinline__ void s5_dir(Frame& F, int g, const bf16* Ug, bf16x8 (&xf)[4][2]) {
    LAS unsigned char* L = F.lds;
    const int tid = F.tid, lane = F.lane, r32 = lane & 31, h = lane >> 5, fr = lane & 15, wv = F.wave;
    const unsigned char* ob = (const unsigned char*)F.out;
        s5_copy<8320>(L + S5_C, ob + OUT_CP + (size_t)(dir * 64 + g) * 9216, tid);
        __syncthreads();
        if (dir == 0) {
            const int rho = tid >> 2, qq = tid & 3; float acc = 0.f;
#pragma unroll
            for (int p8 = 0; p8 < 8; ++p8) { const int q = 8 * qq + p8; const v4u pw = *(const LAS v4u*)(L + S5_A + rho * S5_PP + (q << 4)), uw = *(const LAS v4u*)(L + S5_U0 + q * 16);
                acc += bf2f((bf16)(pw.x & 0xffff)) * bf2f((bf16)(uw.x & 0xffff)) + bf2f((bf16)(pw.x >> 16)) * bf2f((bf16)(uw.x >> 16)) + bf2f((bf16)(pw.y & 0xffff)) * bf2f((bf16)(uw.y & 0xffff)) + bf2f((bf16)(pw.y >> 16)) * bf2f((bf16)(uw.y >> 16))
                     + bf2f((bf16)(pw.z & 0xffff)) * bf2f((bf16)(uw.z & 0xffff)) + bf2f((bf16)(pw.z >> 16)) * bf2f((bf16)(uw.z >> 16)) + bf2f((bf16)(pw.w & 0xffff)) * bf2f((bf16)(uw.w & 0xffff)) + bf2f((bf16)(pw.w >> 16)) * bf2f((bf16)(uw.w >> 16)); }
            { int lo_ = lane; asm volatile("" : "+v"(lo_));
              acc += __builtin_bit_cast(float, __builtin_amdgcn_ds_bpermute((lo_ ^ 1) << 2, __builtin_bit_cast(int, acc))); acc += __builtin_bit_cast(float, __builtin_amdgcn_ds_bpermute((lo_ ^ 2) << 2, __builtin_bit_cast(int, acc))); }
            if (qq == 0) { const int part = (rho >> 5) & 1, n = (rho & 31) + 32 * (rho >> 6); ((LAS float*)(L + S5_X0))[part * 64 + n] = acc; }
        }
        f32x16 S[4];
#pragma unroll
        for (int rt = 0; rt < 4; ++rt) S[rt] = (f32x16){0.f,0.f,0.f,0.f,0.f,0.f,0.f,0.f,0.f,0.f,0.f,0.f,0.f,0.f,0.f,0.f};
        { unsigned pbo = (unsigned)((dir ? S5_B : S5_A) + r32 * S5_PP + h * 16); asm volatile("" : "+v"(pbo)); const LAS unsigned char* Pb = L + pbo; S5_LOAD_UF(uf)
#pragma unroll
          for (int ks = 0; ks < 16; ++ks) {
#pragma unroll
            for (int rt = 0; rt < 4; ++rt) S[rt] = MFMA32(*(const LAS bf16x8*)(Pb + rt * 32 * S5_PP + ks * 32), uf[ks], S[rt]); __builtin_amdgcn_sched_barrier(0); } }
        unsigned l5o = (unsigned)(S5_L5 + dir * 2560); asm volatile("" : "+v"(l5o)); const LAS float* L5 = (const LAS float*)(L + l5o); const LAS float* L5h = L5 + 8 * h;
#pragma unroll
        for (int p = 0; p < 2; ++p)
#pragma unroll
            for (int reg = 0; reg < 16; ++reg) { const int n = 32 * p + (reg & 3) + 8 * (reg >> 2);
#define S5_STEP(sstep) { constexpr int CT = (dir ? 0x100 : 0x110) | (1 << (sstep)); const f32x2 lam = *(const LAS f32x2*)(L5h + ((sstep) * 64 + n) * 2); \
                    const float tr = s5_dpp<CT>(S[2 * p][reg]), ti = s5_dpp<CT>(S[2 * p + 1][reg]); S[2 * p][reg] += lam.x * tr - lam.y * ti; S[2 * p + 1][reg] += lam.x * ti + lam.y * tr; }
                S5_STEP(0) S5_STEP(1) S5_STEP(2) S5_STEP(3)
#undef S5_STEP
                S5_FENCE(p, reg); }
        { unsigned tw = (unsigned)(S5_TOT + (2 * wv + (r32 >> 4)) * 512 + h * 16); asm volatile("" : "+v"(tw)); LAS float* tot = (LAS float*)(L + tw);
          if (fr == (dir ? 0 : 15)) {
#pragma unroll
            for (int p = 0; p < 2; ++p)
#pragma unroll
                for (int reg = 0; reg < 16; ++reg) { const int n = 32 * p + (reg & 3) + 8 * (reg >> 2); tot[n] = S[2 * p][reg]; tot[64 + n] = S[2 * p + 1][reg]; } } }
        __syncthreads();
        { unsigned toto = (unsigned)(S5_TOT + lane * 4), x0o = (unsigned)(S5_X0 + lane * 4); asm volatile("" : "+v"(toto), "+v"(x0o));
          const LAS float* tot = (const LAS float*)(L + toto); const f32x2 l256 = *(const LAS f32x2*)(L5 + (4 * 64 + lane) * 2);
          float wr_ = dir ? 0.f : ((const LAS float*)(L + x0o))[0], wi_ = dir ? 0.f : ((const LAS float*)(L + x0o))[64];
          float w0r = 0.f, w0i = 0.f, w1r = 0.f, w1i = 0.f;
          const int s0 = dir ? 2 * wv + 1 : 2 * wv, s1 = dir ? 2 * wv : 2 * wv + 1;
          for (int kk = 0; kk < 16; ++kk) { const int k = dir ? 15 - kk : kk;
              if (k == s0) { w0r = wr_; w0i = wi_; } if (k == s1) { w1r = wr_; w1i = wi_; }
              const float tr = tot[k * 128], ti = tot[k * 128 + 64];
              const float nr = l256.x * wr_ - l256.y * wi_ + tr, ni = l256.x * wi_ + l256.y * wr_ + ti; wr_ = nr; wi_ = ni; }
          if (dir == 1 && wv == 0) { ((LAS float*)(L + x0o))[128] = wr_; ((LAS float*)(L + x0o))[192] = wi_; }
          __syncthreads();
          LAS float* win = (LAS float*)(L + toto);
          win[s0 * 128] = w0r; win[s0 * 128 + 64] = w0i; win[s1 * 128] = w1r; win[s1 * 128 + 64] = w1i; }
        LDS_WAIT(); asm volatile("" ::: "memory");
        { unsigned wino = (unsigned)(S5_TOT + (2 * wv + (r32 >> 4)) * 512 + h * 16), cpo = (unsigned)(S5_C + fr * 520 + h * 32); asm volatile("" : "+v"(wino), "+v"(cpo));
          const LAS float* win = (const LAS float*)(L + wino); const LAS float* CP = (const LAS float*)(L + cpo);
#pragma unroll
          for (int p = 0; p < 2; ++p)
#pragma unroll
            for (int reg = 0; reg < 16; ++reg) { const int n = 32 * p + (reg & 3) + 8 * (reg >> 2);
                const float er = s5_dpp<(dir ? 0x100 : 0x110) | 1>(S[2 * p][reg]), ei = s5_dpp<(dir ? 0x100 : 0x110) | 1>(S[2 * p + 1][reg]);
                const f32x2 cp = *(const LAS f32x2*)(CP + 2 * n); const float wr_ = win[n], wi_ = win[64 + n];
                S[2 * p][reg] = er + cp.x * wr_ - cp.y * wi_; S[2 * p + 1][reg] = ei + cp.x * wi_ + cp.y * wr_; S5_FENCE(p, reg); }
#pragma unroll
          for (int rt = 0; rt < 4; ++rt)
#pragma unroll
            for (int s = 0; s < 2; ++s) { v4u w; w.x = cvtpk(S[rt][8 * s], S[rt][8 * s + 1]); w.y = cvtpk(S[rt][8 * s + 2], S[rt][8 * s + 3]); w.z = cvtpk(S[rt][8 * s + 4], S[rt][8 * s + 5]); w.w = cvtpk(S[rt][8 * s + 6], S[rt][8 * s + 7]);
                xf[rt][s] = __builtin_bit_cast(bf16x8, w); } }
        __syncthreads();
}
__device__ __forceinline__ void s5_block(Frame& F, int b, int g) {
    LAS unsigned char* L = F.lds;
    const int tid = F.tid, lane = F.lane, r32 = lane & 31, h = lane >> 5, fr = lane & 15, wv = F.wave;
    const unsigned char* ob = (const unsigned char*)F.out;
    const bf16* Ug = WSP(bf16, WS_U) + (size_t)(b * 64 + g) * LPOS * 16;
    s5_copy_p(L + S5_A, ob + OUT_P + (size_t)g * 65536, tid);
    s5_copy_p(L + S5_B, ob + OUT_P + (size_t)(64 + g) * 65536, tid);
    s5_copy<2560>(L + S5_L5, ob + OUT_L5 + (size_t)g * 2560, tid);
    s5_copy<2560>(L + S5_L5 + 2560, ob + OUT_L5 + (size_t)(64 + g) * 2560, tid);
    if (tid < 32) *(LAS v4u*)(L + S5_U0 + tid * 16) = *(const v4u*)((const unsigned char*)Ug + tid * 16);
    bf16x8 xf0[4][2], xf1[4][2];
    s5_dir<0>(F, g, Ug, xf0);
    s5_dir<1>(F, g, Ug, xf1);
    s5_copy<65536>(L + S5_A, ob + OUT_R + (size_t)g * 65536, tid);
    s5_copy<65536>(L + S5_B, ob + OUT_R + (size_t)(64 + g) * 65536, tid);
    s5_copy<8704>(L + S5_C, ob + OUT_KL + (size_t)g * 9216, tid);
    s5_copy<8704>(L + S5_C + 8704, ob + OUT_KL + (size_t)(64 + g) * 9216, tid);
    __syncthreads();
    { S5_LOAD_UF(uf)
#pragma unroll
    for (int hf = 0; hf < 4; ++hf) {
        f32x16 Y[2];
#pragma unroll
        for (int t2 = 0; t2 < 2; ++t2) Y[t2] = (f32x16){0.f,0.f,0.f,0.f,0.f,0.f,0.f,0.f,0.f,0.f,0.f,0.f,0.f,0.f,0.f,0.f};
#pragma unroll
        for (int t2 = 0; t2 < 2; ++t2) { const int RT = 2 * hf + t2;
            unsigned kfo = (unsigned)(S5_C + ((r32 & 15) * 16 + 8 * h) * 2 + (r32 >> 4) * 512), kbo = (unsigned)(S5_C + 8704 + ((r32 & 15) * 16 + 8 * h) * 2 - (r32 >> 4) * 512);
            asm volatile("" : "+v"(kfo), "+v"(kbo)); const LAS unsigned char* KLf = L + kfo; const LAS unsigned char* KLb = L + kbo;
#pragma unroll
            for (int ks = 0; ks < 16; ++ks) {
                if (ks <= 2 * RT + 1) Y[t2] = MFMA32(*(const LAS bf16x8*)(KLf + (2 * RT - ks + 1) * 512), uf[ks], Y[t2]);
                if (ks >= 2 * RT) Y[t2] = MFMA32(*(const LAS bf16x8*)(KLb + (ks - 2 * RT + 1) * 512), uf[ks], Y[t2]); __builtin_amdgcn_sched_barrier(0); }
            unsigned fx = (unsigned)((fr ^ h) << 4); asm volatile("" : "+v"(fx));
#pragma unroll
            for (int dir = 0; dir < 2; ++dir) { unsigned rbo = (unsigned)((dir ? S5_B : S5_A) + r32 * 256); asm volatile("" : "+v"(rbo)); const LAS unsigned char* Rb = L + rbo + RT * 8192;
#pragma unroll
                for (int rt = 0; rt < 4; ++rt)
#pragma unroll
                    for (int s = 0; s < 2; ++s) { Y[t2] = MFMA32(*(const LAS bf16x8*)(Rb + (((rt * 2 + s) * 32) ^ fx)), (dir ? xf1[rt][s] : xf0[rt][s]), Y[t2]); __builtin_amdgcn_sched_barrier(0); } } }
        const int chunk = 1 + 32 * wv + r32;
#pragma unroll
        for (int t2 = 0; t2 < 2; ++t2)
#pragma unroll
            for (int il = 0; il < 2; ++il) { const int pos = chunk * 16 + 2 * (2 * hf + t2) + il; bf16* yp = OUTP(bf16, OUT_YG) + (size_t)(b * SEQ + pos - 16) * 1024 + g * 16 + 4 * h;
#pragma unroll
                for (int cg = 0; cg < 2; ++cg) { const int r0 = 8 * il + 4 * cg; v2u w; w.x = cvtpk(gelu_tanh(Y[t2][r0]), gelu_tanh(Y[t2][r0 + 1])); w.y = cvtpk(gelu_tanh(Y[t2][r0 + 2]), gelu_tanh(Y[t2][r0 + 3]));
                    *(v2u*)(yp + 8 * cg) = w; } }
        __builtin_amdgcn_sched_barrier(0);
    } }
    if (tid < 256) {
        const int c = tid >> 4, q = tid & 15; float acc = 0.f;
        { const LAS unsigned char* kf = L + S5_C + ((16 - q) * 256 + c * 16) * 2; const LAS unsigned char* u0 = L + S5_U0 + q * 32;
#pragma unroll
          for (int e = 0; e < 16; ++e) acc += bf2f(*(const LAS bf16*)(kf + 2 * e)) * bf2f(*(const LAS bf16*)(u0 + 2 * e)); }
        if (q == 0) { const LAS unsigned char* kb = L + S5_C + 8704 + (1 * 256 + c * 16) * 2; const LAS unsigned char* u15 = L + S5_U0 + 15 * 32;
#pragma unroll
          for (int e = 0; e < 16; ++e) acc += bf2f(*(const LAS bf16*)(kb + 2 * e)) * bf2f(*(const LAS bf16*)(u15 + 2 * e)); }
        { const int row = 240 + c; const LAS unsigned char* rp = L + S5_B + row * 256 + ((q ^ (row & 15)) << 4); const LAS float* xb0 = (const LAS float*)(L + S5_XB0);
          const int rt = q >> 2, s = (q >> 1) & 1, hh = q & 1;
#pragma unroll
          for (int j = 0; j < 8; ++j) { const int sig = 16 * s + 8 * (j >> 2) + 4 * hh + (j & 3); acc += bf2f(*(const LAS bf16*)(rp + 2 * j)) * xb0[(rt & 1) * 64 + 32 * (rt >> 1) + sig]; } }
#pragma unroll
        for (int o = 1; o < 16; o <<= 1) acc += __shfl_xor(acc, o);
        if (q == 0) SMP(bf16, SM_AYG15)[b * 1024 + g * 16 + c] = (bf16)f2bf(gelu_tanh(acc));
    }
    __syncthreads();
}

__device__ __forceinline__ void p5_fixup_panel(Frame& F, int pm) {
    const float* EA = WSP(float, WS_EA); const float* EP = WSP(float, WS_EP); const float* EG = WSP(float, WS_EG);
    const float* cw = F.in[IN_CONVW]; bf16* ACT = WSP(bf16, WS_ACT);
    for (int j = F.tid * 4; j < DFF; j += NWAVES * 64 * 4) {
        const f32x4 w0 = *(const f32x4*)(cw + j), w2 = *(const f32x4*)(cw + 2 * DFF + j);
        f32x4 p[8], g[8], nb[8];
#pragma unroll
        for (int e = 0; e < 8; e += 7) { const int er = 8 * pm + e, eblk = er >> 1, side = er & 1, row = eblk * 64 + (side ? 63 : 0);
            p[e] = *(const f32x4*)(EP + (size_t)er * DFF + j); g[e] = *(const f32x4*)(EG + (size_t)er * DFF + j);
            if (!side) nb[e] = ((row & 4095) == 0) ? *(const f32x4*)(SMP(float, SM_A15) + (row >> 12) * DFF + j) : *(const f32x4*)(EA + (size_t)((eblk - 1) * 2 + 1) * DFF + j);
            else nb[e] = ((row & 4095) == 4095) ? (f32x4){0.f, 0.f, 0.f, 0.f} : *(const f32x4*)(EA + (size_t)((eblk + 1) * 2) * DFF + j); }
#pragma unroll
        for (int e = 0; e < 8; e += 7) { const int er = 8 * pm + e, row = (er >> 1) * 64 + ((er & 1) ? 63 : 0); const f32x4 v = p[e] + ((er & 1) ? w2 : w0) * nb[e];
            v2u w; w.x = cvtpk(gelu_tanh(v[0]) * g[e][0], gelu_tanh(v[1]) * g[e][1]); w.y = cvtpk(gelu_tanh(v[2]) * g[e][2], gelu_tanh(v[3]) * g[e][3]);
            *(v2u*)(ACT + (size_t)row * DFF + j) = w; }
    }
}
__device__ __forceinline__ void p7_final(Frame& F) {
    const float* rowsq = (const float*)(F.ws + WS_CTL + CTL_ROWSQ3); const f32x4* gf = (const f32x4*)F.in[IN_GF] + F.lane;
    for (int m = F.gw; m < M; m += 2 * F.NGW) {
        const int m2 = m + F.NGW;
        const float rs = 1.0f / sqrtf(rowsq[m] * (1.0f / DM) + EPS), rs2 = 1.0f / sqrtf(rowsq[m2] * (1.0f / DM) + EPS);
        const v2u* hr = (const v2u*)(WSP(bf16, WS_H3B) + (size_t)m * DM) + F.lane; const v2u* hr2 = (const v2u*)(WSP(bf16, WS_H3B) + (size_t)m2 * DM) + F.lane;
        f32x4* xr = (f32x4*)(F.out + (size_t)m * DM) + F.lane; f32x4* xr2 = (f32x4*)(F.out + (size_t)m2 * DM) + F.lane;
        v2u a[8], b[8];
#pragma unroll
        for (int j = 0; j < 8; ++j) { a[j] = hr[64 * j]; b[j] = hr2[64 * j]; }
#pragma unroll
        for (int j = 0; j < 8; ++j) { const f32x4 g = gf[64 * j];
            f32x4 va, vb; va[0] = __builtin_bit_cast(float, a[j].x << 16); va[1] = __builtin_bit_cast(float, a[j].x & 0xffff0000u); va[2] = __builtin_bit_cast(float, a[j].y << 16); va[3] = __builtin_bit_cast(float, a[j].y & 0xffff0000u);
            vb[0] = __builtin_bit_cast(float, b[j].x << 16); vb[1] = __builtin_bit_cast(float, b[j].x & 0xffff0000u); vb[2] = __builtin_bit_cast(float, b[j].y << 16); vb[3] = __builtin_bit_cast(float, b[j].y & 0xffff0000u);
            xr[64 * j] = va * rs * g; xr2[64 * j] = vb * rs2 * g; }
    }
}

#ifndef MK_N_LAUNCHES
#define MK_N_LAUNCHES 1
#endif
constexpr int N_PHASES = 10;
#ifndef GEMM_ALIGN
#define GEMM_ALIGN true
#endif
#ifndef GEMM_SP2
#define GEMM_SP2 true
#endif
struct Args { const float* in[23]; float* out; unsigned char* ws; int ph_lo, ph_hi, li, pad; };
__global__ void __launch_bounds__(NWAVES * 64, 2) skel_fwd(Args args) {
    extern __shared__ __attribute__((aligned(16))) unsigned char lds_raw[];
    Frame F;
    F.lds = (LAS unsigned char*)lds_raw;
    F.tid = threadIdx.x; F.lane = F.tid & 63; F.wave = __builtin_amdgcn_readfirstlane(F.tid >> 6);
    F.G = gridDim.x; { const int bx = blockIdx.x; F.vcu = (F.G % 8 == 0) ? (bx % 8) * (F.G / 8) + bx / 8 : bx; }
    F.gw = F.vcu * NWAVES + F.wave; F.NGW = F.G * NWAVES;
#pragma unroll
    for (int i = 0; i < 23; ++i) F.in[i] = args.in[i];
    F.out = args.out; F.ws = args.ws;
    volatile LAS unsigned* MISC = (volatile LAS unsigned*)(F.lds + MISC_OFF);
    for (int u = F.tid; u < (LDS_BYTES - RING_BYTES) / 4; u += NWAVES * 64) ((LAS unsigned*)(F.lds + RING_BYTES))[u] = 0u;
    __syncthreads();
    XcdBarrier bar; bar.bar = (unsigned*)(F.ws + WS_CTL) + CW_BAR; bar.x = 0; bar.st = nullptr;
    if (MK_N_LAUNCHES == 1) bar = xcd_barrier_post((unsigned*)(F.ws + WS_CTL) + CW_BAR, MISC + 8);
    const int lo = args.ph_lo, hi = args.ph_hi;
#define IN(k) (lo <= (k) && (k) < hi)
#define SEAM(k) do { if (IN(k) && IN((k) + 1)) xcd_barrier(bar); } while (0)
    const int bid = (int)blockIdx.x;

    if (IN(0)) { p0_prologue(F); } SEAM(0);

    if (IN(1)) {
        p1_meta(F); VM_WAIT(); __syncthreads();
        { pg8::Gemm g{WSP(bf16, WS_XB), WSP(bf16, WS_WIN) + (size_t)2048 * DM, M, 1024, DM}; pg8::StaticOrder S; S.init(M, 1024, F.G, bid);
          EpiG1 E{SMP(float, SM_R1), WSP(bf16, WS_Q), WSP(bf16, WS_K), WSP(bf16, WS_U), WSP(unsigned char, WS_SGNA), WSP(unsigned char, WS_SGSSM), 8};
          pg8::gemm_phase<EpiG1, pg8::StaticOrder, GEMM_ALIGN, GEMM_SP2>(F.lds, g, S, E);
          }
        { pg8::Gemm g{OUTP(bf16, OUT_XB8), OUTP(bf16, OUT_W8), M, 6144, DM / 2, OUTP(bf16, OUT_WV8), OUTP(bf16, OUT_XB8)};
          pg8::DualOrder S; S.init(M, 6144, 1024, M, F.G, bid);
          EpiP1 E{EpiQKG{SMP(float, SM_R1), WSP(bf16, WS_Q), WSP(bf16, WS_K), WSP(unsigned char, WS_SGNA), WSP(unsigned char, WS_SGSSM)}, EpiVt{SMP(float, SM_R1), WSP(bf16, WS_VT)}};
          pg8::gemm_phase<EpiP1, pg8::DualOrder, GEMM_ALIGN, GEMM_SP2, true>(F.lds, g, S, E);
          }
    } SEAM(1);

    if (IN(2)) {
        for (int bg = F.vcu; bg < NB * 64; bg += F.G) s5_block(F, bg >> 6, bg & 63);
        if (F.wave == 7 && F.vcu < NHEAD) p2_meta_attn(F, F.vcu);
        LAS bf16* P = (LAS bf16*)(F.lds + F.wave * 9216);
        { constexpr int NGRP = NB * NHEAD * 32;
          v4u kp[9]; float bp[2]; bf16x8 qf[2]; int gi = F.vcu;
          if (gi < NGRP) { na_prefetch(F, gi, kp, bp); na_commit(F, kp, bp); na_qload(F, gi, qf); }
          __syncthreads();
          for (; gi < NGRP; gi += F.G) { const bool hn = gi + F.G < NGRP;
              if (hn) na_prefetch(F, gi + F.G, kp, bp);
              na_task(F, gi, P, kp, bp, qf, hn);
              __syncthreads(); } }
    } SEAM(2);

    if (IN(3)) {
        p3a_meta(F); VM_WAIT(); __syncthreads();
        pg8::Gemm g{OUTP(bf16, OUT_YG), WSP(bf16, WS_WGLU), M, 1024, 1024}; pg8::StaticOrder S; S.init(M, 1024, F.G, bid);
        EpiGlu E{OUTP(bf16, OUT_YG), OUTP(bf16, OUT_SGLU)};
        pg8::gemm_phase<EpiGlu, pg8::StaticOrder, GEMM_ALIGN, GEMM_SP2>(F.lds, g, S, E);
    } SEAM(3);

    if (IN(4)) {
        p3b_meta(F); VM_WAIT(); __syncthreads();
        { pg8::Gemm g{WSP(bf16, WS_O), OUTP(bf16, OUT_WNA8), M, DM, 512}; pg8::StaticOrder S; S.init(M, DM, F.G, bid);
          EpiMix<false> E{WSP(unsigned char, WS_SGNA), WSP(bf16, WS_MIX), 1.0f / (255.f * 1024.f)};
          pg8::gemm_phase<EpiMix<false>, pg8::StaticOrder, GEMM_ALIGN, GEMM_SP2, true>(F.lds, g, S, E);
          }
        { pg8::Gemm g{OUTP(bf16, OUT_SGLU), WSP(bf16, WS_WSSM), M, DM, 1024}; pg8::StaticOrder S; S.init(M, DM, F.G, bid);
          EpiMix<true> E{WSP(unsigned char, WS_SGSSM), WSP(bf16, WS_MIX), 1.0f / 255.f};
          pg8::gemm_phase<EpiMix<true>, pg8::StaticOrder, GEMM_ALIGN, GEMM_SP2>(F.lds, g, S, E); }
    } SEAM(4);

    if (IN(5)) {
        p3c_meta(F); VM_WAIT(); __syncthreads();
        pg8::Gemm g{WSP(bf16, WS_MIX), WSP(bf16, WS_WOUT), M, DM, DM}; pg8::StaticOrder S; S.init(M, DM, F.G, bid);
        EpiRes<true> E{WSP(bf16, WS_XB), WSP(bf16, WS_H2B), (float*)(F.ws + WS_CTL + CTL_ROWSQ2)};
        pg8::gemm_phase<EpiRes<true>, pg8::StaticOrder, GEMM_ALIGN, GEMM_SP2>(F.lds, g, S, E);
    } SEAM(5);

    if (IN(6)) {
        p4_meta(F); VM_WAIT(); __syncthreads();
        pg8::Gemm g{WSP(bf16, WS_H2B), WSP(bf16, WS_WUP), M, 2 * DFF, DM}; pg8::StaticOrder S; S.init(M, 2 * DFF, F.G, bid);
        EpiUp E{(const float*)(F.ws + WS_CTL + CTL_ROWSQ2), F.in[IN_CONVW], F.in[IN_CONVB], WSP(bf16, WS_ACT), WSP(float, WS_EA), WSP(float, WS_EP), WSP(float, WS_EG), F.lds + RING_BYTES};
        pg8::gemm_phase<EpiUp, pg8::StaticOrder, GEMM_ALIGN, GEMM_SP2>(F.lds, g, S, E);
    } SEAM(6);

    if (IN(8)) {
        pg8::Gemm g{WSP(bf16, WS_ACT), WSP(bf16, WS_WDOWN), M, DM, DFF}; pg8::StaticOrder S; S.init(M, DM, F.G, bid);
        { pg8::Unit u; int lastpm = -1; for (int i = 0; S.next(i, u); ++i) if (u.pm != lastpm) { p5_fixup_panel(F, u.pm); lastpm = u.pm; } }
        VM_WAIT(); __syncthreads();
        EpiRes<false> E{WSP(bf16, WS_H2B), WSP(bf16, WS_H3B), (float*)(F.ws + WS_CTL + CTL_ROWSQ3)};
        pg8::gemm_phase<EpiRes<false>, pg8::StaticOrder, GEMM_ALIGN, GEMM_SP2>(F.lds, g, S, E);
    } SEAM(8);

    if (IN(9)) { p7_final(F); }

#undef IN
#undef SEAM
}

extern "C" void kernel_launch(void* const* d_in, const int* in_sizes, int n_in, void* d_out, int out_size, void* d_ws, size_t ws_size, hipStream_t stream) {
    static int grid = 0;
    if (grid == 0) {
        if (n_in != 23 || out_size != M * DM || ws_size < WS_END) { fprintf(stderr, "kernel_launch: unexpected shapes (n_in %d out %d ws %zu)\n", n_in, out_size, ws_size); grid = -1; return; }
        int dev = 0, cus = 0, per_cu = 0;
        if (hipGetDevice(&dev) != hipSuccess || hipDeviceGetAttribute(&cus, hipDeviceAttributeMultiprocessorCount, dev) != hipSuccess) { grid = -1; return; }
        if (hipFuncSetAttribute((const void*)skel_fwd, hipFuncAttributeMaxDynamicSharedMemorySize, LDS_BYTES) != hipSuccess) { fprintf(stderr, "kernel_launch: hipFuncSetAttribute failed\n"); grid = -1; return; }
        if (hipOccupancyMaxActiveBlocksPerMultiprocessor(&per_cu, (const void*)skel_fwd, NWAVES * 64, LDS_BYTES) != hipSuccess || per_cu < 1) fprintf(stderr, "kernel_launch: occupancy query reports %d\n", per_cu);
        (void)hipGetLastError();
        grid = cus;
    }
    if (grid < 0) return;
    if (hipMemsetAsync((char*)d_ws + WS_CTL, 0, CTL_ZERO_BYTES, stream) != hipSuccess) return;
    Args a{};
    for (int i = 0; i < 23; ++i) a.in[i] = (const float*)d_in[i];
    a.out = (float*)d_out; a.ws = (unsigned char*)d_ws;
    const int nl = MK_N_LAUNCHES;
    for (int li = 0; li < nl; ++li) {
        a.ph_lo = (MK_N_LAUNCHES == 1) ? 0 : li; a.ph_hi = (MK_N_LAUNCHES == 1) ? N_PHASES : li + 1; a.li = li;
        hipLaunchKernelGGL(skel_fwd, dim3(grid), dim3(NWAVES * 64), LDS_BYTES, stream, a);
        const hipError_t le = hipPeekAtLastError();
        if (le != hipSuccess) { fprintf(stderr, "kernel_launch: launch %d failed: %s\n", li, hipGetErrorName(le)); break; }
    }
}
```

```cpp
#include <hip/hip_runtime.h>
#include <cstdio>
#include <cstdint>
#define MK_N_LAUNCHES 1
namespace pg8 {
#define PG8_LAS __attribute__((address_space(3)))
typedef unsigned short bf16_t;
typedef short bf16x8 __attribute__((ext_vector_type(8)));
typedef float f32x4 __attribute__((ext_vector_type(4)));
typedef unsigned u32x4 __attribute__((ext_vector_type(4)));
constexpr int BM = 256, BK = 64, HALF = 128, HTB = HALF * BK * 2  , STAGE_BYTES = 8 * HTB, NXCD = 8, WGM = 8;

__host__ __device__ __forceinline__ int lds_byte(int r, int c) { const int st = (r >> 4) * 2 + (c >> 5), rr = r & 15, cc = c & 31, ob = rr * 64 + cc * 2; return st * 1024 + (ob ^ (((ob >> 9) & 1) << 5)); }
__host__ __device__ __forceinline__ void stage_rc(int b, int& R, int& C) { const int st = b / 1024, sb = b % 1024, swz = sb ^ (((sb >> 9) & 1) << 5); R = (st >> 1) * 16 + swz / 64; C = (st & 1) * 32 + (swz % 64) / 2; }
__host__ __device__ __forceinline__ int perm32(int rho) { const int n = rho >> 4, i = rho & 15; return 8 * (i >> 2) + 4 * n + (i & 3); }

struct Unit { int pm, pn; };
struct Gemm { const bf16_t* A; const bf16_t* Bt; int M, N, K; };

struct StaticOrder {
    int nM, nN, nwg, G, c;
    __host__ __device__ void init(int M, int N, int G_, int c_) { nM = M / BM; nN = N / BM; nwg = nM * nN; G = G_; c = c_; }
    __host__ __device__ bool next(int i, Unit& u) const {
        const long L = (long)i * G + c; if (L >= nwg) return false;
        int wgid = (int)L; { const int q = nwg / NXCD, r = nwg % NXCD, xcd = wgid % NXCD, off = wgid / NXCD; wgid = (xcd < r ? xcd * (q + 1) : r * (q + 1) + (xcd - r) * q) + off; }
        const int nig = WGM * nN, gid = wgid / nig, fm = gid * WGM, gsz = (nM - fm) < WGM ? (nM - fm) : WGM;
        u.pm = fm + ((wgid % nig) % gsz); u.pn = (wgid % nig) / gsz; return true;
    }
    __device__ __forceinline__ void a_ready(const Unit&) const {}
    __device__ __forceinline__ void done(const Unit&) const {}
};

__device__ __forceinline__ unsigned cvt_pk_bf16(float lo, float hi) { unsigned r; asm volatile("v_cvt_pk_bf16_f32 %0, %1, %2" : "=v"(r) : "v"(lo), "v"(hi)); return r; }
typedef float f32x2 __attribute__((ext_vector_type(2)));
typedef int v8i32 __attribute__((ext_vector_type(8)));
typedef int i32x4_ __attribute__((ext_vector_type(4)));
template <class Epi, class Sched, bool ALIGN_EPI = false, bool SP2 = false, bool F8 = false>
__device__ __forceinline__ void gemm_phase(PG8_LAS unsigned char* lds, const Gemm g, const Sched& S, const Epi& E) {
    const int tid = threadIdx.x, wid = __builtin_amdgcn_readfirstlane(tid >> 6), lane = tid & 63, wr = wid >> 2, wc = wid & 3, fr = lane & 15, fq = lane >> 4;
    const int K = g.K, nt = K / BK;
    unsigned voffA[2], voffB[2];
#pragma unroll
    for (int i = 0; i < 2; ++i) { int R, C; stage_rc(tid * 16 + i * 8192, R, C); const int Rb = Epi::PERM ? ((R & ~31) + perm32(R & 31)) : R;
        const int Ra = Epi::APERM ? ((R & ~63) + 4 * (R & 15) + ((R >> 4) & 3)) : R;
        voffA[i] = (unsigned)(Ra * K + C) * 2u; voffB[i] = (unsigned)(Rb * K + C) * 2u; }
    const size_t kstep = (size_t)(BK * 2);
    const size_t hstep = (size_t)HALF * K * 2;
    const size_t tstep = 2 * hstep;
    const unsigned ldsw = (unsigned)wid * 1024u;
    const int aoff = lds_byte(wr * 64 + fr, fq * 8), boff = lds_byte(wc * 32 + fr, fq * 8);
#define PG8_SA(b, h) (((b) * 2 + (h)) * HTB)
#define PG8_SB(b, h) ((4 + (b) * 2 + (h)) * HTB)
#define PG8_STAGE(bufoff, gbase, voff) do { _Pragma("unroll") for (int _i = 0; _i < 2; ++_i) \
        __builtin_amdgcn_global_load_lds((const unsigned*)((const char*)(gbase) + (voff)[_i]), (PG8_LAS unsigned*)(lds + (bufoff) + ldsw + _i * 8192), 16, 0, 0); } while (0)
#define PG8_LDA(dst, b, h) do { _Pragma("unroll") for (int m = 0; m < 4; ++m) _Pragma("unroll") for (int k = 0; k < 2; ++k) dst[m][k] = *(const PG8_LAS bf16x8*)(lds + PG8_SA(b, h) + aoff + m * 2048 + k * 1024); } while (0)
#define PG8_LDB(dst, b, h) do { _Pragma("unroll") for (int n = 0; n < 2; ++n) _Pragma("unroll") for (int k = 0; k < 2; ++k) dst[n][k] = *(const PG8_LAS bf16x8*)(lds + PG8_SB(b, h) + boff + n * 2048 + k * 1024); } while (0)
#define PG8_CAT8(x, y) (__builtin_shufflevector(__builtin_bit_cast(i32x4_, x), __builtin_bit_cast(i32x4_, y), 0, 1, 2, 3, 4, 5, 6, 7))
#define PG8_MMA(ai, bj, At, Bt) do { __builtin_amdgcn_s_setprio(1); \
        if constexpr (F8) { _Pragma("unroll") for (int m = 0; m < 4; ++m) _Pragma("unroll") for (int n = 0; n < 2; ++n) { const v8i32 b8_ = PG8_CAT8(Bt[n][0], Bt[n][1]), a8_ = PG8_CAT8(At[m][0], At[m][1]); \
            asm volatile("v_mfma_f32_16x16x128_f8f6f4 %0, %1, %2, %0" : "+v"(acc[ai][bj][m][n]) : "v"(b8_), "v"(a8_)); } } \
        else { _Pragma("unroll") for (int m = 0; m < 4; ++m) _Pragma("unroll") for (int n = 0; n < 2; ++n) _Pragma("unroll") for (int k = 0; k < 2; ++k) \
            acc[ai][bj][m][n] = __builtin_amdgcn_mfma_f32_16x16x32_bf16(Bt[n][k], At[m][k], acc[ai][bj][m][n], 0, 0, 0); } __builtin_amdgcn_s_setprio(0); } while (0)
#define PG8_WAIT_V(n) asm volatile("s_waitcnt vmcnt(" #n ")" ::: "memory")
#define PG8_WAIT_L(n) asm volatile("s_waitcnt lgkmcnt(" #n ")" ::: "memory")
#define PG8_BAR __builtin_amdgcn_s_barrier()
#define PG8_SCHED __builtin_amdgcn_sched_barrier(0)
    Unit cur, nxt; int ui = 0;
    if (!S.next(0, cur)) return;
    f32x4 acc[2][2][4][2];
#pragma unroll
    for (int a = 0; a < 2; ++a)
#pragma unroll
        for (int b = 0; b < 2; ++b)
#pragma unroll
            for (int m = 0; m < 4; ++m)
#pragma unroll
                for (int n = 0; n < 2; ++n) acc[a][b][m][n] = (f32x4){0.f, 0.f, 0.f, 0.f};
    bf16x8 At[4][2], B0[2][2], B1[2][2];
    const char* cA = (const char*)g.A + (size_t)cur.pm * tstep; const char* cB = (const char*)g.Bt + (size_t)cur.pn * tstep;
    S.a_ready(cur);
    if constexpr (SP2) {
        PG8_STAGE(PG8_SB(0, 0), cB, voffB); PG8_STAGE(PG8_SB(0, 1), cB + hstep, voffB); PG8_STAGE(PG8_SA(0, 0), cA, voffA); PG8_STAGE(PG8_SA(0, 1), cA + hstep, voffA);
        if (wr == 1) PG8_BAR;
        PG8_WAIT_V(2); PG8_BAR;
        PG8_STAGE(PG8_SB(1, 0), cB + kstep, voffB); PG8_STAGE(PG8_SA(1, 0), cA + kstep, voffA); PG8_STAGE(PG8_SB(1, 1), cB + hstep + kstep, voffB);
        PG8_WAIT_V(6); PG8_BAR;
    } else {
        PG8_STAGE(PG8_SB(0, 0), cB, voffB); PG8_STAGE(PG8_SA(0, 0), cA, voffA); PG8_STAGE(PG8_SB(0, 1), cB + hstep, voffB); PG8_STAGE(PG8_SA(0, 1), cA + hstep, voffA);
        if (wr == 1) PG8_BAR;
        PG8_WAIT_V(4); PG8_BAR;
        PG8_STAGE(PG8_SB(1, 0), cB + kstep, voffB); PG8_STAGE(PG8_SA(1, 0), cA + kstep, voffA); PG8_STAGE(PG8_SB(1, 1), cB + hstep + kstep, voffB);
        PG8_WAIT_V(6); PG8_BAR;
    }
    for (;;) {
        const bool has_next = S.next(ui + 1, nxt);
        const char* nA = has_next ? (const char*)g.A + (size_t)nxt.pm * tstep : cA; const char* nB = has_next ? (const char*)g.Bt + (size_t)nxt.pn * tstep : cB;
        for (int t = 0; t < nt; t += 2) {
            const bool last = (t == nt - 2);
            const char* a1 = cA + (size_t)(t + 1) * kstep;
            const char* a2 = last ? nA : cA + (size_t)(t + 2) * kstep; const char* b2 = last ? nB : cB + (size_t)(t + 2) * kstep;
            const char* a3 = a2 + kstep; const char* b3 = b2 + kstep;
            if (last && has_next) S.a_ready(nxt);
            if constexpr (SP2) {
            PG8_LDB(B0, 0, 0); PG8_LDB(B1, 0, 1); PG8_SCHED; PG8_LDA(At, 0, 0); PG8_STAGE(PG8_SA(1, 1), a1 + hstep, voffA);
            PG8_WAIT_V(8); PG8_WAIT_L(0); PG8_BAR; PG8_MMA(0, 0, At, B0); PG8_MMA(0, 1, At, B1); PG8_BAR; PG8_SCHED;
            PG8_LDA(At, 0, 1); PG8_STAGE(PG8_SB(0, 0), b2, voffB); PG8_STAGE(PG8_SB(0, 1), b2 + hstep, voffB); PG8_STAGE(PG8_SA(0, 0), a2, voffA);
            PG8_WAIT_V(8); PG8_WAIT_L(0); PG8_BAR; PG8_MMA(1, 0, At, B0); PG8_MMA(1, 1, At, B1); PG8_BAR; PG8_SCHED;
            PG8_LDB(B0, 1, 0); PG8_LDB(B1, 1, 1); PG8_SCHED; PG8_LDA(At, 1, 0); PG8_STAGE(PG8_SA(0, 1), a2 + hstep, voffA);
            PG8_WAIT_V(8); PG8_WAIT_L(0); PG8_BAR; PG8_MMA(0, 0, At, B0); PG8_MMA(0, 1, At, B1); PG8_BAR; PG8_SCHED;
            PG8_LDA(At, 1, 1); PG8_STAGE(PG8_SB(1, 0), b3, voffB); PG8_STAGE(PG8_SB(1, 1), b3 + hstep, voffB); PG8_STAGE(PG8_SA(1, 0), a3, voffA);
            PG8_WAIT_V(8); PG8_WAIT_L(0); PG8_BAR; PG8_MMA(1, 0, At, B0); PG8_MMA(1, 1, At, B1); PG8_BAR; PG8_SCHED;
            } else {
            PG8_LDB(B0, 0, 0); PG8_SCHED; PG8_LDA(At, 0, 0); PG8_STAGE(PG8_SA(1, 1), a1 + hstep, voffA);
            PG8_WAIT_L(8); PG8_BAR; PG8_WAIT_L(0); PG8_MMA(0, 0, At, B0); PG8_BAR; PG8_SCHED;
            PG8_LDB(B1, 0, 1); PG8_STAGE(PG8_SB(0, 0), b2, voffB);
            PG8_BAR; PG8_WAIT_L(0); PG8_MMA(0, 1, At, B1); PG8_BAR;
            PG8_LDA(At, 0, 1); PG8_STAGE(PG8_SA(0, 0), a2, voffA);
            PG8_BAR; PG8_WAIT_L(0); PG8_MMA(1, 0, At, B0); PG8_BAR; PG8_SCHED;
            PG8_STAGE(PG8_SB(0, 1), b2 + hstep, voffB);
            PG8_WAIT_V(6); PG8_BAR; PG8_MMA(1, 1, At, B1); PG8_BAR;
            PG8_LDB(B0, 1, 0); PG8_SCHED; PG8_LDA(At, 1, 0); PG8_STAGE(PG8_SA(0, 1), a2 + hstep, voffA);
            PG8_WAIT_L(8); PG8_BAR; PG8_WAIT_L(0); PG8_MMA(0, 0, At, B0); PG8_BAR; PG8_SCHED;
            PG8_LDB(B1, 1, 1); PG8_STAGE(PG8_SB(1, 0), b3, voffB);
            PG8_BAR; PG8_WAIT_L(0); PG8_MMA(0, 1, At, B1); PG8_BAR;
            PG8_LDA(At, 1, 1); PG8_STAGE(PG8_SA(1, 0), a3, voffA);
            PG8_BAR; PG8_WAIT_L(0); PG8_MMA(1, 0, At, B0); PG8_BAR; PG8_SCHED;
            PG8_STAGE(PG8_SB(1, 1), b3 + hstep, voffB);
            PG8_WAIT_V(6); PG8_BAR; PG8_MMA(1, 1, At, B1); PG8_BAR;
            }
        }
        if constexpr (F8) asm volatile("s_nop 15\n\ts_nop 15\n\ts_nop 15" ::: "memory");
        if constexpr (ALIGN_EPI) { if (wr == 0) PG8_BAR; }
        if constexpr (!Epi::AFTER_DRAIN) { E(acc, cur, wr, wc, fr, fq); S.done(cur); }
        if (!has_next) break;
#pragma unroll
        for (int a = 0; a < 2; ++a)
#pragma unroll
            for (int b = 0; b < 2; ++b)
#pragma unroll
                for (int m = 0; m < 4; ++m)
#pragma unroll
                    for (int n = 0; n < 2; ++n) acc[a][b][m][n] = (f32x4){0.f, 0.f, 0.f, 0.f};
        cur = nxt; cA = nA; cB = nB; ++ui;
        if constexpr (ALIGN_EPI) { if (wr == 1) PG8_BAR; }
    }
    PG8_WAIT_V(0);
    if constexpr (!ALIGN_EPI) { if (wr == 0) PG8_BAR; }
    PG8_BAR;
    if constexpr (Epi::AFTER_DRAIN) { E.fused(acc, cur, wr, wc, fr, fq, lds, wid, lane); S.done(cur); }
#undef PG8_SA
#undef PG8_SB
#undef PG8_STAGE
#undef PG8_LDA
#undef PG8_LDB
#undef PG8_MMA
#undef PG8_CAT8
#undef PG8_WAIT_V
#undef PG8_WAIT_L
#undef PG8_BAR
#undef PG8_SCHED
}
}
#define GAS __attribute__((address_space(1)))
#define LAS __attribute__((address_space(3)))
typedef unsigned short bf16;
typedef unsigned v4u __attribute__((ext_vector_type(4)));
typedef float f32x4 __attribute__((ext_vector_type(4)));
typedef short bf16x8 __attribute__((ext_vector_type(8)));
typedef GAS unsigned gu32;
typedef GAS unsigned long long gu64;
#define RLX_AGENT __ATOMIC_RELAXED, __HIP_MEMORY_SCOPE_AGENT
#define LDS_WAIT() asm volatile("s_waitcnt lgkmcnt(0)" ::: "memory")
#define VM_WAIT() asm volatile("s_waitcnt vmcnt(0)" ::: "memory")
__device__ __forceinline__ unsigned long long rt() { return __builtin_amdgcn_s_memrealtime(); }
__device__ __forceinline__ unsigned f2bf(float f) { unsigned u = __builtin_bit_cast(unsigned, f); return (u + 0x7fffu + ((u >> 16) & 1u)) >> 16; }
__device__ __forceinline__ unsigned pk2(float lo, float hi) { return f2bf(lo) | (f2bf(hi) << 16); }
#define XB_TMO      128
#define XB_XCNT(j)  (256  + 64 * (j))
#define XB_XSUB(j)  (1280 + 64 * (j))
#define XB_XGEN(j)  (2304 + 64 * (j))
#define XB_TOP      3328
#define XB_TOPGEN   3392
#define XCD_BAR_WORDS 3456
#define XB_SPIN_CAP (1u << 18)

__device__ __forceinline__ unsigned xb_ld(unsigned* p)              { return __hip_atomic_load(p, __ATOMIC_RELAXED, __HIP_MEMORY_SCOPE_AGENT); }
__device__ __forceinline__ unsigned xb_add(unsigned* p, unsigned v) { return __hip_atomic_fetch_add(p, v, __ATOMIC_RELAXED, __HIP_MEMORY_SCOPE_AGENT); }
__device__ __forceinline__ unsigned xb_xcc_id() { return (unsigned)__builtin_amdgcn_s_getreg((3 << 11) | 20) & 0xFu; }
#define XB_SPIN(cond, bar) do { unsigned _sp = 0; while (cond) { __builtin_amdgcn_s_sleep(1); \
    if ((++_sp & 255u) == 0u) { if (xb_ld(&(bar)[XB_TMO])) break; if (_sp > XB_SPIN_CAP) { atomicAdd(&(bar)[XB_TMO], 1u); break; } } } } while (0)

struct XcdBarrier {
    unsigned* bar; unsigned x;
    volatile LAS unsigned* st;
};

__device__ __forceinline__ XcdBarrier xcd_barrier_post(unsigned* bar, volatile LAS unsigned* st) {
    XcdBarrier b; b.bar = bar; b.x = xb_xcc_id(); b.st = st;
    if (threadIdx.x == 0) (void)xb_add(&bar[XB_XCNT(b.x)], 1u);
    return b;
}
__device__ __forceinline__ void xcd_barrier_complete(unsigned* bar, unsigned x, unsigned& nloc, unsigned& nx) {
    const unsigned G = gridDim.x * gridDim.y * gridDim.z;
    unsigned sum, cnt, mine, sp = 0u;
    for (;;) {
        sum = 0u; cnt = 0u; mine = 0u;
#pragma unroll
        for (unsigned j = 0; j < 16; ++j) { const unsigned c = xb_ld(&bar[XB_XCNT(j)]); sum += c; cnt += (c > 0u) ? 1u : 0u; mine = (j == x) ? c : mine; }
        if (sum == G) break;
        __builtin_amdgcn_s_sleep(1);
        if ((++sp & 255u) == 0u) { if (xb_ld(&bar[XB_TMO])) break; if (sp > XB_SPIN_CAP) { atomicAdd(&bar[XB_TMO], 1u); break; } }
    }
    nloc = mine > 0u ? mine : 1u; nx = cnt > 0u ? cnt : 1u;
}

__device__ __forceinline__ void xcd_barrier(const XcdBarrier& b) {
    asm volatile("s_waitcnt vmcnt(0)" ::: "memory");
    __syncthreads();
    if (threadIdx.x == 0) {
        unsigned* bar = b.bar;
        __builtin_amdgcn_s_waitcnt(0);
        unsigned nloc = b.st[0], nx = b.st[1];
        if (nloc == 0u) { xcd_barrier_complete(bar, b.x, nloc, nx); b.st[0] = nloc; b.st[1] = nx; }
        const unsigned old = xb_add(&bar[XB_XSUB(b.x)], 1u);
        const unsigned gen = old / nloc;
        if (old + 1u == (gen + 1u) * nloc) {
            __builtin_amdgcn_fence(__ATOMIC_RELEASE, "agent");
            asm volatile("s_waitcnt vmcnt(0)" ::: "memory");
            const unsigned og = xb_add(&bar[XB_TOP], 1u);
            const unsigned tg = og / nx;
            if (og + 1u == (tg + 1u) * nx) xb_add(&bar[XB_TOPGEN], 1u);
            else XB_SPIN(xb_ld(&bar[XB_TOPGEN]) == tg, bar);
            __builtin_amdgcn_fence(__ATOMIC_ACQUIRE, "agent");
            xb_add(&bar[XB_XGEN(b.x)], 1u);
            asm volatile("s_waitcnt vmcnt(0)" ::: "memory");
        } else {
            XB_SPIN(xb_ld(&bar[XB_XGEN(b.x)]) == gen, bar);
            __builtin_amdgcn_fence(__ATOMIC_ACQUIRE, "agent");
            asm volatile("s_waitcnt vmcnt(0)" ::: "memory");
        }
    }
    __syncthreads();
}

constexpr int NB = 4, SEQ = 4096, DM = 2048, LPOS = 4112, M = NB * SEQ;
constexpr int DFF = 5632, NHEAD = 16, HD = 64;
constexpr int NIN = 8192, NMAIN = 7168;
constexpr int NCH = 257;
constexpr float EPS = 1e-6f;
constexpr int NWAVES = 8;

constexpr size_t MiB = 1u << 20;
constexpr size_t WS_CTL = 0, CTL_ZERO_BYTES = 1 * MiB;
constexpr size_t WS_WIN = 1 * MiB, WS_WUP = 33 * MiB, WS_WDOWN = 77 * MiB, WS_WOUT = 99 * MiB, WS_WNA = 107 * MiB, WS_WSSM = 111 * MiB, WS_WGLU = 115 * MiB;
constexpr size_t WS_Q = 117 * MiB, WS_K = 149 * MiB, WS_VT = 181 * MiB, WS_U = 213 * MiB, WS_O = 247 * MiB;
constexpr size_t WS_MIX = 117 * MiB;
constexpr size_t WS_ACT = 117 * MiB;
constexpr size_t WS_SGNA = 293 * MiB, WS_SGSSM = 357 * MiB;
constexpr size_t WS_H2B = 293 * MiB;
constexpr size_t WS_EA = 357 * MiB, WS_EP = 369 * MiB, WS_EG = 381 * MiB;
constexpr size_t WS_XB = 421 * MiB;
constexpr size_t OUT_WV8 = 22 * MiB;
constexpr size_t OUT_W8 = 64 * MiB;
constexpr size_t OUT_WNA8 = 24 * MiB;
constexpr size_t OUT_WG8 = 26 * MiB, OUT_XB8 = 32 * MiB;
constexpr size_t OUT_YG = 32 * MiB, OUT_SGLU = 64 * MiB;
constexpr size_t WS_H3B = 421 * MiB;
constexpr size_t WS_SMALL = 485 * MiB, WS_END = 512 * MiB;
constexpr size_t SM_R1 = 0, SM_R1M = 192 * 1024, SM_Q15 = 196 * 1024, SM_SGNA15 = 200 * 1024, SM_SGSSM15 = 208 * 1024;
constexpr size_t SM_XBM = 256 * 1024, SM_KM = 320 * 1024, SM_VMT = 352 * 1024, SM_AYG15 = 416 * 1024, SM_AO15 = 448 * 1024, SM_AS15 = 480 * 1024;
constexpr size_t SM_AMIX15 = 512 * 1024, SM_AH2B15 = 576 * 1024, SM_A15 = 640 * 1024, SM_LAM16 = 768 * 1024;
constexpr size_t CTL_ROWSQ2 = 256 * 1024, CTL_ROWSQ3 = 320 * 1024, CTL_ROWSQM = 384 * 1024;
constexpr int CW_BAR = 4096;
constexpr size_t OUT_P = 0, OUT_R = 8 * MiB, OUT_KL = 16 * MiB, OUT_CP = 18 * MiB, OUT_L5 = 20 * MiB;

constexpr int RING_BYTES = 131072;
constexpr int MISC_OFF = 159744 - 256;
constexpr int LDS_BYTES = 159744;
static_assert(MISC_OFF + 128 <= LDS_BYTES, "LDS map");

typedef float f32x2 __attribute__((ext_vector_type(2)));
typedef unsigned v2u __attribute__((ext_vector_type(2)));
struct Frame {
    LAS unsigned char* lds;
    int tid, lane, wave, vcu, G, gw, NGW;
    const float* in[23];
    float* out; unsigned char* ws;
};
#define IN_X 0
#define IN_META 1
#define IN_G1 2
#define IN_WIN 3
#define IN_RPB 4
#define IN_LAMRE 5
#define IN_LAMIM 6
#define IN_LOGSTEP 7
#define IN_BRE 8
#define IN_BIM 9
#define IN_CRE 10
#define IN_CIM 11
#define IN_SSMD 12
#define IN_WGLU 13
#define IN_WNA 14
#define IN_WSSM 15
#define IN_WOUT 16
#define IN_G2 17
#define IN_WUP 18
#define IN_CONVW 19
#define IN_CONVB 20
#define IN_WDOWN 21
#define IN_GF 22
#define WSP(T, off) ((T*)(F.ws + (off)))
#define SMP(T, off) ((T*)(F.ws + WS_SMALL + (off)))
#define OUTP(T, off) ((T*)((unsigned char*)F.out + (off)))

__device__ __forceinline__ float wave_sum(float v) {
#pragma unroll
    for (int o = 1; o < 64; o <<= 1) v += __shfl_xor(v, o);
    return v;
}
typedef __bf16 bf16x2_t __attribute__((ext_vector_type(2)));
__device__ __forceinline__ unsigned cvtpk(float lo, float hi) { f32x2 v = {lo, hi}; bf16x2_t b = __builtin_convertvector(v, bf16x2_t); return __builtin_bit_cast(unsigned, b); }
__device__ __forceinline__ float bf2f(bf16 h) { return __builtin_bit_cast(float, (unsigned)h << 16); }
__device__ __forceinline__ float sigmoidf_(float x) { return __builtin_amdgcn_rcpf(1.0f + __expf(-x)); }
__device__ __forceinline__ float gelu_tanh(float x) { const float z = x * __builtin_fmaf(x * x, -0.10294324f, -2.3022082f); return x * __builtin_amdgcn_rcpf(1.0f + __builtin_amdgcn_exp2f(z)); }
__device__ __forceinline__ unsigned pk4_fp8(float a, float b, float c, float d) { unsigned w = __builtin_amdgcn_cvt_pk_fp8_f32(a, b, 0, false); return __builtin_amdgcn_cvt_pk_fp8_f32(c, d, w, true); }
template <int CTRL> __device__ __forceinline__ float dpp0(float x) { return __builtin_bit_cast(float, __builtin_amdgcn_update_dpp(0, __builtin_bit_cast(int, x), CTRL, 0xf, 0xf, true)); }
__device__ __forceinline__ bf16x8 ldfrag(const bf16* base, int ld, int lane) { return *(const bf16x8*)(base + (size_t)(lane & 15) * ld + 8 * (lane >> 4)); }
__device__ __forceinline__ bf16x8 ldfrag_lds(const LAS bf16* base, int ld, int lane) { return *(const LAS bf16x8*)(base + (lane & 15) * ld + 8 * (lane >> 4)); }
#define MFMA16(a, b, c) __builtin_amdgcn_mfma_f32_16x16x32_bf16((a), (b), (c), 0, 0, 0)
__device__ __forceinline__ bf16x8 dq8(v2u w) {
    const f32x2 a = __builtin_amdgcn_cvt_pk_f32_fp8((int)w.x, false), b = __builtin_amdgcn_cvt_pk_f32_fp8((int)w.x, true), c = __builtin_amdgcn_cvt_pk_f32_fp8((int)w.y, false), d = __builtin_amdgcn_cvt_pk_f32_fp8((int)w.y, true);
    v4u o; o.x = cvtpk(a[0], a[1]); o.y = cvtpk(b[0], b[1]); o.z = cvtpk(c[0], c[1]); o.w = cvtpk(d[0], d[1]); return __builtin_bit_cast(bf16x8, o); }
template <int K> __device__ __forceinline__ f32x4 meta_nt16_f8(Frame& F, const bf16* A, int lda, const unsigned char* Bt8, int ldb) {
    constexpr int NS = K / 8 / 32;
    const int lane = F.lane;
    const bf16* ap = A + (size_t)(lane & 15) * lda + 8 * (lane >> 4) + F.wave * (K / 8); const unsigned char* bp = Bt8 + (size_t)(lane & 15) * ldb + 8 * (lane >> 4) + F.wave * (K / 8);
    bf16x8 a[NS]; v2u b[NS];
#pragma unroll
    for (int i = 0; i < NS; ++i) { a[i] = *(const bf16x8*)(ap + 32 * i); b[i] = *(const v2u*)(bp + 32 * i); }
    f32x4 acc = {0.f, 0.f, 0.f, 0.f};
#pragma unroll
    for (int i = 0; i < NS; ++i) acc = MFMA16(a[i], dq8(b[i]), acc);
    LAS f32x4* red = (LAS f32x4*)F.lds;
    red[F.wave * 64 + lane] = acc;
    __syncthreads();
    f32x4 sum = {0.f, 0.f, 0.f, 0.f};
    if (F.wave == 0) {
#pragma unroll
        for (int w = 0; w < 8; ++w) sum = sum + red[w * 64 + lane]; }
    __syncthreads();
    return sum;
}
template <int K> __device__ __forceinline__ f32x4 meta_nt16_pair(Frame& F, const bf16* A, int lda, const void* Bt, int ldb, bool f8, f32x4* other = nullptr) {
    constexpr int NS = K / 4 / 32;
    const int lane = F.lane, kq = F.wave & 3;
    const bf16* ap = A + (size_t)(lane & 15) * lda + 8 * (lane >> 4) + kq * (K / 4);
    bf16x8 a[NS], b[NS];
#pragma unroll
    for (int i = 0; i < NS; ++i) a[i] = *(const bf16x8*)(ap + 32 * i);
    if (f8) { const unsigned char* bp = (const unsigned char*)Bt + (size_t)(lane & 15) * ldb + 8 * (lane >> 4) + kq * (K / 4); v2u q[NS];
#pragma unroll
        for (int i = 0; i < NS; ++i) q[i] = *(const v2u*)(bp + 32 * i);
#pragma unroll
        for (int i = 0; i < NS; ++i) b[i] = dq8(q[i]); }
    else { const bf16* bp = (const bf16*)Bt + (size_t)(lane & 15) * ldb + 8 * (lane >> 4) + kq * (K / 4);
#pragma unroll
        for (int i = 0; i < NS; ++i) b[i] = *(const bf16x8*)(bp + 32 * i); }
    f32x4 acc = {0.f, 0.f, 0.f, 0.f};
#pragma unroll
    for (int i = 0; i < NS; ++i) acc = MFMA16(a[i], b[i], acc);
    LAS f32x4* red = (LAS f32x4*)F.lds;
    red[F.wave * 64 + lane] = acc;
    __syncthreads();
    f32x4 sum = {0.f, 0.f, 0.f, 0.f};
    if (kq == 0) {
#pragma unroll
        for (int w = 0; w < 4; ++w) sum = sum + red[(F.wave + w) * 64 + lane]; }
    if (other && F.wave == 0) { f32x4 s2 = {0.f, 0.f, 0.f, 0.f};
#pragma unroll
        for (int w = 4; w < 8; ++w) s2 = s2 + red[w * 64 + lane];
        *other = s2; }
    __syncthreads();
    return sum;
}
template <int K> __device__ __forceinline__ f32x4 meta_nt16(Frame& F, const bf16* A, int lda, const bf16* Bt, int ldb) {
    constexpr int NS = K / 8 / 32;
    const int lane = F.lane;
    const bf16* ap = A + (size_t)(lane & 15) * lda + 8 * (lane >> 4) + F.wave * (K / 8); const bf16* bp = Bt + (size_t)(lane & 15) * ldb + 8 * (lane >> 4) + F.wave * (K / 8);
    bf16x8 a[NS], b[NS];
#pragma unroll
    for (int i = 0; i < NS; ++i) { a[i] = *(const bf16x8*)(ap + 32 * i); b[i] = *(const bf16x8*)(bp + 32 * i); }
    f32x4 acc = {0.f, 0.f, 0.f, 0.f};
#pragma unroll
    for (int i = 0; i < NS; ++i) acc = MFMA16(a[i], b[i], acc);
    LAS f32x4* red = (LAS f32x4*)F.lds;
    red[F.wave * 64 + lane] = acc;
    __syncthreads();
    f32x4 sum = {0.f, 0.f, 0.f, 0.f};
    if (F.wave == 0) {
#pragma unroll
        for (int w = 0; w < 8; ++w) sum = sum + red[w * 64 + lane]; }
    __syncthreads();
    return sum;
}

constexpr int P0_TP = 264;
__device__ __forceinline__ void p0_transpose_item(const float* W, int K, int N, bf16* WT, int dest_row0, const float* kscale, LAS bf16* TT, int kb, int nb, int lane, int wave, unsigned char* W8 = nullptr, int dest8_row0 = 0, bool keep16 = false) {
    const int k0 = 256 * kb + 32 * wave, n0 = 128 * nb, kr = lane >> 5, n4 = (lane & 31) * 4;
    f32x4 v[16]; unsigned loff = (unsigned)(kr * 16 * N + n4) * 4u; asm volatile("" : "+v"(loff));
#pragma unroll
    for (int i = 0; i < 16; ++i) v[i] = __builtin_nontemporal_load((const f32x4*)((const char*)(W + (size_t)(k0 + i) * N + n0) + loff));
    if (kscale) {
#pragma unroll
        for (int i = 0; i < 16; ++i) v[i] = v[i] * kscale[k0 + 16 * kr + i]; }
    LAS unsigned* TT32 = (LAS unsigned*)TT;
#pragma unroll
    for (int p8 = 0; p8 < 8; ++p8) { const int kd = 16 * wave + ((8 * kr + p8) ^ (4 * (lane & 3)));
#pragma unroll
        for (int cc = 0; cc < 4; ++cc) TT32[(n4 + cc) * (P0_TP / 2) + kd] = cvtpk(v[2 * p8][cc], v[2 * p8 + 1][cc]); }
    __syncthreads();
    const int c = lane & 31, nr = lane >> 5;
#pragma unroll
    for (int j = 0; j < 8; ++j) { const int n = 16 * wave + 2 * j + nr; const v4u w = *(const LAS v4u*)(TT + n * P0_TP + 8 * (c ^ ((n >> 2) & 3)));
        if (!W8 || keep16) *(v4u*)(WT + (size_t)(dest_row0 + n) * K + 256 * kb + 8 * c) = w;
        if (W8) { v2u q;
            q.x = pk4_fp8(64.f * __builtin_bit_cast(float, w.x << 16), 64.f * __builtin_bit_cast(float, w.x & 0xffff0000u), 64.f * __builtin_bit_cast(float, w.y << 16), 64.f * __builtin_bit_cast(float, w.y & 0xffff0000u));
            q.y = pk4_fp8(64.f * __builtin_bit_cast(float, w.z << 16), 64.f * __builtin_bit_cast(float, w.z & 0xffff0000u), 64.f * __builtin_bit_cast(float, w.w << 16), 64.f * __builtin_bit_cast(float, w.w & 0xffff0000u));
            *(v2u*)(W8 + (size_t)(dest8_row0 + n) * K + 256 * kb + 8 * c) = q; } }
    __syncthreads();
}
__device__ __forceinline__ void p0_row(const float* xrow, bf16* orow, float* rout, int lane, unsigned* o8row = nullptr) {
    const f32x4* xr = (const f32x4*)xrow + lane;
    f32x4 v[8]; float s = 0.f;
#pragma unroll
    for (int j = 0; j < 8; ++j) { v[j] = __builtin_nontemporal_load(xr + 64 * j); s += (v[j].x * v[j].x + v[j].y * v[j].y) + (v[j].z * v[j].z + v[j].w * v[j].w); }
    s = wave_sum(s);
    if (lane == 0) *rout = 1.0f / sqrtf(s * (1.0f / DM) + EPS);
    unsigned long long* o8 = (unsigned long long*)orow + lane;
#pragma unroll
    for (int j = 0; j < 8; ++j) o8[64 * j] = (unsigned long long)pk2(v[j].x, v[j].y) | ((unsigned long long)pk2(v[j].z, v[j].w) << 32);
    if (o8row) {
#pragma unroll
        for (int j = 0; j < 8; ++j) o8row[64 * j + lane] = pk4_fp8(v[j].x, v[j].y, v[j].z, v[j].w); }
}
__device__ __forceinline__ void sincos_d(double x, double& s, double& c) {
    const double TWO_PI = 6.283185307179586476925286766559;
    const double k = __builtin_rint(x / TWO_PI); double r = x - k * TWO_PI; r *= 0.25;
    const double r2 = r * r;
    double sn = r * (1.0 + r2 * (-1.0 / 6 + r2 * (1.0 / 120 + r2 * (-1.0 / 5040 + r2 * (1.0 / 362880 + r2 * (-1.0 / 39916800 + r2 * (1.0 / 6227020800.0)))))));
    double cs = 1.0 + r2 * (-0.5 + r2 * (1.0 / 24 + r2 * (-1.0 / 720 + r2 * (1.0 / 40320 + r2 * (-1.0 / 3628800 + r2 * (1.0 / 479001600.0 + r2 * (-1.0 / 87178291200.0)))))));
#pragma unroll
    for (int i = 0; i < 2; ++i) { const double s2 = 2.0 * sn * cs, c2 = cs * cs - sn * sn; sn = s2; cs = c2; }
    s = sn; c = cs;
}
__device__ __forceinline__ void cpow_(float lre, float lim, float step, int k, float& pr, float& pi) {
    const float mag = expf(lre * step * (float)k); double sd, cd; sincos_d((double)lim * (double)step * (double)k, sd, cd); pr = mag * (float)cd; pi = mag * (float)sd;
}
__device__ __forceinline__ void p0_s5_tables(Frame& F, int dir, int g, int half) {
    LAS float* LP = (LAS float*)F.lds;
    LAS float* BB = LP + 17 * 64 * 2;
    LAS float* CC = BB + 64 * 16 * 2;
    LAS float* KK = CC + 16 * 64 * 2;
    const int t = F.tid, dg = dir * 64 + g, lane = F.lane;
    unsigned char* ob = (unsigned char*)F.out;
    const float step = expf(F.in[IN_LOGSTEP][dg]);
    for (int e = t; e < 64 * (half ? 38 : 17); e += 512) { const int n = e & 63, idx = e >> 6;
        const float lre = F.in[IN_LAMRE][dg * 64 + n], lim = F.in[IN_LAMIM][dg * 64 + n];
        const int k = idx <= 16 ? idx : (idx < 22 ? (16 << (idx - 17)) : 16 * (dir ? 15 - (idx - 22) : (idx - 22)));
        float pr, pi; cpow_(lre, lim, step, k, pr, pi);
        if (idx <= 16) { LP[(idx * 64 + n) * 2] = pr; LP[(idx * 64 + n) * 2 + 1] = pi; }
        else if (idx < 22) { float* L5 = (float*)(ob + OUT_L5 + (size_t)dg * 2560); L5[((idx - 17) * 64 + n) * 2] = pr; L5[((idx - 17) * 64 + n) * 2 + 1] = pi; }
        else { float* CP = (float*)(ob + OUT_CP + (size_t)dg * 9216); CP[(idx - 22) * 130 + 2 * n] = pr; CP[(idx - 22) * 130 + 2 * n + 1] = pi; } }
    for (int e = t; e < 1024; e += 512) { const int c = e >> 6, n = e & 63; CC[e * 2] = F.in[IN_CRE][(dg * 16 + c) * 64 + n]; CC[e * 2 + 1] = F.in[IN_CIM][(dg * 16 + c) * 64 + n]; }
    __syncthreads();
    for (int e = t; e < 1024; e += 512) { const int n = e >> 4, c = e & 15;
        const float lre = F.in[IN_LAMRE][dg * 64 + n], lim = F.in[IN_LAMIM][dg * 64 + n], l1r = LP[(64 + n) * 2], l1i = LP[(64 + n) * 2 + 1];
        const float ar = l1r - 1.f, ai = l1i, den = 1.0f / (lre * lre + lim * lim), fr_ = (ar * lre + ai * lim) * den, fi_ = (ai * lre - ar * lim) * den;
        const float br = F.in[IN_BRE][(dg * 64 + n) * 16 + c], bi = F.in[IN_BIM][(dg * 64 + n) * 16 + c];
        BB[e * 2] = fr_ * br - fi_ * bi; BB[e * 2 + 1] = fr_ * bi + fi_ * br; }
    __syncthreads();
    if (!half) {
        bf16* P = (bf16*)(ob + OUT_P) + (size_t)dg * 128 * 256;
        for (int e8 = t; e8 < 128 * 256 / 8; e8 += 512) { const int e = 8 * e8, rho = e >> 8, k = e & 255, part = (rho >> 5) & 1, n = (rho & 31) + 32 * (rho >> 6), j = k >> 4, cp = k & 15, ex = dir ? j : 15 - j;
            const float lr = LP[(ex * 64 + n) * 2], li = LP[(ex * 64 + n) * 2 + 1];
            const LAS f32x4* b4 = (const LAS f32x4*)(BB + (n * 16 + cp) * 2); float o[8];
#pragma unroll
            for (int q = 0; q < 4; ++q) { const f32x4 b = b4[q]; o[2 * q] = part ? (lr * b[1] + li * b[0]) : (lr * b[0] - li * b[1]); o[2 * q + 1] = part ? (lr * b[3] + li * b[2]) : (lr * b[2] - li * b[3]); }
            v4u w; w.x = cvtpk(o[0], o[1]); w.y = cvtpk(o[2], o[3]); w.z = cvtpk(o[4], o[5]); w.w = cvtpk(o[6], o[7]); *(v4u*)(P + e) = w; }
    } else {
#pragma unroll
        for (int dd = 0; dd < 2; ++dd) { const int d = 2 * F.wave + dd, c = lane & 15; f32x4 acc = {0.f, 0.f, 0.f, 0.f};
            for (int tt = 0; tt < 32; ++tt) { const int k = 4 * tt + (lane >> 4), part = k >> 6, n = k & 63;
                const float cr = CC[(c * 64 + n) * 2], ci = CC[(c * 64 + n) * 2 + 1], lr = LP[(d * 64 + n) * 2], li = LP[(d * 64 + n) * 2 + 1];
                const float av = part ? -(cr * li + ci * lr) : (cr * lr - ci * li), bv = BB[(n * 16 + c) * 2 + part];
                acc = __builtin_amdgcn_mfma_f32_16x16x4f32(av, bv, acc, 0, 0, 0); }
#pragma unroll
            for (int r = 0; r < 4; ++r) KK[(d * 16 + 4 * (lane >> 4) + r) * 16 + c] = acc[r]; }
        bf16* R = (bf16*)(ob + OUT_R) + (size_t)dg * 256 * 128;
        for (int e8 = t; e8 < 256 * 128 / 8; e8 += 512) { const int e = 8 * e8, row = e >> 7, kk = e & 127, q = (kk >> 3) ^ (row & 15), rt = q >> 2, s = (q >> 1) & 1, hh = q & 1;
            const int part = rt & 1, i = row >> 4, c = row & 15, ex = dir ? 16 - i : i + 1; float o[8];
#pragma unroll
            for (int jh = 0; jh < 2; ++jh) { const int n0 = 32 * (rt >> 1) + 16 * s + 8 * jh + 4 * hh;
                const LAS f32x4* c4 = (const LAS f32x4*)(CC + (c * 64 + n0) * 2); const LAS f32x4* l4 = (const LAS f32x4*)(LP + (ex * 64 + n0) * 2);
#pragma unroll
                for (int u2 = 0; u2 < 2; ++u2) { const f32x4 cc = c4[u2], ll = l4[u2];
                    o[4 * jh + 2 * u2] = part ? -(cc[0] * ll[1] + cc[1] * ll[0]) : (cc[0] * ll[0] - cc[1] * ll[1]); o[4 * jh + 2 * u2 + 1] = part ? -(cc[2] * ll[3] + cc[3] * ll[2]) : (cc[2] * ll[2] - cc[3] * ll[3]); } }
            v4u w; w.x = cvtpk(o[0], o[1]); w.y = cvtpk(o[2], o[3]); w.z = cvtpk(o[4], o[5]); w.w = cvtpk(o[6], o[7]); *(v4u*)(R + e) = w; }
        __syncthreads();
        bf16* KL = (bf16*)(ob + OUT_KL + (size_t)dg * 9216);
        for (int e = t; e < 17 * 256; e += 512) { const int d = (e >> 8) - 1, c = (e >> 4) & 15, cp = e & 15; float v = 0.f;
            if (d >= 0) { v = KK[(d * 16 + c) * 16 + cp]; if (dir == 0 && d == 0 && c == cp) v += F.in[IN_SSMD][g * 16 + c]; }
            KL[e] = (bf16)f2bf(v); }
    }
    __syncthreads();
}
__device__ __forceinline__ void p0_prologue(Frame& F) {
    for (int v = F.vcu; v < 256; v += F.G) p0_s5_tables(F, (v >> 1) >> 6, (v >> 1) & 63, v & 1);
    LAS bf16* scr = (LAS bf16*)F.lds;
    const int gw = F.gw, NGW = F.NGW;
    constexpr int I_IN = 8 * 64, I_UP = 8 * 88, I_DOWN = 22 * 16, I_OUT = 8 * 16, I_NA = 4 * 16, I_SSM = 4 * 16, I_GLU = 4 * 8;
    constexpr int NITEMS = I_IN + I_UP + I_DOWN + I_OUT + I_NA + I_SSM + I_GLU;
    for (int it = F.vcu; it < NITEMS; it += F.G) {
        int r = it;
        if (r < I_IN) { const int kb = r % 8, nb = r / 8, n0 = nb * 128;
            const int dest = n0 < 2048 ? n0 : (n0 < 3072 ? 7168 + (n0 - 2048) : (n0 < 4096 ? 2048 + (n0 - 3072) : 3072 + (n0 - 4096)));
            p0_transpose_item(F.in[IN_WIN], DM, NIN, WSP(bf16, WS_WIN), dest, F.in[IN_G1], scr, kb, nb, F.lane, F.wave, (n0 < 2048 || n0 >= 4096) ? OUTP(unsigned char, OUT_W8) : (n0 < 3072 ? OUTP(unsigned char, OUT_WV8) : nullptr), n0 < 2048 ? n0 : (n0 >= 4096 ? n0 - 2048 : n0 - 2048)); continue; } r -= I_IN;
        if (r < I_UP) { const int kb = r % 8, nb = r / 8, n0 = nb * 128; const int isg = n0 >= DFF, j0 = isg ? n0 - DFF : n0;
            const int dest = 256 * (j0 >> 7) + (isg ? 128 : 0) + (j0 & 127);
            p0_transpose_item(F.in[IN_WUP], DM, 2 * DFF, WSP(bf16, WS_WUP), dest, F.in[IN_G2], scr, kb, nb, F.lane, F.wave); continue; } r -= I_UP;
        if (r < I_DOWN) { p0_transpose_item(F.in[IN_WDOWN], DFF, DM, WSP(bf16, WS_WDOWN), (r / 22) * 128, nullptr, scr, r % 22, r / 22, F.lane, F.wave); continue; } r -= I_DOWN;
        if (r < I_OUT) { p0_transpose_item(F.in[IN_WOUT], DM, DM, WSP(bf16, WS_WOUT), (r / 8) * 128, nullptr, scr, r % 8, r / 8, F.lane, F.wave); continue; } r -= I_OUT;
        if (r < I_NA) { p0_transpose_item(F.in[IN_WNA], 1024, DM, WSP(bf16, WS_WNA), (r / 4) * 128, nullptr, scr, r % 4, r / 4, F.lane, F.wave, OUTP(unsigned char, OUT_WNA8), (r / 4) * 128); continue; } r -= I_NA;
        if (r < I_SSM) { p0_transpose_item(F.in[IN_WSSM], 1024, DM, WSP(bf16, WS_WSSM), (r / 4) * 128, nullptr, scr, r % 4, r / 4, F.lane, F.wave); continue; } r -= I_SSM;
        p0_transpose_item(F.in[IN_WGLU], 1024, 1024, WSP(bf16, WS_WGLU), (r / 4) * 128, nullptr, scr, r % 4, r / 4, F.lane, F.wave);
    }
    for (int m = gw; m < M; m += NGW) p0_row(F.in[IN_X] + (size_t)m * DM, WSP(bf16, WS_XB) + (size_t)m * DM, SMP(float, SM_R1) + m, F.lane, OUTP(unsigned, OUT_XB8) + (size_t)m * (DM / 4));
    if (gw < 16) p0_row(F.in[IN_META] + (size_t)gw * DM, SMP(bf16, SM_XBM) + (size_t)gw * DM, SMP(float, SM_R1M) + gw, F.lane);
}

typedef float f32x4 __attribute__((ext_vector_type(4)));
__device__ __forceinline__ v4u pack8(f32x4 v0, f32x4 v1) { v4u w; w.x = cvtpk(v0[0], v0[1]); w.y = cvtpk(v0[2], v0[3]); w.z = cvtpk(v1[0], v1[1]); w.w = cvtpk(v1[2], v1[3]); return w; }
__device__ __forceinline__ void unpack8(v4u w, f32x4& v0, f32x4& v1) {
    v0[0] = __builtin_bit_cast(float, w.x << 16); v0[1] = __builtin_bit_cast(float, w.x & 0xffff0000u); v0[2] = __builtin_bit_cast(float, w.y << 16); v0[3] = __builtin_bit_cast(float, w.y & 0xffff0000u);
    v1[0] = __builtin_bit_cast(float, w.z << 16); v1[1] = __builtin_bit_cast(float, w.z & 0xffff0000u); v1[2] = __builtin_bit_cast(float, w.w << 16); v1[3] = __builtin_bit_cast(float, w.w & 0xffff0000u); }
__device__ __forceinline__ unsigned q8(f32x4 v) { const unsigned a = (unsigned)(sigmoidf_(v[0]) * 255.f + 0.5f), b = (unsigned)(sigmoidf_(v[1]) * 255.f + 0.5f), c = (unsigned)(sigmoidf_(v[2]) * 255.f + 0.5f), d = (unsigned)(sigmoidf_(v[3]) * 255.f + 0.5f);
    return a | (b << 8) | (c << 16) | (d << 24); }
__device__ __forceinline__ unsigned q8n(f32x4 a, float ns) { unsigned q[4];
#pragma unroll
    for (int i = 0; i < 4; ++i) q[i] = (unsigned)__builtin_fmaf(__builtin_amdgcn_rcpf(1.0f + __builtin_amdgcn_exp2f(a[i] * ns)), 255.f, 0.5f);
    return q[0] | (q[1] << 8) | (q[2] << 16) | (q[3] << 24); }
__device__ __forceinline__ f32x4 uq8(unsigned w) { f32x4 o; o[0] = (float)(w & 0xffu); o[1] = (float)((w >> 8) & 0xffu); o[2] = (float)((w >> 16) & 0xffu); o[3] = (float)(w >> 24); return o; }
__device__ __forceinline__ f32x4 sig4(f32x4 v) { f32x4 o; o[0] = sigmoidf_(v[0]); o[1] = sigmoidf_(v[1]); o[2] = sigmoidf_(v[2]); o[3] = sigmoidf_(v[3]); return o; }

struct EpiG1 {
    static constexpr bool PERM = true, AFTER_DRAIN = false, APERM = false;
    const float* r1; bf16 *Q, *K, *U; unsigned char *SGNA, *SGSSM; int pn0;
    __device__ __forceinline__ void operator()(const f32x4 (&acc)[2][2][4][2], const pg8::Unit& u0, int wr, int wc, int fr, int fq) const {
        const pg8::Unit u{u0.pm, u0.pn + pn0};
        const int seg = u.pn < 4 ? 0 : (u.pn < 8 ? 1 : (u.pn < 12 ? 2 : (u.pn < 20 ? 3 : 4)));
        float rsv[2][4];
#pragma unroll
        for (int ai = 0; ai < 2; ++ai)
#pragma unroll
            for (int m = 0; m < 4; ++m) rsv[ai][m] = r1[u.pm * 256 + ai * 128 + wr * 64 + m * 16 + fr];
#pragma unroll
        for (int ai = 0; ai < 2; ++ai)
#pragma unroll
            for (int m = 0; m < 4; ++m) { const int row = u.pm * 256 + ai * 128 + wr * 64 + m * 16 + fr; const float rs = rsv[ai][m]; unsigned gq[4];
#pragma unroll
                for (int bj = 0; bj < 2; ++bj) { const int c0 = u.pn * 256 + bj * 128 + wc * 32 + 8 * fq; f32x4 v0 = acc[ai][bj][m][0] * rs, v1 = acc[ai][bj][m][1] * rs;
                    if (seg == 0) { v0 = v0 * 0.125f; v1 = v1 * 0.125f; *(v4u*)(Q + (size_t)row * 1024 + c0) = pack8(v0, v1); }
                    else if (seg == 1) { const int c = c0 - 1024, hh = c >> 6, d0 = c & 63, bb = row >> 12, tt = row & 4095;
                        *(v4u*)(K + ((((((size_t)(bb * 16 + hh) * 64 + (tt >> 6)) * 8 + ((tt & 63) >> 3)) * 2 + (d0 >> 5)) * 4 + ((d0 >> 3) & 3)) * 8 + (tt & 7)) * 8) = pack8(v0, v1); }
                    else if (seg == 2) { const int cu = c0 - 2048, g = cu >> 4, b = row >> 12, t = row & 4095; *(v4u*)(U + ((size_t)(b * 64 + g) * LPOS + 16 + t) * 16 + (cu & 15)) = pack8(v0, v1); }
                    else { gq[2 * bj] = q8(v0); gq[2 * bj + 1] = q8(v1); } }
                if (seg >= 3) { v4u w; w.x = gq[0]; w.y = gq[1]; w.z = gq[2]; w.w = gq[3]; *(v4u*)((seg == 3 ? SGNA + (u.pn - 12) * 256 : SGSSM + (u.pn - 20) * 256) + (size_t)row * 2048 + 64 * wc + 16 * fq) = w; } }
    }
};
struct EpiQKG {
    static constexpr bool PERM = true, AFTER_DRAIN = false, APERM = false;
    const float* r1; bf16 *Q, *K; unsigned char *SGNA, *SGSSM;
    __device__ __forceinline__ void operator()(const f32x4 (&acc)[2][2][4][2], const pg8::Unit& u, int wr, int wc, int fr, int fq) const {
        float rsv[2][4];
#pragma unroll
        for (int ai = 0; ai < 2; ++ai)
#pragma unroll
            for (int m = 0; m < 4; ++m) rsv[ai][m] = r1[u.pm * 256 + ai * 128 + wr * 64 + m * 16 + fr];
        if (u.pn >= 8) {
            unsigned char* dst = (u.pn < 16 ? SGNA + (u.pn - 8) * 256 : SGSSM + (u.pn - 16) * 256) + 64 * wc + 16 * fq;
#pragma unroll
            for (int ai = 0; ai < 2; ++ai)
#pragma unroll
                for (int m = 0; m < 4; ++m) { const int row = u.pm * 256 + ai * 128 + wr * 64 + m * 16 + fr; const float ns = rsv[ai][m] * (-1.4426950408889634f / 64.f);
                    v4u w; w.x = q8n(acc[ai][0][m][0], ns); w.y = q8n(acc[ai][0][m][1], ns); w.z = q8n(acc[ai][1][m][0], ns); w.w = q8n(acc[ai][1][m][1], ns);
                    *(v4u*)(dst + (size_t)row * 2048) = w; }
        } else {
#pragma unroll
            for (int ai = 0; ai < 2; ++ai)
#pragma unroll
                for (int m = 0; m < 4; ++m) { const int row = u.pm * 256 + ai * 128 + wr * 64 + m * 16 + fr; const float rs = rsv[ai][m] * (1.0f / 64.f);
#pragma unroll
                    for (int bj = 0; bj < 2; ++bj) { const int c0 = u.pn * 256 + bj * 128 + wc * 32 + 8 * fq;
                        if (u.pn < 4) { const float qs = rs * 0.125f; *(v4u*)(Q + (size_t)row * 1024 + c0) = pack8(acc[ai][bj][m][0] * qs, acc[ai][bj][m][1] * qs); }
                        else { const int c = c0 - 1024, hh = c >> 6, d0 = c & 63, bb = row >> 12, tt = row & 4095;
                            *(v4u*)(K + ((((((size_t)(bb * 16 + hh) * 64 + (tt >> 6)) * 8 + ((tt & 63) >> 3)) * 2 + (d0 >> 5)) * 4 + ((d0 >> 3) & 3)) * 8 + (tt & 7)) * 8) = pack8(acc[ai][bj][m][0] * rs, acc[ai][bj][m][1] * rs); } } }
        }
    }
};
struct EpiGate {
    static constexpr bool PERM = true, AFTER_DRAIN = false, APERM = false;
    const float* r1; unsigned char *SGNA, *SGSSM;
    __device__ __forceinline__ void operator()(const f32x4 (&acc)[2][2][4][2], const pg8::Unit& u, int wr, int wc, int fr, int fq) const {
        float rsv[2][4];
#pragma unroll
        for (int ai = 0; ai < 2; ++ai)
#pragma unroll
            for (int m = 0; m < 4; ++m) rsv[ai][m] = r1[u.pm * 256 + ai * 128 + wr * 64 + m * 16 + fr];
        unsigned char* dst = (u.pn < 8 ? SGNA + u.pn * 256 : SGSSM + (u.pn - 8) * 256) + 64 * wc + 16 * fq;
#pragma unroll
        for (int ai = 0; ai < 2; ++ai)
#pragma unroll
            for (int m = 0; m < 4; ++m) { const int row = u.pm * 256 + ai * 128 + wr * 64 + m * 16 + fr; const float ns = rsv[ai][m] * (-1.4426950408889634f / 64.f);
                v4u w; w.x = q8n(acc[ai][0][m][0], ns); w.y = q8n(acc[ai][0][m][1], ns); w.z = q8n(acc[ai][1][m][0], ns); w.w = q8n(acc[ai][1][m][1], ns);
                *(v4u*)(dst + (size_t)row * 2048) = w; }
    }
};
struct EpiVt {
    static constexpr bool PERM = true, AFTER_DRAIN = false, APERM = false;
    const float* r1; bf16* VT;
    __device__ __forceinline__ void operator()(const f32x4 (&acc)[2][2][4][2], const pg8::Unit& u, int wr, int wc, int fr, int fq) const {
#pragma unroll
        for (int bj = 0; bj < 2; ++bj) { const int c0 = u.pn * 256 + bj * 128 + wc * 32 + 8 * fq; const f32x4 s0 = *(const f32x4*)(r1 + c0) * (1.0f / 64.f), s1 = *(const f32x4*)(r1 + c0 + 4) * (1.0f / 64.f);
#pragma unroll
            for (int ai = 0; ai < 2; ++ai)
#pragma unroll
                for (int m = 0; m < 4; ++m) { const int row = u.pm * 256 + ai * 128 + wr * 64 + m * 16 + fr, bb = c0 >> 12, tt = c0 & 4095;
                    *(v4u*)(VT + (((((size_t)(bb * 16 + (row >> 6)) * 64 + (tt >> 6)) * 4 + ((row >> 2) & 3)) * 8 + ((tt & 63) >> 3)) * 16 + (((row >> 4) & 3) * 4 + (row & 3))) * 8) = pack8(acc[ai][bj][m][0] * s0, acc[ai][bj][m][1] * s1); } }
    }
};
struct EpiGlu {
    static constexpr bool PERM = true, AFTER_DRAIN = false, APERM = false;
    const bf16* YG; bf16* S;
    __device__ __forceinline__ void operator()(const f32x4 (&acc)[2][2][4][2], const pg8::Unit& u, int wr, int wc, int fr, int fq) const {
#pragma unroll
        for (int ai = 0; ai < 2; ++ai)
#pragma unroll
            for (int m = 0; m < 4; ++m) { const int row = u.pm * 256 + ai * 128 + wr * 64 + m * 16 + fr;
#pragma unroll
                for (int bj = 0; bj < 2; ++bj) { const int c0 = u.pn * 256 + bj * 128 + wc * 32 + 8 * fq; f32x4 y0, y1; unpack8(*(const v4u*)(YG + (size_t)row * 1024 + c0), y0, y1);
                    *(v4u*)(S + (size_t)row * 1024 + c0) = pack8(y0 * sig4(acc[ai][bj][m][0]), y1 * sig4(acc[ai][bj][m][1])); } }
    }
};
template <bool ADD> struct EpiMix {
    static constexpr bool PERM = true, AFTER_DRAIN = false, APERM = false;
    const unsigned char* GATE; bf16* MIX; float asc;
    __device__ __forceinline__ void operator()(const f32x4 (&acc)[2][2][4][2], const pg8::Unit& u, int wr, int wc, int fr, int fq) const {
#pragma unroll
        for (int ai = 0; ai < 2; ++ai)
#pragma unroll
            for (int m = 0; m < 4; ++m) { const int row = u.pm * 256 + ai * 128 + wr * 64 + m * 16 + fr;
                const v4u gw = *(const v4u*)(GATE + (size_t)row * 2048 + u.pn * 256 + 64 * wc + 16 * fq);
#pragma unroll
                for (int bj = 0; bj < 2; ++bj) { const int c0 = u.pn * 256 + bj * 128 + wc * 32 + 8 * fq;
                    f32x4 v0 = uq8(bj ? gw.z : gw.x) * (acc[ai][bj][m][0] * asc), v1 = uq8(bj ? gw.w : gw.y) * (acc[ai][bj][m][1] * asc);
                    if (ADD) { f32x4 p0, p1; unpack8(*(const v4u*)(MIX + (size_t)row * 2048 + c0), p0, p1); v0 = v0 + p0; v1 = v1 + p1; }
                    *(v4u*)(MIX + (size_t)row * 2048 + c0) = pack8(v0, v1); } }
    }
};

template <bool H2> struct EpiRes {
    static constexpr bool PERM = true, AFTER_DRAIN = false, APERM = false;
    const bf16* baseb; bf16* outb; float* rowsq;
    __device__ __forceinline__ void operator()(const f32x4 (&acc)[2][2][4][2], const pg8::Unit& u, int wr, int wc, int fr, int fq) const {
#pragma unroll
        for (int ai = 0; ai < 2; ++ai)
#pragma unroll
            for (int m = 0; m < 4; ++m) { const int row = u.pm * 256 + ai * 128 + wr * 64 + m * 16 + fr; float ss = 0.f;
#pragma unroll
                for (int bj = 0; bj < 2; ++bj) { const size_t off = (size_t)row * 2048 + u.pn * 256 + bj * 128 + wc * 32 + 8 * fq;
                    f32x4 v0, v1; unpack8(*(const v4u*)(baseb + off), v0, v1);
                    v0 = v0 + acc[ai][bj][m][0]; v1 = v1 + acc[ai][bj][m][1];
                    *(v4u*)(outb + off) = pack8(v0, v1);
                    ss += (v0[0] * v0[0] + v0[1] * v0[1]) + (v0[2] * v0[2] + v0[3] * v0[3]) + (v1[0] * v1[0] + v1[1] * v1[1]) + (v1[2] * v1[2] + v1[3] * v1[3]); }
                ss += __shfl_xor(ss, 16); ss += __shfl_xor(ss, 32);
                if (fq == 0) atomicAdd(rowsq + row, ss); }
    }
};
struct EpiUp {
    static constexpr bool PERM = true, AFTER_DRAIN = false, APERM = true;
    const float* rowsq; const float* convw; const float* convb; bf16* ACT; float *EA, *EP, *EG; LAS unsigned char* ex;
    __device__ __forceinline__ void operator()(const f32x4 (&acc)[2][2][4][2], const pg8::Unit& u, int wr, int wc, int fr, int fq) const {
        const int ja0 = u.pn * 128 + wc * 32 + 8 * fq;
        LAS f32x4* EX = (LAS f32x4*)ex;
        float r2[2][4];
#pragma unroll
        for (int ai = 0; ai < 2; ++ai) { const f32x4 rq = *(const f32x4*)(rowsq + u.pm * 256 + ai * 128 + wr * 64 + 4 * fr);
#pragma unroll
            for (int m = 0; m < 4; ++m) r2[ai][m] = __builtin_amdgcn_rsqf(rq[m] * (1.0f / DM) + EPS); }
#pragma unroll
        for (int ai = 0; ai < 2; ++ai)
#pragma unroll
            for (int n = 0; n < 2; ++n) { const int e = (((2 * ai + wr) * 2) * 4 + wc) * 8 + fq * 2 + n;
                if (fr == 0) EX[e] = acc[ai][0][0][n] * r2[ai][0];
                if (fr == 15) EX[e + 32] = acc[ai][0][3][n] * r2[ai][3]; }
        __syncthreads();
#pragma unroll
        for (int ai = 0; ai < 2; ++ai) {
            const int row0 = u.pm * 256 + ai * 128 + wr * 64 + 4 * fr, blk = 2 * ai + wr;
            const bool has_up = blk > 0, has_dn = blk < 3;
            v2u wq[2][4];
#pragma unroll
            for (int n = 0; n < 2; ++n) {
                const int ja = ja0 + 4 * n;
                const f32x4 w0 = *(const f32x4*)(convw + ja), w1 = *(const f32x4*)(convw + DFF + ja), w2 = *(const f32x4*)(convw + 2 * DFF + ja), cb = *(const f32x4*)(convb + ja);
                f32x4 upn = {0.f, 0.f, 0.f, 0.f}, dnn = {0.f, 0.f, 0.f, 0.f};
                if (has_up) upn = EX[((((blk - 1) * 2 + 1) * 4 + wc) * 8) + fq * 2 + n];
                if (has_dn) dnn = EX[((((blk + 1) * 2) * 4 + wc) * 8) + fq * 2 + n];
                f32x4 av[4], gv[4], cv[4];
#pragma unroll
                for (int m = 0; m < 4; ++m) { av[m] = acc[ai][0][m][n] * r2[ai][m]; gv[m] = acc[ai][1][m][n] * r2[ai][m]; }
#pragma unroll
                for (int i = 0; i < 4; ++i) {
                    float up0 = dpp0<0x111>(av[3][i]), dn3 = dpp0<0x101>(av[0][i]);
                    if (fr == 0) up0 = upn[i];
                    if (fr == 15) dn3 = dnn[i];
                    cv[0][i] = __builtin_fmaf(w2[i], av[1][i], __builtin_fmaf(w0[i], up0, __builtin_fmaf(w1[i], av[0][i], cb[i])));
                    cv[1][i] = __builtin_fmaf(w2[i], av[2][i], __builtin_fmaf(w0[i], av[0][i], __builtin_fmaf(w1[i], av[1][i], cb[i])));
                    cv[2][i] = __builtin_fmaf(w2[i], av[3][i], __builtin_fmaf(w0[i], av[1][i], __builtin_fmaf(w1[i], av[2][i], cb[i])));
                    cv[3][i] = __builtin_fmaf(w2[i], dn3, __builtin_fmaf(w0[i], av[2][i], __builtin_fmaf(w1[i], av[3][i], cb[i])));
                }
                if (!has_up && fr == 0) { const size_t eo = (size_t)(u.pm * 8) * DFF + ja; *(f32x4*)(EA + eo) = av[0]; *(f32x4*)(EP + eo) = cv[0]; *(f32x4*)(EG + eo) = gv[0]; }
                if (!has_dn && fr == 15) { const size_t eo = (size_t)(u.pm * 8 + 7) * DFF + ja; *(f32x4*)(EA + eo) = av[3]; *(f32x4*)(EP + eo) = cv[3]; *(f32x4*)(EG + eo) = gv[3]; }
#pragma unroll
                for (int m = 0; m < 4; ++m) { wq[n][m].x = cvtpk(gelu_tanh(cv[m][0]) * gv[m][0], gelu_tanh(cv[m][1]) * gv[m][1]); wq[n][m].y = cvtpk(gelu_tanh(cv[m][2]) * gv[m][2], gelu_tanh(cv[m][3]) * gv[m][3]); }
            }
#pragma unroll
            for (int m = 0; m < 4; ++m) { const bool edge = (m == 0 && fr == 0 && !has_up) || (m == 3 && fr == 15 && !has_dn);
                if (!edge) { v4u w; w.x = wq[0][m].x; w.y = wq[0][m].y; w.z = wq[1][m].x; w.w = wq[1][m].y; *(v4u*)(ACT + (size_t)(row0 + m) * DFF + ja0) = w; } }
        }
    }
};


__device__ __forceinline__ void p1_meta(Frame& F) {
    const int lane = F.lane, lr = lane & 15, lg = lane >> 4;
    for (int cb0 = F.vcu; cb0 < 256; cb0 += F.G) {
        const int cb = cb0 + 256 * (F.wave >> 2), c16 = 16 * cb; const bool isu = c16 >= 2048 && c16 < 3072;
        const void* bt = isu ? (const void*)(WSP(bf16, WS_WIN) + (size_t)c16 * DM)
                             : (const void*)(c16 >= 7168 ? OUTP(unsigned char, OUT_WV8) + (size_t)(c16 - 7168) * DM : OUTP(unsigned char, OUT_W8) + (size_t)(c16 < 2048 ? c16 : c16 - 1024) * DM);
        const f32x4 acc = meta_nt16_pair<DM>(F, SMP(bf16, SM_XBM), DM, bt, DM, !isu);
        if ((F.wave & 3) != 0) continue;
        const float* r1m = SMP(float, SM_R1M);
        const int col = 16 * cb + lr; const float wsc = isu ? 1.0f : (1.0f / 64.f);
#pragma unroll
        for (int r = 0; r < 4; ++r) { const int j = 4 * lg + r; const float v = acc[r] * (r1m[j] * wsc);
            if (col < 1024) { if (j == 15) SMP(float, SM_Q15)[col] = v * 0.125f; }
            else if (col < 2048) SMP(bf16, SM_KM)[j * 1024 + (col - 1024)] = (bf16)f2bf(v);
            else if (col < 3072) { const int cu = col - 2048, g = cu >> 4; const bf16 h = (bf16)f2bf(v);
#pragma unroll
                for (int b = 0; b < NB; ++b) WSP(bf16, WS_U)[((size_t)(b * 64 + g) * LPOS + j) * 16 + (cu & 15)] = h; }
            else if (col < 5120) { if (j == 15) SMP(float, SM_SGNA15)[col - 3072] = sigmoidf_(v); }
            else if (col < 7168) { if (j == 15) SMP(float, SM_SGSSM15)[col - 5120] = sigmoidf_(v); }
            else { bf16* vm = SMP(bf16, SM_VMT) + (size_t)(col - 7168) * 32; vm[j] = (bf16)f2bf(v); vm[16 + j] = 0; } }
    }
}
__device__ __forceinline__ void p2_meta_attn(Frame& F, int h) {
    const int lane = F.lane, j = lane & 15, part = lane >> 4;
    const f32x4* q4 = (const f32x4*)(SMP(float, SM_Q15) + h * 64 + 16 * part); const v4u* k4 = (const v4u*)(SMP(bf16, SM_KM) + j * 1024 + h * 64 + 16 * part);
    const f32x4 qa = q4[0], qb = q4[1], qc = q4[2], qd = q4[3]; const v4u ka = k4[0], kb = k4[1];
    f32x4 k0, k1, k2, k3; unpack8(ka, k0, k1); unpack8(kb, k2, k3);
    const f32x4 pr = qa * k0 + qb * k1 + qc * k2 + qd * k3;
    float s = (pr[0] + pr[1]) + (pr[2] + pr[3]);
    s += __shfl_xor(s, 16); s += __shfl_xor(s, 32);
    float mx = s;
#pragma unroll
    for (int o = 1; o < 16; o <<= 1) mx = fmaxf(mx, __shfl_xor(mx, o));
    float p = __expf(s - mx), sum = p;
#pragma unroll
    for (int o = 1; o < 16; o <<= 1) sum += __shfl_xor(sum, o);
    p = p / sum;
    const v4u* v4 = (const v4u*)(SMP(bf16, SM_VMT) + (size_t)(h * 64 + lane) * 32); const v4u va = v4[0], vb = v4[1];
    f32x4 v0, v1, v2, v3; unpack8(va, v0, v1); unpack8(vb, v2, v3);
    float o = 0.f;
#pragma unroll
    for (int k = 0; k < 4; ++k) { o += __shfl(p, k) * v0[k] + __shfl(p, 4 + k) * v1[k] + __shfl(p, 8 + k) * v2[k] + __shfl(p, 12 + k) * v3[k]; }
    const bf16 ob = (bf16)f2bf(o);
#pragma unroll
    for (int b = 0; b < NB; ++b) SMP(bf16, SM_AO15)[b * 1024 + h * 64 + lane] = ob;
}
__device__ __forceinline__ void p3a_meta(Frame& F) {
    const int lane = F.lane, lr = lane & 15, lg = lane >> 4;
    for (int cb = F.vcu; cb < 64; cb += F.G) {
        const f32x4 acc = meta_nt16<1024>(F, SMP(bf16, SM_AYG15), 1024, WSP(bf16, WS_WGLU) + (size_t)(16 * cb) * 1024, 1024);
        if (F.wave != 0) continue;
#pragma unroll
        for (int r = 0; r < 4; ++r) { const int i = 4 * lg + r, col = 16 * cb + lr; const float y = bf2f(SMP(bf16, SM_AYG15)[i * 1024 + col]); SMP(bf16, SM_AS15)[i * 1024 + col] = (bf16)f2bf(y * sigmoidf_(acc[r])); }
    }
}
__device__ __forceinline__ void p3b_meta(Frame& F) {
    const int lane = F.lane, lr = lane & 15, lg = lane >> 4;
    for (int cb = F.vcu; cb < 128; cb += F.G) {
        f32x4 a2 = {0.f, 0.f, 0.f, 0.f};
        const bool hi = (F.wave >> 2) != 0;
        f32x4 a1 = meta_nt16_pair<1024>(F, hi ? SMP(bf16, SM_AS15) : SMP(bf16, SM_AO15), 1024, hi ? (const void*)(WSP(bf16, WS_WSSM) + (size_t)(16 * cb) * 1024) : (const void*)(OUTP(unsigned char, OUT_WNA8) + (size_t)(16 * cb) * 1024), 1024, !hi, &a2);
        if (F.wave != 0) continue;
        a1 = a1 * (1.0f / 64.f);
        const int col = 16 * cb + lr; const float gn = SMP(float, SM_SGNA15)[col], gs = SMP(float, SM_SGSSM15)[col];
#pragma unroll
        for (int r = 0; r < 4; ++r) { const int i = 4 * lg + r; SMP(bf16, SM_AMIX15)[i * 2048 + col] = (bf16)f2bf(gn * a1[r] + gs * a2[r]); }
    }
}
__device__ __forceinline__ void p3c_meta(Frame& F) {
    const int lane = F.lane, lr = lane & 15, lg = lane >> 4;
    for (int cb = F.vcu; cb < 128; cb += F.G) {
        const f32x4 acc = meta_nt16<2048>(F, SMP(bf16, SM_AMIX15), 2048, WSP(bf16, WS_WOUT) + (size_t)(16 * cb) * 2048, 2048);
        if (F.wave != 0) continue;
        const int col = 16 * cb + lr; const float mt = F.in[IN_META][15 * DM + col];
#pragma unroll
        for (int r = 0; r < 4; ++r) { const int i = 4 * lg + r; const float v = mt + acc[r]; SMP(bf16, SM_AH2B15)[i * 2048 + col] = (bf16)f2bf(v);
            float ss = v * v;
#pragma unroll
            for (int o = 1; o < 16; o <<= 1) ss += __shfl_xor(ss, o);
            if (lr == 0 && i < NB) atomicAdd((float*)(F.ws + WS_CTL + CTL_ROWSQM) + i, ss); }
    }
}
__device__ __forceinline__ void p4_meta(Frame& F) {
    const int lane = F.lane, lr = lane & 15, lg = lane >> 4;
    for (int cb0 = F.vcu; cb0 < DFF / 32; cb0 += F.G) {
        const int cb = cb0 + (DFF / 32) * (F.wave >> 2), j0 = 16 * cb, wrow = 256 * (j0 >> 7) + (j0 & 127);
        const f32x4 acc = meta_nt16_pair<2048>(F, SMP(bf16, SM_AH2B15), 2048, WSP(bf16, WS_WUP) + (size_t)wrow * 2048, 2048, false);
        if ((F.wave & 3) != 0) continue;
        if (lg == 0) {
#pragma unroll
            for (int r = 0; r < 4; ++r) { const float r2 = 1.0f / sqrtf(((const float*)(F.ws + WS_CTL + CTL_ROWSQM))[r] * (1.0f / DM) + EPS); SMP(float, SM_A15)[r * DFF + j0 + lr] = acc[r] * r2; } }
    }
}

constexpr int NA_K_OFF = 8 * 9216, NA_RPB_OFF = NA_K_OFF + 9 * 8192;
__device__ __forceinline__ void na_prefetch(Frame& F, int gi, v4u (&k)[9], float (&bs)[2]) {
    const int r0 = (2 * gi) & 63, h = (gi >> 5) & 15, b = gi >> 9, rs0 = min(max(r0 - 4, 0), 56);
    const unsigned char* src = (const unsigned char*)(WSP(bf16, WS_K) + (size_t)((b * 16 + h) * 64 + rs0) * 4096) + F.tid * 16;
#pragma unroll
    for (int i = 0; i < 9; ++i) k[i] = *(const v4u*)(src + i * 8192);
#pragma unroll
    for (int q = 0; q < 2; ++q) { const int e = F.tid + 512 * q, x = (e & 63) - 16; bs[q] = (e < 960 && x >= 0 && x < 31) ? F.in[IN_RPB][(h * 15 + (e >> 6)) * 31 + x] : 0.f; }
}
__device__ __forceinline__ void na_commit(Frame& F, const v4u (&k)[9], const float (&bs)[2]) {
#pragma unroll
    for (int i = 0; i < 9; ++i) *(LAS v4u*)(F.lds + NA_K_OFF + i * 8192 + F.tid * 16) = k[i];
#pragma unroll
    for (int q = 0; q < 2; ++q) { const int e = F.tid + 512 * q; if (e < 960) ((LAS float*)(F.lds + NA_RPB_OFF))[e] = bs[q]; }
}
__device__ __forceinline__ void na_qload(Frame& F, int gi, bf16x8 (&qf)[2]) {
    const int qb = F.wave & 3, r = ((2 * gi) & 63) + (F.wave >> 2), h = (gi >> 5) & 15, b = gi >> 9;
    const bf16* Qp = WSP(bf16, WS_Q) + ((size_t)(b * SEQ + r * 64 + 16 * qb) * 1024 + h * 64);
    qf[0] = ldfrag(Qp, 1024, F.lane); qf[1] = ldfrag(Qp + 32, 1024, F.lane);
}
__device__ __forceinline__ void na_task(Frame& F, int gi, LAS bf16* P  , const v4u (&kpre)[9], const float (&bpre)[2], bf16x8 (&qf)[2], bool has_next) {
    const int qb = F.wave & 3, r0 = (2 * gi) & 63, r = r0 + (F.wave >> 2), h = (gi >> 5) & 15, b = gi >> 9;
    const int lane = F.lane, lr = lane & 15, lg = lane >> 4;
    const int w0 = (qb == 0) ? 0 : (qb == 1) ? 8 : (qb == 2) ? 24 : 32;
    const int rs = min(max(r - 4, 0), 56), rs0 = min(max(r0 - 4, 0), 56);
    const int cq = 16 * qb + lr, cs = min(max(cq - 8, 0), 48);
    const bf16x8 qf0 = qf[0], qf1 = qf[1];
    const LAS float* rpb = (const LAS float*)(F.lds + NA_RPB_OFF) + (rs - r + 7) * 64 + 16 + (w0 + 4 * lg - cq + 15);
    bool vld[2][4];
#pragma unroll
    for (int hf = 0; hf < 2; ++hf)
#pragma unroll
        for (int i = 0; i < 4; ++i) vld[hf][i] = (unsigned)(w0 + 16 * hf + 4 * lg + i - cs) < 16u;
    const LAS unsigned char* Kb = F.lds + NA_K_OFF + (rs - rs0) * 8192 + ((w0 >> 3) + (lr >> 3)) * 1024 + lg * 128 + (lr & 7) * 16;
    const bf16* Km = SMP(bf16, SM_KM) + lr * 1024 + h * 64 + 8 * lg;
    const bf16* Vb = WSP(bf16, WS_VT) + ((size_t)((b * 16 + h) * 64 + rs) * 4096 + ((w0 >> 3) + lg) * 128 + lr * 8);
    const bf16* Vm = SMP(bf16, SM_VMT) + (size_t)(h * 64 + 16 * (lr >> 2) + (lr & 3)) * 32 + 8 * lg;
#define NA_KLD(t, ks) (*(const LAS bf16x8*)(Kb + (((t) >> 1) * 8192 + ((t) & 1) * 2048 + (ks) * 512)))
#define NA_SB() __builtin_amdgcn_sched_barrier(0)
    f32x4 s[17];
#define NA_TILE(t, f0, f1) do { f32x4 a_ = {0.f, 0.f, 0.f, 0.f}; a_ = MFMA16((f0), qf0, a_); a_ = MFMA16((f1), qf1, a_); \
        _Pragma("unroll") for (int i = 0; i < 4; ++i) { float bias = rpb[((t) >> 1) * 64 + 16 * ((t) & 1) + i]; asm volatile("" : "+v"(bias)); s[t][i] = vld[(t) & 1][i] ? a_[i] + bias : -INFINITY; } } while (0)
    bf16x8 ka[8], kb[8]; const bf16x8 km0 = *(const bf16x8*)Km, km1 = *(const bf16x8*)(Km + 32);
#pragma unroll
    for (int t = 0; t < 4; ++t) { ka[2 * t] = NA_KLD(t, 0); ka[2 * t + 1] = NA_KLD(t, 1); }
#pragma unroll
    for (int t = 0; t < 4; ++t) { kb[2 * t] = NA_KLD(t + 4, 0); kb[2 * t + 1] = NA_KLD(t + 4, 1); }
    NA_SB();
#pragma unroll
    for (int t = 0; t < 4; ++t) NA_TILE(t, ka[2 * t], ka[2 * t + 1]);
    NA_SB();
#pragma unroll
    for (int t = 0; t < 4; ++t) { ka[2 * t] = NA_KLD(t + 8, 0); ka[2 * t + 1] = NA_KLD(t + 8, 1); }
    NA_SB();
#pragma unroll
    for (int t = 0; t < 4; ++t) NA_TILE(t + 4, kb[2 * t], kb[2 * t + 1]);
    NA_SB();
#pragma unroll
    for (int t = 0; t < 4; ++t) { kb[2 * t] = NA_KLD(t + 12, 0); kb[2 * t + 1] = NA_KLD(t + 12, 1); }
    NA_SB();
#pragma unroll
    for (int t = 0; t < 4; ++t) NA_TILE(t + 8, ka[2 * t], ka[2 * t + 1]);
    NA_SB();
#pragma unroll
    for (int t = 0; t < 4; ++t) NA_TILE(t + 12, kb[2 * t], kb[2 * t + 1]);
    { f32x4 a_ = {0.f, 0.f, 0.f, 0.f}; a_ = MFMA16(km0, qf0, a_); a_ = MFMA16(km1, qf1, a_); s[16] = a_; }
    LDS_WAIT(); __syncthreads();
    if (has_next) { na_commit(F, kpre, bpre); na_qload(F, gi + F.G, qf); }
    NA_SB();
    bf16x8 va[9], vb[9];
#pragma unroll
    for (int s8 = 0; s8 < 8; ++s8) { va[s8] = *(const bf16x8*)(Vb + s8 * 4096); vb[s8] = *(const bf16x8*)(Vb + 1024 + s8 * 4096); }
    va[8] = *(const bf16x8*)Vm; vb[8] = *(const bf16x8*)(Vm + 4 * 32);
    NA_SB();
    float mx = -INFINITY;
#pragma unroll
    for (int t = 0; t < 17; ++t) mx = fmaxf(mx, fmaxf(fmaxf(s[t][0], s[t][1]), fmaxf(s[t][2], s[t][3])));
    mx = fmaxf(mx, __shfl_xor(mx, 16)); mx = fmaxf(mx, __shfl_xor(mx, 32));
    float sum = 0.f;
#pragma unroll
    for (int t = 0; t < 17; ++t) {
#pragma unroll
        for (int i = 0; i < 4; ++i) { const float p = __expf(s[t][i] - mx); s[t][i] = p; sum += p; } }
    sum += __shfl_xor(sum, 16); sum += __shfl_xor(sum, 32);
    const float inv = 1.0f / sum;
#pragma unroll
    for (int t = 0; t < 17; ++t) { v2u w; w.x = cvtpk(s[t][0] * inv, s[t][1] * inv); w.y = cvtpk(s[t][2] * inv, s[t][3] * inv);
        *(LAS v2u*)(P + lr * 288 + t * 16 + 4 * lg) = w; }
    { v2u z; z.x = 0u; z.y = 0u; *(LAS v2u*)(P + lr * 288 + 272 + 4 * lg) = z; }
    LDS_WAIT(); asm volatile("" ::: "memory");
    unsigned char* Op = WSP(unsigned char, WS_O) + ((size_t)(b * SEQ + r * 64 + 16 * qb + lr) * 1024 + h * 64) + 16 * lg;
    unsigned ow[4];
    bf16x8 pf[9];
#pragma unroll
    for (int s8 = 0; s8 < 9; ++s8) pf[s8] = ldfrag_lds(P + 32 * s8, 288, lane);
#define NA_PV(db, vf) do { f32x4 o_ = {0.f, 0.f, 0.f, 0.f}; _Pragma("unroll") for (int s8 = 0; s8 < 9; ++s8) o_ = MFMA16(vf[s8], pf[s8], o_); \
        ow[db] = pk4_fp8(o_[0] * 16.f, o_[1] * 16.f, o_[2] * 16.f, o_[3] * 16.f); } while (0)
    NA_SB();
    NA_PV(0, va);
    NA_SB();
#pragma unroll
    for (int s8 = 0; s8 < 8; ++s8) va[s8] = *(const bf16x8*)(Vb + 2048 + s8 * 4096);
    va[8] = *(const bf16x8*)(Vm + 8 * 32);
    NA_SB();
    NA_PV(1, vb);
    NA_SB();
#pragma unroll
    for (int s8 = 0; s8 < 8; ++s8) vb[s8] = *(const bf16x8*)(Vb + 3072 + s8 * 4096);
    vb[8] = *(const bf16x8*)(Vm + 12 * 32);
    NA_SB();
    NA_PV(2, va);
    NA_SB();
    NA_PV(3, vb);
    { v4u w0; w0.x = ow[0]; w0.y = ow[1]; w0.z = ow[2]; w0.w = ow[3]; *(v4u*)Op = w0; }
    LDS_WAIT(); asm volatile("" ::: "memory");
#undef NA_KLD
#undef NA_TILE
#undef NA_PV
#undef NA_SB
}

typedef float f32x16 __attribute__((ext_vector_type(16)));
#define MFMA32(a, b, c) __builtin_amdgcn_mfma_f32_32x32x16_bf16((a), (b), (c), 0, 0, 0)
constexpr int S5_PP = 528;
constexpr int S5_A = 0, S5_B = 128 * S5_PP, S5_C = 2 * 128 * S5_PP, S5_TOT = S5_C + 8320, S5_M = S5_C + 17408;
constexpr int S5_L5 = S5_M, S5_X0 = S5_M + 5120, S5_XB0 = S5_X0 + 512, S5_U0 = S5_XB0 + 512;
static_assert(S5_U0 + 512 <= MISC_OFF, "S5 LDS map");
template <int BYTES> __device__ __forceinline__ void s5_copy(LAS unsigned char* dst, const unsigned char* src, int tid) {
    unsigned t16 = (unsigned)tid * 16u; asm volatile("" : "+v"(t16));
    constexpr int NIT = (BYTES + 8191) / 8192; v4u tmp[NIT];
#pragma unroll
    for (int i = 0; i < NIT; ++i) if (BYTES % 8192 == 0 || i < NIT - 1 || t16 + i * 8192u < (unsigned)BYTES) tmp[i] = *(const v4u*)(src + t16 + i * 8192u);
#pragma unroll
    for (int i = 0; i < NIT; ++i) if (BYTES % 8192 == 0 || i < NIT - 1 || t16 + i * 8192u < (unsigned)BYTES) *(LAS v4u*)(dst + t16 + i * 8192u) = tmp[i];
}
__device__ __forceinline__ void s5_copy_p(LAS unsigned char* dst, const unsigned char* src, int tid) {
    unsigned t16 = (unsigned)tid * 16u; asm volatile("" : "+v"(t16));
    v4u tmp[8];
#pragma unroll
    for (int i = 0; i < 8; ++i) tmp[i] = *(const v4u*)(src + t16 + i * 8192u);
#pragma unroll
    for (int i = 0; i < 8; ++i) { const unsigned o = t16 + i * 8192u; *(LAS v4u*)(dst + (o >> 9) * S5_PP + (o & 511)) = tmp[i]; }
}
#define S5_LOAD_UF(uf) bf16x8 uf[16]; { unsigned uo_ = (unsigned)(((1 + 32 * wv + r32) * 256 + 8 * h) * 2); asm volatile("" : "+v"(uo_)); const unsigned char* up_ = (const unsigned char*)Ug + uo_; \
    _Pragma("unroll") for (int ks = 0; ks < 16; ++ks) uf[ks] = *(const bf16x8*)(up_ + 32 * ks); }
template <int CTRL> __device__ __forceinline__ float s5_dpp(float x) { return __builtin_bit_cast(float, __builtin_amdgcn_update_dpp(0, __builtin_bit_cast(int, x), CTRL, 0xf, 0xf, false)); }
#define S5_PIN8(A, B, r0) asm volatile("" : "+v"(A[r0]), "+v"(A[r0 + 1]), "+v"(A[r0 + 2]), "+v"(A[r0 + 3]), "+v"(B[r0]), "+v"(B[r0 + 1]), "+v"(B[r0 + 2]), "+v"(B[r0 + 3]))
#define S5_FENCE(p, reg) do { if (((reg) & 3) == 3) { S5_PIN8(S[2 * (p)], S[2 * (p) + 1], (reg) - 3); if ((reg) < 15) S5_PIN8(S[2 * (p)], S[2 * (p) + 1], (reg) + 1); else if ((p) == 0) S5_PIN8(S[2], S[3], 0); } } while (0)
template <int dir> __device__ __forceinline__ void s5_dir(Frame& F, int g, const bf16* Ug, bf16x8 (&xf)[4][2]) {
    LAS unsigned char* L = F.lds;
    const int tid = F.tid, lane = F.lane, r32 = lane & 31, h = lane >> 5, fr = lane & 15, wv = F.wave;
    const unsigned char* ob = (const unsigned char*)F.out;
        s5_copy<8320>(L + S5_C, ob + OUT_CP + (size_t)(dir * 64 + g) * 9216, tid);
        __syncthreads();
        if (dir == 0) {
            const int rho = tid >> 2, qq = tid & 3; float acc = 0.f;
#pragma unroll
            for (int p8 = 0; p8 < 8; ++p8) { const int q = 8 * qq + p8; const v4u pw = *(const LAS v4u*)(L + S5_A + rho * S5_PP + (q << 4)), uw = *(const LAS v4u*)(L + S5_U0 + q * 16);
                acc += bf2f((bf16)(pw.x & 0xffff)) * bf2f((bf16)(uw.x & 0xffff)) + bf2f((bf16)(pw.x >> 16)) * bf2f((bf16)(uw.x >> 16)) + bf2f((bf16)(pw.y & 0xffff)) * bf2f((bf16)(uw.y & 0xffff)) + bf2f((bf16)(pw.y >> 16)) * bf2f((bf16)(uw.y >> 16))
                     + bf2f((bf16)(pw.z & 0xffff)) * bf2f((bf16)(uw.z & 0xffff)) + bf2f((bf16)(pw.z >> 16)) * bf2f((bf16)(uw.z >> 16)) + bf2f((bf16)(pw.w & 0xffff)) * bf2f((bf16)(uw.w & 0xffff)) + bf2f((bf16)(pw.w >> 16)) * bf2f((bf16)(uw.w >> 16)); }
            { int lo_ = lane; asm volatile("" : "+v"(lo_));
              acc += __builtin_bit_cast(float, __builtin_amdgcn_ds_bpermute((lo_ ^ 1) << 2, __builtin_bit_cast(int, acc))); acc += __builtin_bit_cast(float, __builtin_amdgcn_ds_bpermute((lo_ ^ 2) << 2, __builtin_bit_cast(int, acc))); }
            if (qq == 0) { const int part = (rho >> 5) & 1, n = (rho & 31) + 32 * (rho >> 6); ((LAS float*)(L + S5_X0))[part * 64 + n] = acc; }
        }
        f32x16 S[4];
#pragma unroll
        for (int rt = 0; rt < 4; ++rt) S[rt] = (f32x16){0.f,0.f,0.f,0.f,0.f,0.f,0.f,0.f,0.f,0.f,0.f,0.f,0.f,0.f,0.f,0.f};
        { unsigned pbo = (unsigned)((dir ? S5_B : S5_A) + r32 * S5_PP + h * 16); asm volatile("" : "+v"(pbo)); const LAS unsigned char* Pb = L + pbo; S5_LOAD_UF(uf)
#pragma unroll
          for (int ks = 0; ks < 16; ++ks) {
#pragma unroll
            for (int rt = 0; rt < 4; ++rt) S[rt] = MFMA32(*(const LAS bf16x8*)(Pb + rt * 32 * S5_PP + ks * 32), uf[ks], S[rt]); __builtin_amdgcn_sched_barrier(0); } }
        unsigned l5o = (unsigned)(S5_L5 + dir * 2560); asm volatile("" : "+v"(l5o)); const LAS float* L5 = (const LAS float*)(L + l5o); const LAS float* L5h = L5 + 8 * h;
#pragma unroll
        for (int p = 0; p < 2; ++p)
#pragma unroll
            for (int reg = 0; reg < 16; ++reg) { const int n = 32 * p + (reg & 3) + 8 * (reg >> 2);
#define S5_STEP(sstep) { constexpr int CT = (dir ? 0x100 : 0x110) | (1 << (sstep)); const f32x2 lam = *(const LAS f32x2*)(L5h + ((sstep) * 64 + n) * 2); \
                    const float tr = s5_dpp<CT>(S[2 * p][reg]), ti = s5_dpp<CT>(S[2 * p + 1][reg]); S[2 * p][reg] += lam.x * tr - lam.y * ti; S[2 * p + 1][reg] += lam.x * ti + lam.y * tr; }
                S5_STEP(0) S5_STEP(1) S5_STEP(2) S5_STEP(3)
#undef S5_STEP
                S5_FENCE(p, reg); }
        { unsigned tw = (unsigned)(S5_TOT + (2 * wv + (r32 >> 4)) * 512 + h * 16); asm volatile("" : "+v"(tw)); LAS float* tot = (LAS float*)(L + tw);
          if (fr == (dir ? 0 : 15)) {
#pragma unroll
            for (int p = 0; p < 2; ++p)
#pragma unroll
                for (int reg = 0; reg < 16; ++reg) { const int n = 32 * p + (reg & 3) + 8 * (reg >> 2); tot[n] = S[2 * p][reg]; tot[64 + n] = S[2 * p + 1][reg]; } } }
        __syncthreads();
        { unsigned toto = (unsigned)(S5_TOT + lane * 4), x0o = (unsigned)(S5_X0 + lane * 4); asm volatile("" : "+v"(toto), "+v"(x0o));
          const LAS float* tot = (const LAS float*)(L + toto); const f32x2 l256 = *(const LAS f32x2*)(L5 + (4 * 64 + lane) * 2);
          float wr_ = dir ? 0.f : ((const LAS float*)(L + x0o))[0], wi_ = dir ? 0.f : ((const LAS float*)(L + x0o))[64];
          float w0r = 0.f, w0i = 0.f, w1r = 0.f, w1i = 0.f;
          const int s0 = dir ? 2 * wv + 1 : 2 * wv, s1 = dir ? 2 * wv : 2 * wv + 1;
          for (int kk = 0; kk < 16; ++kk) { const int k = dir ? 15 - kk : kk;
              if (k == s0) { w0r = wr_; w0i = wi_; } if (k == s1) { w1r = wr_; w1i = wi_; }
              const float tr = tot[k * 128], ti = tot[k * 128 + 64];
              const float nr = l256.x * wr_ - l256.y * wi_ + tr, ni = l256.x * wi_ + l256.y * wr_ + ti; wr_ = nr; wi_ = ni; }
          if (dir == 1 && wv == 0) { ((LAS float*)(L + x0o))[128] = wr_; ((LAS float*)(L + x0o))[192] = wi_; }
          __syncthreads();
          LAS float* win = (LAS float*)(L + toto);
          win[s0 * 128] = w0r; win[s0 * 128 + 64] = w0i; win[s1 * 128] = w1r; win[s1 * 128 + 64] = w1i; }
        LDS_WAIT(); asm volatile("" ::: "memory");
        { unsigned wino = (unsigned)(S5_TOT + (2 * wv + (r32 >> 4)) * 512 + h * 16), cpo = (unsigned)(S5_C + fr * 520 + h * 32); asm volatile("" : "+v"(wino), "+v"(cpo));
          const LAS float* win = (const LAS float*)(L + wino); const LAS float* CP = (const LAS float*)(L + cpo);
#pragma unroll
          for (int p = 0; p < 2; ++p)
#pragma unroll
            for (int reg = 0; reg < 16; ++reg) { const int n = 32 * p + (reg & 3) + 8 * (reg >> 2);
                const float er = s5_dpp<(dir ? 0x100 : 0x110) | 1>(S[2 * p][reg]), ei = s5_dpp<(dir ? 0x100 : 0x110) | 1>(S[2 * p + 1][reg]);
                const f32x2 cp = *(const LAS f32x2*)(CP + 2 * n); const float wr_ = win[n], wi_ = win[64 + n];
                S[2 * p][reg] = er + cp.x * wr_ - cp.y * wi_; S[2 * p + 1][reg] = ei + cp.x * wi_ + cp.y * wr_; S5_FENCE(p, reg); }
#pragma unroll
          for (int rt = 0; rt < 4; ++rt)
#pragma unroll
            for (int s = 0; s < 2; ++s) { v4u w; w.x = cvtpk(S[rt][8 * s], S[rt][8 * s + 1]); w.y = cvtpk(S[rt][8 * s + 2], S[rt][8 * s + 3]); w.z = cvtpk(S[rt][8 * s + 4], S[rt][8 * s + 5]); w.w = cvtpk(S[rt][8 * s + 6], S[rt][8 * s + 7]);
                xf[rt][s] = __builtin_bit_cast(bf16x8, w); } }
        __syncthreads();
}
__device__ __forceinline__ void s5_block(Frame& F, int b, int g) {
    LAS unsigned char* L = F.lds;
    const int tid = F.tid, lane = F.lane, r32 = lane & 31, h = lane >> 5, fr = lane & 15, wv = F.wave;
    const unsigned char* ob = (const unsigned char*)F.out;
    const bf16* Ug = WSP(bf16, WS_U) + (size_t)(b * 64 + g) * LPOS * 16;
    s5_copy_p(L + S5_A, ob + OUT_P + (size_t)g * 65536, tid);
    s5_copy_p(L + S5_B, ob + OUT_P + (size_t)(64 + g) * 65536, tid);
    s5_copy<2560>(L + S5_L5, ob + OUT_L5 + (size_t)g * 2560, tid);
    s5_copy<2560>(L + S5_L5 + 2560, ob + OUT_L5 + (size_t)(64 + g) * 2560, tid);
    if (tid < 32) *(LAS v4u*)(L + S5_U0 + tid * 16) = *(const v4u*)((const unsigned char*)Ug + tid * 16);
    bf16x8 xf0[4][2], xf1[4][2];
    s5_dir<0>(F, g, Ug, xf0);
    s5_dir<1>(F, g, Ug, xf1);
    s5_copy<65536>(L + S5_A, ob + OUT_R + (size_t)g * 65536, tid);
    s5_copy<65536>(L + S5_B, ob + OUT_R + (size_t)(64 + g) * 65536, tid);
    s5_copy<8704>(L + S5_C, ob + OUT_KL + (size_t)g * 9216, tid);
    s5_copy<8704>(L + S5_C + 8704, ob + OUT_KL + (size_t)(64 + g) * 9216, tid);
    __syncthreads();
    { S5_LOAD_UF(uf)
#pragma unroll
    for (int hf = 0; hf < 4; ++hf) {
        f32x16 Y[2];
#pragma unroll
        for (int t2 = 0; t2 < 2; ++t2) Y[t2] = (f32x16){0.f,0.f,0.f,0.f,0.f,0.f,0.f,0.f,0.f,0.f,0.f,0.f,0.f,0.f,0.f,0.f};
#pragma unroll
        for (int t2 = 0; t2 < 2; ++t2) { const int RT = 2 * hf + t2;
            unsigned kfo = (unsigned)(S5_C + ((r32 & 15) * 16 + 8 * h) * 2 + (r32 >> 4) * 512), kbo = (unsigned)(S5_C + 8704 + ((r32 & 15) * 16 + 8 * h) * 2 - (r32 >> 4) * 512);
            asm volatile("" : "+v"(kfo), "+v"(kbo)); const LAS unsigned char* KLf = L + kfo; const LAS unsigned char* KLb = L + kbo;
#pragma unroll
            for (int ks = 0; ks < 16; ++ks) {
                if (ks <= 2 * RT + 1) Y[t2] = MFMA32(*(const LAS bf16x8*)(KLf + (2 * RT - ks + 1) * 512), uf[ks], Y[t2]);
                if (ks >= 2 * RT) Y[t2] = MFMA32(*(const LAS bf16x8*)(KLb + (ks - 2 * RT + 1) * 512), uf[ks], Y[t2]); __builtin_amdgcn_sched_barrier(0); }
            unsigned fx = (unsigned)((fr ^ h) << 4); asm volatile("" : "+v"(fx));
#pragma unroll
            for (int dir = 0; dir < 2; ++dir) { unsigned rbo = (unsigned)((dir ? S5_B : S5_A) + r32 * 256); asm volatile("" : "+v"(rbo)); const LAS unsigned char* Rb = L + rbo + RT * 8192;
#pragma unroll
                for (int rt = 0; rt < 4; ++rt)
#pragma unroll
                    for (int s = 0; s < 2; ++s) { Y[t2] = MFMA32(*(const LAS bf16x8*)(Rb + (((rt * 2 + s) * 32) ^ fx)), (dir ? xf1[rt][s] : xf0[rt][s]), Y[t2]); __builtin_amdgcn_sched_barrier(0); } } }
        const int chunk = 1 + 32 * wv + r32;
#pragma unroll
        for (int t2 = 0; t2 < 2; ++t2)
#pragma unroll
            for (int il = 0; il < 2; ++il) { const int pos = chunk * 16 + 2 * (2 * hf + t2) + il; bf16* yp = OUTP(bf16, OUT_YG) + (size_t)(b * SEQ + pos - 16) * 1024 + g * 16 + 4 * h;
#pragma unroll
                for (int cg = 0; cg < 2; ++cg) { const int r0 = 8 * il + 4 * cg; v2u w; w.x = cvtpk(gelu_tanh(Y[t2][r0]), gelu_tanh(Y[t2][r0 + 1])); w.y = cvtpk(gelu_tanh(Y[t2][r0 + 2]), gelu_tanh(Y[t2][r0 + 3]));
                    *(v2u*)(yp + 8 * cg) = w; } }
        __builtin_amdgcn_sched_barrier(0);
    } }
    if (tid < 256) {
        const int c = tid >> 4, q = tid & 15; float acc = 0.f;
        { const LAS unsigned char* kf = L + S5_C + ((16 - q) * 256 + c * 16) * 2; const LAS unsigned char* u0 = L + S5_U0 + q * 32;
#pragma unroll
          for (int e = 0; e < 16; ++e) acc += bf2f(*(const LAS bf16*)(kf + 2 * e)) * bf2f(*(const LAS bf16*)(u0 + 2 * e)); }
        if (q == 0) { const LAS unsigned char* kb = L + S5_C + 8704 + (1 * 256 + c * 16) * 2; const LAS unsigned char* u15 = L + S5_U0 + 15 * 32;
#pragma unroll
          for (int e = 0; e < 16; ++e) acc += bf2f(*(const LAS bf16*)(kb + 2 * e)) * bf2f(*(const LAS bf16*)(u15 + 2 * e)); }
        { const int row = 240 + c; const LAS unsigned char* rp = L + S5_B + row * 256 + ((q ^ (row & 15)) << 4); const LAS float* xb0 = (const LAS float*)(L + S5_XB0);
          const int rt = q >> 2, s = (q >> 1) & 1, hh = q & 1;
#pragma unroll
          for (int j = 0; j < 8; ++j) { const int sig = 16 * s + 8 * (j >> 2) + 4 * hh + (j & 3); acc += bf2f(*(const LAS bf16*)(rp + 2 * j)) * xb0[(rt & 1) * 64 + 32 * (rt >> 1) + sig]; } }
#pragma unroll
        for (int o = 1; o < 16; o <<= 1) acc += __shfl_xor(acc, o);
        if (q == 0) SMP(bf16, SM_AYG15)[b * 1024 + g * 16 + c] = (bf16)f2bf(gelu_tanh(acc));
    }
    __syncthreads();
}

__device__ __forceinline__ void p5_fixup_panel(Frame& F, int pm) {
    const float* EA = WSP(float, WS_EA); const float* EP = WSP(float, WS_EP); const float* EG = WSP(float, WS_EG);
    const float* cw = F.in[IN_CONVW]; bf16* ACT = WSP(bf16, WS_ACT);
    for (int j = F.tid * 4; j < DFF; j += NWAVES * 64 * 4) {
        const f32x4 w0 = *(const f32x4*)(cw + j), w2 = *(const f32x4*)(cw + 2 * DFF + j);
        f32x4 p[8], g[8], nb[8];
#pragma unroll
        for (int e = 0; e < 8; e += 7) { const int er = 8 * pm + e, eblk = er >> 1, side = er & 1, row = eblk * 64 + (side ? 63 : 0);
            p[e] = *(const f32x4*)(EP + (size_t)er * DFF + j); g[e] = *(const f32x4*)(EG + (size_t)er * DFF + j);
            if (!side) nb[e] = ((row & 4095) == 0) ? *(const f32x4*)(SMP(float, SM_A15) + (row >> 12) * DFF + j) : *(const f32x4*)(EA + (size_t)((eblk - 1) * 2 + 1) * DFF + j);
            else nb[e] = ((row & 4095) == 4095) ? (f32x4){0.f, 0.f, 0.f, 0.f} : *(const f32x4*)(EA + (size_t)((eblk + 1) * 2) * DFF + j); }
#pragma unroll
        for (int e = 0; e < 8; e += 7) { const int er = 8 * pm + e, row = (er >> 1) * 64 + ((er & 1) ? 63 : 0); const f32x4 v = p[e] + ((er & 1) ? w2 : w0) * nb[e];
            v2u w; w.x = cvtpk(gelu_tanh(v[0]) * g[e][0], gelu_tanh(v[1]) * g[e][1]); w.y = cvtpk(gelu_tanh(v[2]) * g[e][2], gelu_tanh(v[3]) * g[e][3]);
            *(v2u*)(ACT + (size_t)row * DFF + j) = w; }
    }
}
__device__ __forceinline__ void p7_final(Frame& F) {
    const float* rowsq = (const float*)(F.ws + WS_CTL + CTL_ROWSQ3); const f32x4* gf = (const f32x4*)F.in[IN_GF] + F.lane;
    for (int m = F.gw; m < M; m += 2 * F.NGW) {
        const int m2 = m + F.NGW;
        const float rs = 1.0f / sqrtf(rowsq[m] * (1.0f / DM) + EPS), rs2 = 1.0f / sqrtf(rowsq[m2] * (1.0f / DM) + EPS);
        const v2u* hr = (const v2u*)(WSP(bf16, WS_H3B) + (size_t)m * DM) + F.lane; const v2u* hr2 = (const v2u*)(WSP(bf16, WS_H3B) + (size_t)m2 * DM) + F.lane;
        f32x4* xr = (f32x4*)(F.out + (size_t)m * DM) + F.lane; f32x4* xr2 = (f32x4*)(F.out + (size_t)m2 * DM) + F.lane;
        v2u a[8], b[8];
#pragma unroll
        for (int j = 0; j < 8; ++j) { a[j] = hr[64 * j]; b[j] = hr2[64 * j]; }
#pragma unroll
        for (int j = 0; j < 8; ++j) { const f32x4 g = gf[64 * j];
            f32x4 va, vb; va[0] = __builtin_bit_cast(float, a[j].x << 16); va[1] = __builtin_bit_cast(float, a[j].x & 0xffff0000u); va[2] = __builtin_bit_cast(float, a[j].y << 16); va[3] = __builtin_bit_cast(float, a[j].y & 0xffff0000u);
            vb[0] = __builtin_bit_cast(float, b[j].x << 16); vb[1] = __builtin_bit_cast(float, b[j].x & 0xffff0000u); vb[2] = __builtin_bit_cast(float, b[j].y << 16); vb[3] = __builtin_bit_cast(float, b[j].y & 0xffff0000u);
            xr[64 * j] = va * rs * g; xr2[64 * j] = vb * rs2 * g; }
    }
}

#ifndef MK_N_LAUNCHES
#define MK_N_LAUNCHES 1
#endif
constexpr int N_PHASES = 10;
#ifndef GEMM_ALIGN
#define GEMM_ALIGN true
#endif
#ifndef GEMM_SP2
#define GEMM_SP2 true
#endif
struct Args { const float* in[23]; float* out; unsigned char* ws; int ph_lo, ph_hi, li, pad; };
__global__ void __launch_bounds__(NWAVES * 64, 2) skel_fwd(Args args) {
    extern __shared__ __attribute__((aligned(16))) unsigned char lds_raw[];
    Frame F;
    F.lds = (LAS unsigned char*)lds_raw;
    F.tid = threadIdx.x; F.lane = F.tid & 63; F.wave = __builtin_amdgcn_readfirstlane(F.tid >> 6);
    F.G = gridDim.x; { const int bx = blockIdx.x; F.vcu = (F.G % 8 == 0) ? (bx % 8) * (F.G / 8) + bx / 8 : bx; }
    F.gw = F.vcu * NWAVES + F.wave; F.NGW = F.G * NWAVES;
#pragma unroll
    for (int i = 0; i < 23; ++i) F.in[i] = args.in[i];
    F.out = args.out; F.ws = args.ws;
    volatile LAS unsigned* MISC = (volatile LAS unsigned*)(F.lds + MISC_OFF);
    for (int u = F.tid; u < (LDS_BYTES - RING_BYTES) / 4; u += NWAVES * 64) ((LAS unsigned*)(F.lds + RING_BYTES))[u] = 0u;
    __syncthreads();
    XcdBarrier bar; bar.bar = (unsigned*)(F.ws + WS_CTL) + CW_BAR; bar.x = 0; bar.st = nullptr;
    if (MK_N_LAUNCHES == 1) bar = xcd_barrier_post((unsigned*)(F.ws + WS_CTL) + CW_BAR, MISC + 8);
    const int lo = args.ph_lo, hi = args.ph_hi;
#define IN(k) (lo <= (k) && (k) < hi)
#define SEAM(k) do { if (IN(k) && IN((k) + 1)) xcd_barrier(bar); } while (0)
    const int bid = (int)blockIdx.x;

    if (IN(0)) { p0_prologue(F); } SEAM(0);

    if (IN(1)) {
        p1_meta(F); VM_WAIT(); __syncthreads();
        { pg8::Gemm g{WSP(bf16, WS_XB), WSP(bf16, WS_WIN) + (size_t)2048 * DM, M, 1024, DM}; pg8::StaticOrder S; S.init(M, 1024, F.G, bid);
          EpiG1 E{SMP(float, SM_R1), WSP(bf16, WS_Q), WSP(bf16, WS_K), WSP(bf16, WS_U), WSP(unsigned char, WS_SGNA), WSP(unsigned char, WS_SGSSM), 8};
          pg8::gemm_phase<EpiG1, pg8::StaticOrder, GEMM_ALIGN, GEMM_SP2>(F.lds, g, S, E);
          }
        { pg8::Gemm g{OUTP(bf16, OUT_XB8), OUTP(bf16, OUT_W8), M, 6144, DM / 2}; pg8::StaticOrder S; S.init(M, 6144, F.G, bid);
          EpiQKG E{SMP(float, SM_R1), WSP(bf16, WS_Q), WSP(bf16, WS_K), WSP(unsigned char, WS_SGNA), WSP(unsigned char, WS_SGSSM)};
          pg8::gemm_phase<EpiQKG, pg8::StaticOrder, GEMM_ALIGN, GEMM_SP2, true>(F.lds, g, S, E);
          }
        { pg8::Gemm g{OUTP(bf16, OUT_WV8), OUTP(bf16, OUT_XB8), 1024, M, DM / 2}; pg8::StaticOrder S; S.init(1024, M, F.G, bid);
          EpiVt E{SMP(float, SM_R1), WSP(bf16, WS_VT)};
          pg8::gemm_phase<EpiVt, pg8::StaticOrder, GEMM_ALIGN, GEMM_SP2, true>(F.lds, g, S, E);
          }
    } SEAM(1);

    if (IN(2)) {
        for (int bg = F.vcu; bg < NB * 64; bg += F.G) s5_block(F, bg >> 6, bg & 63);
        if (F.wave == 7 && F.vcu < NHEAD) p2_meta_attn(F, F.vcu);
        LAS bf16* P = (LAS bf16*)(F.lds + F.wave * 9216);
        { constexpr int NGRP = NB * NHEAD * 32;
          v4u kp[9]; float bp[2]; bf16x8 qf[2]; int gi = F.vcu;
          if (gi < NGRP) { na_prefetch(F, gi, kp, bp); na_commit(F, kp, bp); na_qload(F, gi, qf); }
          __syncthreads();
          for (; gi < NGRP; gi += F.G) { const bool hn = gi + F.G < NGRP;
              if (hn) na_prefetch(F, gi + F.G, kp, bp);
              na_task(F, gi, P, kp, bp, qf, hn);
              __syncthreads(); } }
    } SEAM(2);

    if (IN(3)) {
        p3a_meta(F); VM_WAIT(); __syncthreads();
        pg8::Gemm g{OUTP(bf16, OUT_YG), WSP(bf16, WS_WGLU), M, 1024, 1024}; pg8::StaticOrder S; S.init(M, 1024, F.G, bid);
        EpiGlu E{OUTP(bf16, OUT_YG), OUTP(bf16, OUT_SGLU)};
        pg8::gemm_phase<EpiGlu, pg8::StaticOrder, GEMM_ALIGN, GEMM_SP2>(F.lds, g, S, E);
    } SEAM(3);

    if (IN(4)) {
        p3b_meta(F); VM_WAIT(); __syncthreads();
        { pg8::Gemm g{WSP(bf16, WS_O), OUTP(bf16, OUT_WNA8), M, DM, 512}; pg8::StaticOrder S; S.init(M, DM, F.G, bid);
          EpiMix<false> E{WSP(unsigned char, WS_SGNA), WSP(bf16, WS_MIX), 1.0f / (255.f * 1024.f)};
          pg8::gemm_phase<EpiMix<false>, pg8::StaticOrder, GEMM_ALIGN, GEMM_SP2, true>(F.lds, g, S, E);
          }
        { pg8::Gemm g{OUTP(bf16, OUT_SGLU), WSP(bf16, WS_WSSM), M, DM, 1024}; pg8::StaticOrder S; S.init(M, DM, F.G, bid);
          EpiMix<true> E{WSP(unsigned char, WS_SGSSM), WSP(bf16, WS_MIX), 1.0f / 255.f};
          pg8::gemm_phase<EpiMix<true>, pg8::StaticOrder, GEMM_ALIGN, GEMM_SP2>(F.lds, g, S, E); }
    } SEAM(4);

    if (IN(5)) {
        p3c_meta(F); VM_WAIT(); __syncthreads();
        pg8::Gemm g{WSP(bf16, WS_MIX), WSP(bf16, WS_WOUT), M, DM, DM}; pg8::StaticOrder S; S.init(M, DM, F.G, bid);
        EpiRes<true> E{WSP(bf16, WS_XB), WSP(bf16, WS_H2B), (float*)(F.ws + WS_CTL + CTL_ROWSQ2)};
        pg8::gemm_phase<EpiRes<true>, pg8::StaticOrder, GEMM_ALIGN, GEMM_SP2>(F.lds, g, S, E);
    } SEAM(5);

    if (IN(6)) {
        p4_meta(F); VM_WAIT(); __syncthreads();
        pg8::Gemm g{WSP(bf16, WS_H2B), WSP(bf16, WS_WUP), M, 2 * DFF, DM}; pg8::StaticOrder S; S.init(M, 2 * DFF, F.G, bid);
        EpiUp E{(const float*)(F.ws + WS_CTL + CTL_ROWSQ2), F.in[IN_CONVW], F.in[IN_CONVB], WSP(bf16, WS_ACT), WSP(float, WS_EA), WSP(float, WS_EP), WSP(float, WS_EG), F.lds + RING_BYTES};
        pg8::gemm_phase<EpiUp, pg8::StaticOrder, GEMM_ALIGN, GEMM_SP2>(F.lds, g, S, E);
    } SEAM(6);

    if (IN(8)) {
        pg8::Gemm g{WSP(bf16, WS_ACT), WSP(bf16, WS_WDOWN), M, DM, DFF}; pg8::StaticOrder S; S.init(M, DM, F.G, bid);
        { pg8::Unit u; int lastpm = -1; for (int i = 0; S.next(i, u); ++i) if (u.pm != lastpm) { p5_fixup_panel(F, u.pm); lastpm = u.pm; } }
        VM_WAIT(); __syncthreads();
        EpiRes<false> E{WSP(bf16, WS_H2B), WSP(bf16, WS_H3B), (float*)(F.ws + WS_CTL + CTL_ROWSQ3)};
        pg8::gemm_phase<EpiRes<false>, pg8::StaticOrder, GEMM_ALIGN, GEMM_SP2>(F.lds, g, S, E);
    } SEAM(8);

    if (IN(9)) { p7_final(F); }

#undef IN
#undef SEAM
}

extern "C" void kernel_launch(void* const* d_in, const int* in_sizes, int n_in, void* d_out, int out_size, void* d_ws, size_t ws_size, hipStream_t stream) {
    static int grid = 0;
    if (grid == 0) {
        if (n_in != 23 || out_size != M * DM || ws_size < WS_END) { fprintf(stderr, "kernel_launch: unexpected shapes (n_in %d out %d ws %zu)\n", n_in, out_size, ws_size); grid = -1; return; }
        int dev = 0, cus = 0, per_cu = 0;
        if (hipGetDevice(&dev) != hipSuccess || hipDeviceGetAttribute(&cus, hipDeviceAttributeMultiprocessorCount, dev) != hipSuccess) { grid = -1; return; }
        if (hipFuncSetAttribute((const void*)skel_fwd, hipFuncAttributeMaxDynamicSharedMemorySize, LDS_BYTES) != hipSuccess) { fprintf(stderr, "kernel_launch: hipFuncSetAttribute failed\n"); grid = -1; return; }
        if (hipOccupancyMaxActiveBlocksPerMultiprocessor(&per_cu, (const void*)skel_fwd, NWAVES * 64, LDS_BYTES) != hipSuccess || per_cu < 1) fprintf(stderr, "kernel_launch: occupancy query reports %d\n", per_cu);
        (void)hipGetLastError();
        grid = cus;
    }
    if (grid < 0) return;
    if (hipMemsetAsync((char*)d_ws + WS_CTL, 0, CTL_ZERO_BYTES, stream) != hipSuccess) return;
    Args a{};
    for (int i = 0; i < 23; ++i) a.in[i] = (const float*)d_in[i];
    a.out = (float*)d_out; a.ws = (unsigned char*)d_ws;
    const int nl = MK_N_LAUNCHES;
    for (int li = 0; li < nl; ++li) {
        a.ph_lo = (MK_N_LAUNCHES == 1) ? 0 : li; a.ph_hi = (MK_N_LAUNCHES == 1) ? N_PHASES : li + 1; a.li = li;
        hipLaunchKernelGGL(skel_fwd, dim3(grid), dim3(NWAVES * 64), LDS_BYTES, stream, a);
        const hipError_t le = hipPeekAtLastError();
        if (le != hipSuccess) { fprintf(stderr, "kernel_launch: launch %d failed: %s\n", li, hipGetErrorName(le)); break; }
    }
}
```

```cpp
#include <hip/hip_runtime.h>
#include <cstdio>
#include <cstdint>
#define MK_N_LAUNCHES 1
namespace pg8 {
#define PG8_LAS __attribute__((address_space(3)))
typedef unsigned short bf16_t;
typedef short bf16x8 __attribute__((ext_vector_type(8)));
typedef float f32x4 __attribute__((ext_vector_type(4)));
typedef unsigned u32x4 __attribute__((ext_vector_type(4)));
constexpr int BM = 256, BK = 64, HALF = 128, HTB = HALF * BK * 2  , STAGE_BYTES = 8 * HTB, NXCD = 8, WGM = 8;

__host__ __device__ __forceinline__ int lds_byte(int r, int c) { const int st = (r >> 4) * 2 + (c >> 5), rr = r & 15, cc = c & 31, ob = rr * 64 + cc * 2; return st * 1024 + (ob ^ (((ob >> 9) & 1) << 5)); }
__host__ __device__ __forceinline__ void stage_rc(int b, int& R, int& C) { const int st = b / 1024, sb = b % 1024, swz = sb ^ (((sb >> 9) & 1) << 5); R = (st >> 1) * 16 + swz / 64; C = (st & 1) * 32 + (swz % 64) / 2; }
__host__ __device__ __forceinline__ int perm32(int rho) { const int n = rho >> 4, i = rho & 15; return 8 * (i >> 2) + 4 * n + (i & 3); }

struct Unit { int pm, pn; };
struct Gemm { const bf16_t* A; const bf16_t* Bt; int M, N, K; int blk = 0; };

struct StaticOrder {
    int nM, nN, nwg, G, c, wgm;
    __host__ __device__ void init(int M, int N, int G_, int c_, int wgm_ = WGM) { nM = M / BM; nN = N / BM; nwg = nM * nN; G = G_; c = c_; wgm = wgm_; }
    __host__ __device__ bool next(int i, Unit& u) const {
        const long L = (long)i * G + c; if (L >= nwg) return false;
        int wgid = (int)L; { const int q = nwg / NXCD, r = nwg % NXCD, xcd = wgid % NXCD, off = wgid / NXCD; wgid = (xcd < r ? xcd * (q + 1) : r * (q + 1) + (xcd - r) * q) + off; }
        const int nig = wgm * nN, gid = wgid / nig, fm = gid * wgm, gsz = (nM - fm) < wgm ? (nM - fm) : wgm;
        u.pm = fm + ((wgid % nig) % gsz); u.pn = (wgid % nig) / gsz; return true;
    }
    __device__ __forceinline__ void a_ready(const Unit&) const {}
    __device__ __forceinline__ void done(const Unit&) const {}
};

__device__ __forceinline__ unsigned cvt_pk_bf16(float lo, float hi) { unsigned r; asm volatile("v_cvt_pk_bf16_f32 %0, %1, %2" : "=v"(r) : "v"(lo), "v"(hi)); return r; }
typedef float f32x2 __attribute__((ext_vector_type(2)));
typedef int v8i32 __attribute__((ext_vector_type(8)));
typedef int i32x4_ __attribute__((ext_vector_type(4)));
template <class Epi, class Sched, bool ALIGN_EPI = false, bool SP2 = false, bool F8 = false>
__device__ __forceinline__ void gemm_phase(PG8_LAS unsigned char* lds, const Gemm g, const Sched& S, const Epi& E) {
    const int tid = threadIdx.x, wid = __builtin_amdgcn_readfirstlane(tid >> 6), lane = tid & 63, wr = wid >> 2, wc = wid & 3, fr = lane & 15, fq = lane >> 4;
    const int K = g.K, nt = K / BK;
    unsigned voffA[2], voffB[2];
#pragma unroll
    for (int i = 0; i < 2; ++i) { int R, C; stage_rc(tid * 16 + i * 8192, R, C); const int Rb = Epi::PERM ? ((R & ~31) + perm32(R & 31)) : R;
        const int Ra = Epi::APERM ? ((R & ~63) + 4 * (R & 15) + ((R >> 4) & 3)) : R;
        voffA[i] = (unsigned)(Ra * (g.blk ? BK : K) + C) * 2u; voffB[i] = (unsigned)(Rb * (g.blk ? BK : K) + C) * 2u; }
    const size_t kstepA = g.blk ? (size_t)g.M * BK * 2 : (size_t)(BK * 2), kstepB = g.blk ? (size_t)g.N * BK * 2 : (size_t)(BK * 2);
    const size_t hstep = (size_t)HALF * (g.blk ? BK : K) * 2;
    const size_t tstep = 2 * hstep;
    const unsigned ldsw = (unsigned)wid * 1024u;
    const int aoff = lds_byte(wr * 64 + fr, fq * 8), boff = lds_byte(wc * 32 + fr, fq * 8);
#define PG8_SA(b, h) (((b) * 2 + (h)) * HTB)
#define PG8_SB(b, h) ((4 + (b) * 2 + (h)) * HTB)
#define PG8_STAGE(bufoff, gbase, voff) do { _Pragma("unroll") for (int _i = 0; _i < 2; ++_i) \
        __builtin_amdgcn_global_load_lds((const unsigned*)((const char*)(gbase) + (voff)[_i]), (PG8_LAS unsigned*)(lds + (bufoff) + ldsw + _i * 8192), 16, 0, 0); } while (0)
#define PG8_LDA(dst, b, h) do { _Pragma("unroll") for (int m = 0; m < 4; ++m) _Pragma("unroll") for (int k = 0; k < 2; ++k) dst[m][k] = *(const PG8_LAS bf16x8*)(lds + PG8_SA(b, h) + aoff + m * 2048 + k * 1024); } while (0)
#define PG8_LDB(dst, b, h) do { _Pragma("unroll") for (int n = 0; n < 2; ++n) _Pragma("unroll") for (int k = 0; k < 2; ++k) dst[n][k] = *(const PG8_LAS bf16x8*)(lds + PG8_SB(b, h) + boff + n * 2048 + k * 1024); } while (0)
#define PG8_CAT8(x, y) (__builtin_shufflevector(__builtin_bit_cast(i32x4_, x), __builtin_bit_cast(i32x4_, y), 0, 1, 2, 3, 4, 5, 6, 7))
#define PG8_MMA(ai, bj, At, Bt) do { __builtin_amdgcn_s_setprio(1); \
        if constexpr (F8) { _Pragma("unroll") for (int m = 0; m < 4; ++m) _Pragma("unroll") for (int n = 0; n < 2; ++n) { const v8i32 b8_ = PG8_CAT8(Bt[n][0], Bt[n][1]), a8_ = PG8_CAT8(At[m][0], At[m][1]); \
            asm volatile("v_mfma_f32_16x16x128_f8f6f4 %0, %1, %2, %0" : "+v"(acc[ai][bj][m][n]) : "v"(b8_), "v"(a8_)); } } \
        else { _Pragma("unroll") for (int m = 0; m < 4; ++m) _Pragma("unroll") for (int n = 0; n < 2; ++n) _Pragma("unroll") for (int k = 0; k < 2; ++k) \
            acc[ai][bj][m][n] = __builtin_amdgcn_mfma_f32_16x16x32_bf16(Bt[n][k], At[m][k], acc[ai][bj][m][n], 0, 0, 0); } __builtin_amdgcn_s_setprio(0); } while (0)
#define PG8_WAIT_V(n) asm volatile("s_waitcnt vmcnt(" #n ")" ::: "memory")
#define PG8_WAIT_L(n) asm volatile("s_waitcnt lgkmcnt(" #n ")" ::: "memory")
#define PG8_BAR __builtin_amdgcn_s_barrier()
#define PG8_SCHED __builtin_amdgcn_sched_barrier(0)
    Unit cur, nxt; int ui = 0;
    if (!S.next(0, cur)) return;
    f32x4 acc[2][2][4][2];
#pragma unroll
    for (int a = 0; a < 2; ++a)
#pragma unroll
        for (int b = 0; b < 2; ++b)
#pragma unroll
            for (int m = 0; m < 4; ++m)
#pragma unroll
                for (int n = 0; n < 2; ++n) acc[a][b][m][n] = (f32x4){0.f, 0.f, 0.f, 0.f};
    bf16x8 At[4][2], B0[2][2], B1[2][2];
    const char* cA = (const char*)g.A + (size_t)cur.pm * tstep; const char* cB = (const char*)g.Bt + (size_t)cur.pn * tstep;
    S.a_ready(cur);
    if constexpr (SP2) {
        PG8_STAGE(PG8_SB(0, 0), cB, voffB); PG8_STAGE(PG8_SB(0, 1), cB + hstep, voffB); PG8_STAGE(PG8_SA(0, 0), cA, voffA); PG8_STAGE(PG8_SA(0, 1), cA + hstep, voffA);
        if (wr == 1) PG8_BAR;
        PG8_WAIT_V(2); PG8_BAR;
        PG8_STAGE(PG8_SB(1, 0), cB + kstepB, voffB); PG8_STAGE(PG8_SA(1, 0), cA + kstepA, voffA); PG8_STAGE(PG8_SB(1, 1), cB + hstep + kstepB, voffB);
        PG8_WAIT_V(6); PG8_BAR;
    } else {
        PG8_STAGE(PG8_SB(0, 0), cB, voffB); PG8_STAGE(PG8_SA(0, 0), cA, voffA); PG8_STAGE(PG8_SB(0, 1), cB + hstep, voffB); PG8_STAGE(PG8_SA(0, 1), cA + hstep, voffA);
        if (wr == 1) PG8_BAR;
        PG8_WAIT_V(4); PG8_BAR;
        PG8_STAGE(PG8_SB(1, 0), cB + kstepB, voffB); PG8_STAGE(PG8_SA(1, 0), cA + kstepA, voffA); PG8_STAGE(PG8_SB(1, 1), cB + hstep + kstepB, voffB);
        PG8_WAIT_V(6); PG8_BAR;
    }
    for (;;) {
        const bool has_next = S.next(ui + 1, nxt);
        const char* nA = has_next ? (const char*)g.A + (size_t)nxt.pm * tstep : cA; const char* nB = has_next ? (const char*)g.Bt + (size_t)nxt.pn * tstep : cB;
        for (int t = 0; t < nt; t += 2) {
            const bool last = (t == nt - 2);
            const char* a1 = cA + (size_t)(t + 1) * kstepA;
            const char* a2 = last ? nA : cA + (size_t)(t + 2) * kstepA; const char* b2 = last ? nB : cB + (size_t)(t + 2) * kstepB;
            const char* a3 = a2 + kstepA; const char* b3 = b2 + kstepB;
            if (last && has_next) S.a_ready(nxt);
            if constexpr (SP2) {
            PG8_LDB(B0, 0, 0); PG8_LDB(B1, 0, 1); PG8_SCHED; PG8_LDA(At, 0, 0); PG8_STAGE(PG8_SA(1, 1), a1 + hstep, voffA);
            PG8_WAIT_V(8); PG8_WAIT_L(0); PG8_BAR; PG8_MMA(0, 0, At, B0); PG8_MMA(0, 1, At, B1); PG8_BAR; PG8_SCHED;
            PG8_LDA(At, 0, 1); PG8_STAGE(PG8_SB(0, 0), b2, voffB); PG8_STAGE(PG8_SB(0, 1), b2 + hstep, voffB); PG8_STAGE(PG8_SA(0, 0), a2, voffA);
            PG8_WAIT_V(8); PG8_WAIT_L(0); PG8_BAR; PG8_MMA(1, 0, At, B0); PG8_MMA(1, 1, At, B1); PG8_BAR; PG8_SCHED;
            PG8_LDB(B0, 1, 0); PG8_LDB(B1, 1, 1); PG8_SCHED; PG8_LDA(At, 1, 0); PG8_STAGE(PG8_SA(0, 1), a2 + hstep, voffA);
            PG8_WAIT_V(8); PG8_WAIT_L(0); PG8_BAR; PG8_MMA(0, 0, At, B0); PG8_MMA(0, 1, At, B1); PG8_BAR; PG8_SCHED;
            PG8_LDA(At, 1, 1); PG8_STAGE(PG8_SB(1, 0), b3, voffB); PG8_STAGE(PG8_SB(1, 1), b3 + hstep, voffB); PG8_STAGE(PG8_SA(1, 0), a3, voffA);
            PG8_WAIT_V(8); PG8_WAIT_L(0); PG8_BAR; PG8_MMA(1, 0, At, B0); PG8_MMA(1, 1, At, B1); PG8_BAR; PG8_SCHED;
            } else {
            PG8_LDB(B0, 0, 0); PG8_SCHED; PG8_LDA(At, 0, 0); PG8_STAGE(PG8_SA(1, 1), a1 + hstep, voffA);
            PG8_WAIT_L(8); PG8_BAR; PG8_WAIT_L(0); PG8_MMA(0, 0, At, B0); PG8_BAR; PG8_SCHED;
            PG8_LDB(B1, 0, 1); PG8_STAGE(PG8_SB(0, 0), b2, voffB);
            PG8_BAR; PG8_WAIT_L(0); PG8_MMA(0, 1, At, B1); PG8_BAR;
            PG8_LDA(At, 0, 1); PG8_STAGE(PG8_SA(0, 0), a2, voffA);
            PG8_BAR; PG8_WAIT_L(0); PG8_MMA(1, 0, At, B0); PG8_BAR; PG8_SCHED;
            PG8_STAGE(PG8_SB(0, 1), b2 + hstep, voffB);
            PG8_WAIT_V(6); PG8_BAR; PG8_MMA(1, 1, At, B1); PG8_BAR;
            PG8_LDB(B0, 1, 0); PG8_SCHED; PG8_LDA(At, 1, 0); PG8_STAGE(PG8_SA(0, 1), a2 + hstep, voffA);
            PG8_WAIT_L(8); PG8_BAR; PG8_WAIT_L(0); PG8_MMA(0, 0, At, B0); PG8_BAR; PG8_SCHED;
            PG8_LDB(B1, 1, 1); PG8_STAGE(PG8_SB(1, 0), b3, voffB);
            PG8_BAR; PG8_WAIT_L(0); PG8_MMA(0, 1, At, B1); PG8_BAR;
            PG8_LDA(At, 1, 1); PG8_STAGE(PG8_SA(1, 0), a3, voffA);
            PG8_BAR; PG8_WAIT_L(0); PG8_MMA(1, 0, At, B0); PG8_BAR; PG8_SCHED;
            PG8_STAGE(PG8_SB(1, 1), b3 + hstep, voffB);
            PG8_WAIT_V(6); PG8_BAR; PG8_MMA(1, 1, At, B1); PG8_BAR;
            }
        }
        if constexpr (F8) asm volatile("s_nop 15\n\ts_nop 15\n\ts_nop 15" ::: "memory");
        if constexpr (ALIGN_EPI) { if (wr == 0) PG8_BAR; }
        if constexpr (!Epi::AFTER_DRAIN) { E(acc, cur, wr, wc, fr, fq); S.done(cur); }
        if (!has_next) break;
#pragma unroll
        for (int a = 0; a < 2; ++a)
#pragma unroll
            for (int b = 0; b < 2; ++b)
#pragma unroll
                for (int m = 0; m < 4; ++m)
#pragma unroll
                    for (int n = 0; n < 2; ++n) acc[a][b][m][n] = (f32x4){0.f, 0.f, 0.f, 0.f};
        cur = nxt; cA = nA; cB = nB; ++ui;
        if constexpr (ALIGN_EPI) { if (wr == 1) PG8_BAR; }
    }
    PG8_WAIT_V(0);
    if constexpr (!ALIGN_EPI) { if (wr == 0) PG8_BAR; }
    PG8_BAR;
    if constexpr (Epi::AFTER_DRAIN) { E.fused(acc, cur, wr, wc, fr, fq, lds, wid, lane); S.done(cur); }
#undef PG8_SA
#undef PG8_SB
#undef PG8_STAGE
#undef PG8_LDA
#undef PG8_LDB
#undef PG8_MMA
#undef PG8_CAT8
#undef PG8_WAIT_V
#undef PG8_WAIT_L
#undef PG8_BAR
#undef PG8_SCHED
}
}
#define GAS __attribute__((address_space(1)))
#define LAS __attribute__((address_space(3)))
typedef unsigned short bf16;
typedef unsigned v4u __attribute__((ext_vector_type(4)));
typedef float f32x4 __attribute__((ext_vector_type(4)));
typedef short bf16x8 __attribute__((ext_vector_type(8)));
typedef GAS unsigned gu32;
typedef GAS unsigned long long gu64;
#define RLX_AGENT __ATOMIC_RELAXED, __HIP_MEMORY_SCOPE_AGENT
#define LDS_WAIT() asm volatile("s_waitcnt lgkmcnt(0)" ::: "memory")
#define VM_WAIT() asm volatile("s_waitcnt vmcnt(0)" ::: "memory")
__device__ __forceinline__ unsigned long long rt() { return __builtin_amdgcn_s_memrealtime(); }
__device__ __forceinline__ unsigned f2bf(float f) { unsigned u = __builtin_bit_cast(unsigned, f); return (u + 0x7fffu + ((u >> 16) & 1u)) >> 16; }
__device__ __forceinline__ unsigned pk2(float lo, float hi) { return f2bf(lo) | (f2bf(hi) << 16); }
#define XB_TMO      128
#define XB_XCNT(j)  (256  + 64 * (j))
#define XB_XSUB(j)  (1280 + 64 * (j))
#define XB_XGEN(j)  (2304 + 64 * (j))
#define XB_TOP      3328
#define XB_TOPGEN   3392
#define XCD_BAR_WORDS 3456
#define XB_SPIN_CAP (1u << 18)

__device__ __forceinline__ unsigned xb_ld(unsigned* p)              { return __hip_atomic_load(p, __ATOMIC_RELAXED, __HIP_MEMORY_SCOPE_AGENT); }
__device__ __forceinline__ unsigned xb_add(unsigned* p, unsigned v) { return __hip_atomic_fetch_add(p, v, __ATOMIC_RELAXED, __HIP_MEMORY_SCOPE_AGENT); }
__device__ __forceinline__ unsigned xb_xcc_id() { return (unsigned)__builtin_amdgcn_s_getreg((3 << 11) | 20) & 0xFu; }
#define XB_SPIN(cond, bar) do { unsigned _sp = 0; while (cond) { __builtin_amdgcn_s_sleep(1); \
    if ((++_sp & 255u) == 0u) { if (xb_ld(&(bar)[XB_TMO])) break; if (_sp > XB_SPIN_CAP) { atomicAdd(&(bar)[XB_TMO], 1u); break; } } } } while (0)

struct XcdBarrier {
    unsigned* bar; unsigned x;
    volatile LAS unsigned* st;
};

__device__ __forceinline__ XcdBarrier xcd_barrier_post(unsigned* bar, volatile LAS unsigned* st) {
    XcdBarrier b; b.bar = bar; b.x = xb_xcc_id(); b.st = st;
    if (threadIdx.x == 0) (void)xb_add(&bar[XB_XCNT(b.x)], 1u);
    return b;
}
__device__ __forceinline__ void xcd_barrier_complete(unsigned* bar, unsigned x, unsigned& nloc, unsigned& nx) {
    const unsigned G = gridDim.x * gridDim.y * gridDim.z;
    unsigned sum, cnt, mine, sp = 0u;
    for (;;) {
        sum = 0u; cnt = 0u; mine = 0u;
#pragma unroll
        for (unsigned j = 0; j < 16; ++j) { const unsigned c = xb_ld(&bar[XB_XCNT(j)]); sum += c; cnt += (c > 0u) ? 1u : 0u; mine = (j == x) ? c : mine; }
        if (sum == G) break;
        __builtin_amdgcn_s_sleep(1);
        if ((++sp & 255u) == 0u) { if (xb_ld(&bar[XB_TMO])) break; if (sp > XB_SPIN_CAP) { atomicAdd(&bar[XB_TMO], 1u); break; } }
    }
    nloc = mine > 0u ? mine : 1u; nx = cnt > 0u ? cnt : 1u;
}

__device__ __forceinline__ void xcd_barrier(const XcdBarrier& b) {
    asm volatile("s_waitcnt vmcnt(0)" ::: "memory");
    __syncthreads();
    if (threadIdx.x == 0) {
        unsigned* bar = b.bar;
        __builtin_amdgcn_s_waitcnt(0);
        unsigned nloc = b.st[0], nx = b.st[1];
        if (nloc == 0u) { xcd_barrier_complete(bar, b.x, nloc, nx); b.st[0] = nloc; b.st[1] = nx; }
        const unsigned old = xb_add(&bar[XB_XSUB(b.x)], 1u);
        const unsigned gen = old / nloc;
        if (old + 1u == (gen + 1u) * nloc) {
            __builtin_amdgcn_fence(__ATOMIC_RELEASE, "agent");
            asm volatile("s_waitcnt vmcnt(0)" ::: "memory");
            const unsigned og = xb_add(&bar[XB_TOP], 1u);
            const unsigned tg = og / nx;
            if (og + 1u == (tg + 1u) * nx) xb_add(&bar[XB_TOPGEN], 1u);
            else XB_SPIN(xb_ld(&bar[XB_TOPGEN]) == tg, bar);
            __builtin_amdgcn_fence(__ATOMIC_ACQUIRE, "agent");
            xb_add(&bar[XB_XGEN(b.x)], 1u);
            asm volatile("s_waitcnt vmcnt(0)" ::: "memory");
        } else {
            XB_SPIN(xb_ld(&bar[XB_XGEN(b.x)]) == gen, bar);
            __builtin_amdgcn_fence(__ATOMIC_ACQUIRE, "agent");
            asm volatile("s_waitcnt vmcnt(0)" ::: "memory");
        }
    }
    __syncthreads();
}

constexpr int NB = 4, SEQ = 4096, DM = 2048, LPOS = 4112, M = NB * SEQ;
constexpr int DFF = 5632, NHEAD = 16, HD = 64;
constexpr int NIN = 8192, NMAIN = 7168;
constexpr int NCH = 257;
constexpr float EPS = 1e-6f;
constexpr int NWAVES = 8;

constexpr size_t MiB = 1u << 20;
constexpr size_t WS_CTL = 0, CTL_ZERO_BYTES = 164 * 1024;
constexpr size_t WS_WIN = 1 * MiB, WS_WUP = 33 * MiB, WS_WDOWN = 77 * MiB, WS_WOUT = 99 * MiB, WS_WNA = 107 * MiB, WS_WSSM = 111 * MiB, WS_WGLU = 115 * MiB;
constexpr size_t WS_Q = 117 * MiB, WS_K = 149 * MiB, WS_VT = 181 * MiB, WS_U = 213 * MiB, WS_O = 247 * MiB;
constexpr size_t WS_MIX = 117 * MiB;
constexpr size_t WS_ACT = 117 * MiB;
constexpr size_t WS_SGNA = 293 * MiB, WS_SGSSM = 357 * MiB;
constexpr size_t WS_H2B = 293 * MiB;
constexpr size_t WS_EA = 357 * MiB, WS_EP = 369 * MiB, WS_EG = 381 * MiB;
constexpr size_t WS_XB = 421 * MiB;
constexpr size_t OUT_WV8 = 22 * MiB;
constexpr size_t OUT_W8 = 64 * MiB;
constexpr size_t OUT_WNA8 = 24 * MiB;
constexpr size_t OUT_WG8 = 26 * MiB, OUT_XB8 = 32 * MiB;
constexpr size_t OUT_YG = 32 * MiB, OUT_SGLU = 64 * MiB;
constexpr size_t WS_H3B = 421 * MiB;
constexpr size_t WS_SMALL = 485 * MiB, WS_END = 512 * MiB;
constexpr size_t SM_R1 = 0, SM_R1M = 192 * 1024, SM_Q15 = 196 * 1024, SM_SGNA15 = 200 * 1024, SM_SGSSM15 = 208 * 1024;
constexpr size_t SM_XBM = 256 * 1024, SM_KM = 320 * 1024, SM_VMT = 352 * 1024, SM_AYG15 = 416 * 1024, SM_AO15 = 448 * 1024, SM_AS15 = 480 * 1024;
constexpr size_t SM_AMIX15 = 512 * 1024, SM_AH2B15 = 576 * 1024, SM_A15 = 640 * 1024, SM_LAM16 = 768 * 1024;
constexpr size_t CTL_ROWSQ2 = 32 * 1024, CTL_ROWSQ3 = 96 * 1024, CTL_ROWSQM = 160 * 1024;
constexpr int CW_BAR = 4096;
constexpr size_t OUT_P = 0, OUT_R = 8 * MiB, OUT_KL = 16 * MiB, OUT_CP = 18 * MiB, OUT_L5 = 20 * MiB;

constexpr int RING_BYTES = 131072;
constexpr int MISC_OFF = 159744 - 256;
constexpr int LDS_BYTES = 159744;
static_assert(MISC_OFF + 128 <= LDS_BYTES, "LDS map");

typedef float f32x2 __attribute__((ext_vector_type(2)));
typedef unsigned v2u __attribute__((ext_vector_type(2)));
struct Frame {
    LAS unsigned char* lds;
    int tid, lane, wave, vcu, G, gw, NGW;
    const float* in[23];
    float* out; unsigned char* ws;
};
#define IN_X 0
#define IN_META 1
#define IN_G1 2
#define IN_WIN 3
#define IN_RPB 4
#define IN_LAMRE 5
#define IN_LAMIM 6
#define IN_LOGSTEP 7
#define IN_BRE 8
#define IN_BIM 9
#define IN_CRE 10
#define IN_CIM 11
#define IN_SSMD 12
#define IN_WGLU 13
#define IN_WNA 14
#define IN_WSSM 15
#define IN_WOUT 16
#define IN_G2 17
#define IN_WUP 18
#define IN_CONVW 19
#define IN_CONVB 20
#define IN_WDOWN 21
#define IN_GF 22
#define WSP(T, off) ((T*)(F.ws + (off)))
#define SMP(T, off) ((T*)(F.ws + WS_SMALL + (off)))
#define OUTP(T, off) ((T*)((unsigned char*)F.out + (off)))

__device__ __forceinline__ float wave_sum(float v) {
#pragma unroll
    for (int o = 1; o < 64; o <<= 1) v += __shfl_xor(v, o);
    return v;
}
typedef __bf16 bf16x2_t __attribute__((ext_vector_type(2)));
__device__ __forceinline__ unsigned cvtpk(float lo, float hi) { f32x2 v = {lo, hi}; bf16x2_t b = __builtin_convertvector(v, bf16x2_t); return __builtin_bit_cast(unsigned, b); }
__device__ __forceinline__ float bf2f(bf16 h) { return __builtin_bit_cast(float, (unsigned)h << 16); }
__device__ __forceinline__ float sigmoidf_(float x) { return __builtin_amdgcn_rcpf(1.0f + __expf(-x)); }
__device__ __forceinline__ float gelu_tanh(float x) { const float z = x * __builtin_fmaf(x * x, -0.10294324f, -2.3022082f); return x * __builtin_amdgcn_rcpf(1.0f + __builtin_amdgcn_exp2f(z)); }
__device__ __forceinline__ unsigned pk4_fp8(float a, float b, float c, float d) { unsigned w = __builtin_amdgcn_cvt_pk_fp8_f32(a, b, 0, false); return __builtin_amdgcn_cvt_pk_fp8_f32(c, d, w, true); }
template <int CTRL> __device__ __forceinline__ float dpp0(float x) { return __builtin_bit_cast(float, __builtin_amdgcn_update_dpp(0, __builtin_bit_cast(int, x), CTRL, 0xf, 0xf, true)); }
__device__ __forceinline__ bf16x8 ldfrag(const bf16* base, int ld, int lane) { return *(const bf16x8*)(base + (size_t)(lane & 15) * ld + 8 * (lane >> 4)); }
__device__ __forceinline__ bf16x8 ldfrag_lds(const LAS bf16* base, int ld, int lane) { return *(const LAS bf16x8*)(base + (lane & 15) * ld + 8 * (lane >> 4)); }
#define MFMA16(a, b, c) __builtin_amdgcn_mfma_f32_16x16x32_bf16((a), (b), (c), 0, 0, 0)
__device__ __forceinline__ bf16x8 dq8(v2u w) {
    const f32x2 a = __builtin_amdgcn_cvt_pk_f32_fp8((int)w.x, false), b = __builtin_amdgcn_cvt_pk_f32_fp8((int)w.x, true), c = __builtin_amdgcn_cvt_pk_f32_fp8((int)w.y, false), d = __builtin_amdgcn_cvt_pk_f32_fp8((int)w.y, true);
    v4u o; o.x = cvtpk(a[0], a[1]); o.y = cvtpk(b[0], b[1]); o.z = cvtpk(c[0], c[1]); o.w = cvtpk(d[0], d[1]); return __builtin_bit_cast(bf16x8, o); }
template <int K> __device__ __forceinline__ f32x4 meta_nt16_f8(Frame& F, const bf16* A, int lda, const unsigned char* Bt8, int ldb) {
    constexpr int NS = K / 8 / 32;
    const int lane = F.lane;
    const bf16* ap = A + (size_t)(lane & 15) * lda + 8 * (lane >> 4) + F.wave * (K / 8); const unsigned char* bp = Bt8 + (size_t)(lane & 15) * ldb + 8 * (lane >> 4) + F.wave * (K / 8);
    bf16x8 a[NS]; v2u b[NS];
#pragma unroll
    for (int i = 0; i < NS; ++i) { a[i] = *(const bf16x8*)(ap + 32 * i); b[i] = *(const v2u*)(bp + 32 * i); }
    f32x4 acc = {0.f, 0.f, 0.f, 0.f};
#pragma unroll
    for (int i = 0; i < NS; ++i) acc = MFMA16(a[i], dq8(b[i]), acc);
    LAS f32x4* red = (LAS f32x4*)F.lds;
    red[F.wave * 64 + lane] = acc;
    __syncthreads();
    f32x4 sum = {0.f, 0.f, 0.f, 0.f};
    if (F.wave == 0) {
#pragma unroll
        for (int w = 0; w < 8; ++w) sum = sum + red[w * 64 + lane]; }
    __syncthreads();
    return sum;
}
template <int K> __device__ __forceinline__ f32x4 meta_nt16_pair(Frame& F, const bf16* A, int lda, const void* Bt, int ldb, bool f8, f32x4* other = nullptr) {
    constexpr int NS = K / 4 / 32;
    const int lane = F.lane, kq = F.wave & 3;
    const bf16* ap = A + (size_t)(lane & 15) * lda + 8 * (lane >> 4) + kq * (K / 4);
    bf16x8 a[NS], b[NS];
#pragma unroll
    for (int i = 0; i < NS; ++i) a[i] = *(const bf16x8*)(ap + 32 * i);
    if (f8) { const unsigned char* bp = (const unsigned char*)Bt + (size_t)(lane & 15) * ldb + 8 * (lane >> 4) + kq * (K / 4); v2u q[NS];
#pragma unroll
        for (int i = 0; i < NS; ++i) q[i] = *(const v2u*)(bp + 32 * i);
#pragma unroll
        for (int i = 0; i < NS; ++i) b[i] = dq8(q[i]); }
    else { const bf16* bp = (const bf16*)Bt + (size_t)(lane & 15) * ldb + 8 * (lane >> 4) + kq * (K / 4);
#pragma unroll
        for (int i = 0; i < NS; ++i) b[i] = *(const bf16x8*)(bp + 32 * i); }
    f32x4 acc = {0.f, 0.f, 0.f, 0.f};
#pragma unroll
    for (int i = 0; i < NS; ++i) acc = MFMA16(a[i], b[i], acc);
    LAS f32x4* red = (LAS f32x4*)F.lds;
    red[F.wave * 64 + lane] = acc;
    __syncthreads();
    f32x4 sum = {0.f, 0.f, 0.f, 0.f};
    if (kq == 0) {
#pragma unroll
        for (int w = 0; w < 4; ++w) sum = sum + red[(F.wave + w) * 64 + lane]; }
    if (other && F.wave == 0) { f32x4 s2 = {0.f, 0.f, 0.f, 0.f};
#pragma unroll
        for (int w = 4; w < 8; ++w) s2 = s2 + red[w * 64 + lane];
        *other = s2; }
    __syncthreads();
    return sum;
}
template <int K> __device__ __forceinline__ f32x4 meta_nt16(Frame& F, const bf16* A, int lda, const bf16* Bt, int ldb) {
    constexpr int NS = K / 8 / 32;
    const int lane = F.lane;
    const bf16* ap = A + (size_t)(lane & 15) * lda + 8 * (lane >> 4) + F.wave * (K / 8); const bf16* bp = Bt + (size_t)(lane & 15) * ldb + 8 * (lane >> 4) + F.wave * (K / 8);
    bf16x8 a[NS], b[NS];
#pragma unroll
    for (int i = 0; i < NS; ++i) { a[i] = *(const bf16x8*)(ap + 32 * i); b[i] = *(const bf16x8*)(bp + 32 * i); }
    f32x4 acc = {0.f, 0.f, 0.f, 0.f};
#pragma unroll
    for (int i = 0; i < NS; ++i) acc = MFMA16(a[i], b[i], acc);
    LAS f32x4* red = (LAS f32x4*)F.lds;
    red[F.wave * 64 + lane] = acc;
    __syncthreads();
    f32x4 sum = {0.f, 0.f, 0.f, 0.f};
    if (F.wave == 0) {
#pragma unroll
        for (int w = 0; w < 8; ++w) sum = sum + red[w * 64 + lane]; }
    __syncthreads();
    return sum;
}

constexpr int P0_TP = 264;
__device__ __forceinline__ void p0_transpose_item(const float* W, int K, int N, bf16* WT, int dest_row0, const float* kscale, LAS bf16* TT, int kb, int nb, int lane, int wave, unsigned char* W8 = nullptr, int dest8_row0 = 0, bool keep16 = false, bool kblk = false) {
    const int k0 = 256 * kb + 32 * wave, n0 = 128 * nb, kr = lane >> 5, n4 = (lane & 31) * 4;
    f32x4 v[16]; unsigned loff = (unsigned)(kr * 16 * N + n4) * 4u; asm volatile("" : "+v"(loff));
#pragma unroll
    for (int i = 0; i < 16; ++i) v[i] = __builtin_nontemporal_load((const f32x4*)((const char*)(W + (size_t)(k0 + i) * N + n0) + loff));
    if (kscale) {
#pragma unroll
        for (int i = 0; i < 16; ++i) v[i] = v[i] * kscale[k0 + 16 * kr + i]; }
    LAS unsigned* TT32 = (LAS unsigned*)TT;
#pragma unroll
    for (int p8 = 0; p8 < 8; ++p8) { const int kd = 16 * wave + ((8 * kr + p8) ^ (4 * (lane & 3)));
#pragma unroll
        for (int cc = 0; cc < 4; ++cc) TT32[(n4 + cc) * (P0_TP / 2) + kd] = cvtpk(v[2 * p8][cc], v[2 * p8 + 1][cc]); }
    __syncthreads();
    const int c = lane & 31, nr = lane >> 5;
#pragma unroll
    for (int j = 0; j < 8; ++j) { const int n = 16 * wave + 2 * j + nr; const v4u w = *(const LAS v4u*)(TT + n * P0_TP + 8 * (c ^ ((n >> 2) & 3)));
        if (!W8 || keep16) *(v4u*)(WT + (kblk ? ((size_t)(4 * kb + (c >> 3)) * N + dest_row0 + n) * 64 + 8 * (c & 7) : (size_t)(dest_row0 + n) * K + 256 * kb + 8 * c)) = w;
        if (W8) { v2u q;
            q.x = pk4_fp8(64.f * __builtin_bit_cast(float, w.x << 16), 64.f * __builtin_bit_cast(float, w.x & 0xffff0000u), 64.f * __builtin_bit_cast(float, w.y << 16), 64.f * __builtin_bit_cast(float, w.y & 0xffff0000u));
            q.y = pk4_fp8(64.f * __builtin_bit_cast(float, w.z << 16), 64.f * __builtin_bit_cast(float, w.z & 0xffff0000u), 64.f * __builtin_bit_cast(float, w.w << 16), 64.f * __builtin_bit_cast(float, w.w & 0xffff0000u));
            *(v2u*)(W8 + (size_t)(dest8_row0 + n) * K + 256 * kb + 8 * c) = q; } }
    __syncthreads();
}
__device__ __forceinline__ void p0_row(const float* xrow, bf16* orow, float* rout, int lane, unsigned* o8row = nullptr) {
    const f32x4* xr = (const f32x4*)xrow + lane;
    f32x4 v[8]; float s = 0.f;
#pragma unroll
    for (int j = 0; j < 8; ++j) { v[j] = __builtin_nontemporal_load(xr + 64 * j); s += (v[j].x * v[j].x + v[j].y * v[j].y) + (v[j].z * v[j].z + v[j].w * v[j].w); }
    s = wave_sum(s);
    if (lane == 0) *rout = 1.0f / sqrtf(s * (1.0f / DM) + EPS);
    unsigned long long* o8 = (unsigned long long*)orow + lane;
#pragma unroll
    for (int j = 0; j < 8; ++j) o8[64 * j] = (unsigned long long)pk2(v[j].x, v[j].y) | ((unsigned long long)pk2(v[j].z, v[j].w) << 32);
    if (o8row) {
#pragma unroll
        for (int j = 0; j < 8; ++j) o8row[64 * j + lane] = pk4_fp8(v[j].x, v[j].y, v[j].z, v[j].w); }
}
__device__ __forceinline__ void p0_row_load(const float* xrow, f32x4 (&v)[8], int lane) {
    const f32x4* xr = (const f32x4*)xrow + lane;
#pragma unroll
    for (int j = 0; j < 8; ++j) v[j] = __builtin_nontemporal_load(xr + 64 * j);
}
__device__ __forceinline__ void p0_row_finish(const f32x4 (&v)[8], bf16* orow, float* rout, int lane, unsigned* o8row) {
    float s = 0.f;
#pragma unroll
    for (int j = 0; j < 8; ++j) s += (v[j].x * v[j].x + v[j].y * v[j].y) + (v[j].z * v[j].z + v[j].w * v[j].w);
    s = wave_sum(s);
    if (lane == 0) *rout = 1.0f / sqrtf(s * (1.0f / DM) + EPS);
    unsigned long long* o8 = (unsigned long long*)orow + lane;
#pragma unroll
    for (int j = 0; j < 8; ++j) o8[64 * j] = (unsigned long long)pk2(v[j].x, v[j].y) | ((unsigned long long)pk2(v[j].z, v[j].w) << 32);
#pragma unroll
    for (int j = 0; j < 8; ++j) o8row[64 * j + lane] = pk4_fp8(v[j].x, v[j].y, v[j].z, v[j].w);
}
__device__ __forceinline__ void sincos_d(double x, double& s, double& c) {
    const double TWO_PI = 6.283185307179586476925286766559;
    const double k = __builtin_rint(x / TWO_PI); double r = x - k * TWO_PI; r *= 0.25;
    const double r2 = r * r;
    double sn = r * (1.0 + r2 * (-1.0 / 6 + r2 * (1.0 / 120 + r2 * (-1.0 / 5040 + r2 * (1.0 / 362880 + r2 * (-1.0 / 39916800 + r2 * (1.0 / 6227020800.0)))))));
    double cs = 1.0 + r2 * (-0.5 + r2 * (1.0 / 24 + r2 * (-1.0 / 720 + r2 * (1.0 / 40320 + r2 * (-1.0 / 3628800 + r2 * (1.0 / 479001600.0 + r2 * (-1.0 / 87178291200.0)))))));
#pragma unroll
    for (int i = 0; i < 2; ++i) { const double s2 = 2.0 * sn * cs, c2 = cs * cs - sn * sn; sn = s2; cs = c2; }
    s = sn; c = cs;
}
__device__ __forceinline__ void cpow_(float lre, float lim, float step, int k, float& pr, float& pi) {
    const float mag = expf(lre * step * (float)k); double sd, cd; sincos_d((double)lim * (double)step * (double)k, sd, cd); pr = mag * (float)cd; pi = mag * (float)sd;
}
__device__ __forceinline__ void p0_s5_tables(Frame& F, int dir, int g, int half) {
    LAS float* LP = (LAS float*)F.lds;
    LAS float* BB = LP + 17 * 64 * 2;
    LAS float* CC = BB + 64 * 16 * 2;
    LAS float* KK = CC + 16 * 64 * 2;
    const int t = F.tid, dg = dir * 64 + g, lane = F.lane;
    unsigned char* ob = (unsigned char*)F.out;
    const float step = expf(F.in[IN_LOGSTEP][dg]);
    for (int e = t; e < 64 * (half ? 38 : 17); e += 512) { const int n = e & 63, idx = e >> 6;
        const float lre = F.in[IN_LAMRE][dg * 64 + n], lim = F.in[IN_LAMIM][dg * 64 + n];
        const int k = idx <= 16 ? idx : (idx < 22 ? (16 << (idx - 17)) : 16 * (dir ? 15 - (idx - 22) : (idx - 22)));
        float pr, pi; cpow_(lre, lim, step, k, pr, pi);
        if (idx <= 16) { LP[(idx * 64 + n) * 2] = pr; LP[(idx * 64 + n) * 2 + 1] = pi; }
        else if (idx < 22) { float* L5 = (float*)(ob + OUT_L5 + (size_t)dg * 2560); L5[((idx - 17) * 64 + n) * 2] = pr; L5[((idx - 17) * 64 + n) * 2 + 1] = pi; }
        else { float* CP = (float*)(ob + OUT_CP + (size_t)dg * 9216); CP[(idx - 22) * 130 + 2 * n] = pr; CP[(idx - 22) * 130 + 2 * n + 1] = pi; } }
    for (int e = t; e < 1024; e += 512) { const int c = e >> 6, n = e & 63; CC[e * 2] = F.in[IN_CRE][(dg * 16 + c) * 64 + n]; CC[e * 2 + 1] = F.in[IN_CIM][(dg * 16 + c) * 64 + n]; }
    __syncthreads();
    for (int e = t; e < 1024; e += 512) { const int n = e >> 4, c = e & 15;
        const float lre = F.in[IN_LAMRE][dg * 64 + n], lim = F.in[IN_LAMIM][dg * 64 + n], l1r = LP[(64 + n) * 2], l1i = LP[(64 + n) * 2 + 1];
        const float ar = l1r - 1.f, ai = l1i, den = 1.0f / (lre * lre + lim * lim), fr_ = (ar * lre + ai * lim) * den, fi_ = (ai * lre - ar * lim) * den;
        const float br = F.in[IN_BRE][(dg * 64 + n) * 16 + c], bi = F.in[IN_BIM][(dg * 64 + n) * 16 + c];
        BB[e * 2] = fr_ * br - fi_ * bi; BB[e * 2 + 1] = fr_ * bi + fi_ * br; }
    __syncthreads();
    if (!half) {
        bf16* P = (bf16*)(ob + OUT_P) + (size_t)dg * 128 * 256;
        for (int e8 = t; e8 < 128 * 256 / 8; e8 += 512) { const int e = 8 * e8, rho = e >> 8, k = e & 255, part = (rho >> 5) & 1, n = (rho & 31) + 32 * (rho >> 6), j = k >> 4, cp = k & 15, ex = dir ? j : 15 - j;
            const float lr = LP[(ex * 64 + n) * 2], li = LP[(ex * 64 + n) * 2 + 1];
            const LAS f32x4* b4 = (const LAS f32x4*)(BB + (n * 16 + cp) * 2); float o[8];
#pragma unroll
            for (int q = 0; q < 4; ++q) { const f32x4 b = b4[q]; o[2 * q] = part ? (lr * b[1] + li * b[0]) : (lr * b[0] - li * b[1]); o[2 * q + 1] = part ? (lr * b[3] + li * b[2]) : (lr * b[2] - li * b[3]); }
            v4u w; w.x = cvtpk(o[0], o[1]); w.y = cvtpk(o[2], o[3]); w.z = cvtpk(o[4], o[5]); w.w = cvtpk(o[6], o[7]); *(v4u*)(P + e) = w; }
    } else {
#pragma unroll
        for (int dd = 0; dd < 2; ++dd) { const int d = 2 * F.wave + dd, c = lane & 15; f32x4 acc = {0.f, 0.f, 0.f, 0.f};
            for (int tt = 0; tt < 32; ++tt) { const int k = 4 * tt + (lane >> 4), part = k >> 6, n = k & 63;
                const float cr = CC[(c * 64 + n) * 2], ci = CC[(c * 64 + n) * 2 + 1], lr = LP[(d * 64 + n) * 2], li = LP[(d * 64 + n) * 2 + 1];
                const float av = part ? -(cr * li + ci * lr) : (cr * lr - ci * li), bv = BB[(n * 16 + c) * 2 + part];
                acc = __builtin_amdgcn_mfma_f32_16x16x4f32(av, bv, acc, 0, 0, 0); }
#pragma unroll
            for (int r = 0; r < 4; ++r) KK[(d * 16 + 4 * (lane >> 4) + r) * 16 + c] = acc[r]; }
        bf16* R = (bf16*)(ob + OUT_R) + (size_t)dg * 256 * 128;
        for (int e8 = t; e8 < 256 * 128 / 8; e8 += 512) { const int e = 8 * e8, row = e >> 7, kk = e & 127, q = (kk >> 3) ^ (row & 15), rt = q >> 2, s = (q >> 1) & 1, hh = q & 1;
            const int part = rt & 1, i = row >> 4, c = row & 15, ex = dir ? 16 - i : i + 1; float o[8];
#pragma unroll
            for (int jh = 0; jh < 2; ++jh) { const int n0 = 32 * (rt >> 1) + 16 * s + 8 * jh + 4 * hh;
                const LAS f32x4* c4 = (const LAS f32x4*)(CC + (c * 64 + n0) * 2); const LAS f32x4* l4 = (const LAS f32x4*)(LP + (ex * 64 + n0) * 2);
#pragma unroll
                for (int u2 = 0; u2 < 2; ++u2) { const f32x4 cc = c4[u2], ll = l4[u2];
                    o[4 * jh + 2 * u2] = part ? -(cc[0] * ll[1] + cc[1] * ll[0]) : (cc[0] * ll[0] - cc[1] * ll[1]); o[4 * jh + 2 * u2 + 1] = part ? -(cc[2] * ll[3] + cc[3] * ll[2]) : (cc[2] * ll[2] - cc[3] * ll[3]); } }
            v4u w; w.x = cvtpk(o[0], o[1]); w.y = cvtpk(o[2], o[3]); w.z = cvtpk(o[4], o[5]); w.w = cvtpk(o[6], o[7]); *(v4u*)(R + e) = w; }
        __syncthreads();
        bf16* KL = (bf16*)(ob + OUT_KL + (size_t)dg * 9216);
        for (int e = t; e < 17 * 256; e += 512) { const int d = (e >> 8) - 1, c = (e >> 4) & 15, cp = e & 15; float v = 0.f;
            if (d >= 0) { v = KK[(d * 16 + c) * 16 + cp]; if (dir == 0 && d == 0 && c == cp) v += F.in[IN_SSMD][g * 16 + c]; }
            KL[e] = (bf16)f2bf(v); }
    }
    __syncthreads();
}
__device__ __forceinline__ void p0_prologue(Frame& F) {
    for (int v = F.vcu; v < 256; v += F.G) p0_s5_tables(F, (v >> 1) >> 6, (v >> 1) & 63, v & 1);
    LAS bf16* scr = (LAS bf16*)F.lds;
    const int gw = F.gw, NGW = F.NGW;
    constexpr int I_IN = 8 * 64, I_UP = 8 * 88, I_DOWN = 22 * 16, I_OUT = 8 * 16, I_NA = 4 * 16, I_SSM = 4 * 16, I_GLU = 4 * 8;
    constexpr int NITEMS = I_IN + I_UP + I_DOWN + I_OUT + I_NA + I_SSM + I_GLU;
    for (int it = F.vcu; it < NITEMS; it += F.G) {
        int r = it;
        if (r < I_IN) { const int kb = r % 8, nb = r / 8, n0 = nb * 128;
            const int dest = n0 < 2048 ? n0 : (n0 < 3072 ? 7168 + (n0 - 2048) : (n0 < 4096 ? 2048 + (n0 - 3072) : 3072 + (n0 - 4096)));
            p0_transpose_item(F.in[IN_WIN], DM, NIN, WSP(bf16, WS_WIN), dest, F.in[IN_G1], scr, kb, nb, F.lane, F.wave, (n0 < 2048 || n0 >= 4096) ? OUTP(unsigned char, OUT_W8) : (n0 < 3072 ? OUTP(unsigned char, OUT_WV8) : nullptr), n0 < 2048 ? n0 : (n0 >= 4096 ? n0 - 2048 : n0 - 2048)); continue; } r -= I_IN;
        if (r < I_UP) { const int kb = r % 8, nb = r / 8, n0 = nb * 128; const int isg = n0 >= DFF, j0 = isg ? n0 - DFF : n0;
            const int dest = 256 * (j0 >> 7) + (isg ? 128 : 0) + (j0 & 127);
            p0_transpose_item(F.in[IN_WUP], DM, 2 * DFF, WSP(bf16, WS_WUP), dest, F.in[IN_G2], scr, kb, nb, F.lane, F.wave); continue; } r -= I_UP;
        if (r < I_DOWN) { p0_transpose_item(F.in[IN_WDOWN], DFF, DM, WSP(bf16, WS_WDOWN), (r / 22) * 128, nullptr, scr, r % 22, r / 22, F.lane, F.wave, nullptr, 0, false, true); continue; } r -= I_DOWN;
        if (r < I_OUT) { p0_transpose_item(F.in[IN_WOUT], DM, DM, WSP(bf16, WS_WOUT), (r / 8) * 128, nullptr, scr, r % 8, r / 8, F.lane, F.wave); continue; } r -= I_OUT;
        if (r < I_NA) { p0_transpose_item(F.in[IN_WNA], 1024, DM, WSP(bf16, WS_WNA), (r / 4) * 128, nullptr, scr, r % 4, r / 4, F.lane, F.wave, OUTP(unsigned char, OUT_WNA8), (r / 4) * 128); continue; } r -= I_NA;
        if (r < I_SSM) { p0_transpose_item(F.in[IN_WSSM], 1024, DM, WSP(bf16, WS_WSSM), (r / 4) * 128, nullptr, scr, r % 4, r / 4, F.lane, F.wave); continue; } r -= I_SSM;
        p0_transpose_item(F.in[IN_WGLU], 1024, 1024, WSP(bf16, WS_WGLU), (r / 4) * 128, nullptr, scr, r % 4, r / 4, F.lane, F.wave);
    }
    { f32x4 va[8], vb[8]; int m = gw;
      if (m < M) p0_row_load(F.in[IN_X] + (size_t)m * DM, va, F.lane);
      while (m < M) {
          { const int mn = m + NGW; if (mn < M) p0_row_load(F.in[IN_X] + (size_t)mn * DM, vb, F.lane);
            p0_row_finish(va, WSP(bf16, WS_XB) + (size_t)m * DM, SMP(float, SM_R1) + m, F.lane, OUTP(unsigned, OUT_XB8) + (size_t)m * (DM / 4)); m = mn; }
          if (m >= M) break;
          { const int mn = m + NGW; if (mn < M) p0_row_load(F.in[IN_X] + (size_t)mn * DM, va, F.lane);
            p0_row_finish(vb, WSP(bf16, WS_XB) + (size_t)m * DM, SMP(float, SM_R1) + m, F.lane, OUTP(unsigned, OUT_XB8) + (size_t)m * (DM / 4)); m = mn; } } }
    if (gw < 16) p0_row(F.in[IN_META] + (size_t)gw * DM, SMP(bf16, SM_XBM) + (size_t)gw * DM, SMP(float, SM_R1M) + gw, F.lane);
}

typedef float f32x4 __attribute__((ext_vector_type(4)));
__device__ __forceinline__ v4u pack8(f32x4 v0, f32x4 v1) { v4u w; w.x = cvtpk(v0[0], v0[1]); w.y = cvtpk(v0[2], v0[3]); w.z = cvtpk(v1[0], v1[1]); w.w = cvtpk(v1[2], v1[3]); return w; }
__device__ __forceinline__ void unpack8(v4u w, f32x4& v0, f32x4& v1) {
    v0[0] = __builtin_bit_cast(float, w.x << 16); v0[1] = __builtin_bit_cast(float, w.x & 0xffff0000u); v0[2] = __builtin_bit_cast(float, w.y << 16); v0[3] = __builtin_bit_cast(float, w.y & 0xffff0000u);
    v1[0] = __builtin_bit_cast(float, w.z << 16); v1[1] = __builtin_bit_cast(float, w.z & 0xffff0000u); v1[2] = __builtin_bit_cast(float, w.w << 16); v1[3] = __builtin_bit_cast(float, w.w & 0xffff0000u); }
__device__ __forceinline__ unsigned q8(f32x4 v) { const unsigned a = (unsigned)(sigmoidf_(v[0]) * 255.f + 0.5f), b = (unsigned)(sigmoidf_(v[1]) * 255.f + 0.5f), c = (unsigned)(sigmoidf_(v[2]) * 255.f + 0.5f), d = (unsigned)(sigmoidf_(v[3]) * 255.f + 0.5f);
    return a | (b << 8) | (c << 16) | (d << 24); }
__device__ __forceinline__ unsigned q8n(f32x4 a, float ns) { unsigned q[4];
#pragma unroll
    for (int i = 0; i < 4; ++i) q[i] = (unsigned)__builtin_fmaf(__builtin_amdgcn_rcpf(1.0f + __builtin_amdgcn_exp2f(a[i] * ns)), 255.f, 0.5f);
    return q[0] | (q[1] << 8) | (q[2] << 16) | (q[3] << 24); }
__device__ __forceinline__ f32x4 uq8(unsigned w) { f32x4 o; o[0] = (float)(w & 0xffu); o[1] = (float)((w >> 8) & 0xffu); o[2] = (float)((w >> 16) & 0xffu); o[3] = (float)(w >> 24); return o; }
__device__ __forceinline__ f32x4 sig4(f32x4 v) { f32x4 o; o[0] = sigmoidf_(v[0]); o[1] = sigmoidf_(v[1]); o[2] = sigmoidf_(v[2]); o[3] = sigmoidf_(v[3]); return o; }

struct EpiG1 {
    static constexpr bool PERM = true, AFTER_DRAIN = false, APERM = false;
    const float* r1; bf16 *Q, *K, *U; unsigned char *SGNA, *SGSSM; int pn0;
    __device__ __forceinline__ void operator()(const f32x4 (&acc)[2][2][4][2], const pg8::Unit& u0, int wr, int wc, int fr, int fq) const {
        const pg8::Unit u{u0.pm, u0.pn + pn0};
        const int seg = u.pn < 4 ? 0 : (u.pn < 8 ? 1 : (u.pn < 12 ? 2 : (u.pn < 20 ? 3 : 4)));
        float rsv[2][4];
#pragma unroll
        for (int ai = 0; ai < 2; ++ai)
#pragma unroll
            for (int m = 0; m < 4; ++m) rsv[ai][m] = r1[u.pm * 256 + ai * 128 + wr * 64 + m * 16 + fr];
#pragma unroll
        for (int ai = 0; ai < 2; ++ai)
#pragma unroll
            for (int m = 0; m < 4; ++m) { const int row = u.pm * 256 + ai * 128 + wr * 64 + m * 16 + fr; const float rs = rsv[ai][m]; unsigned gq[4];
#pragma unroll
                for (int bj = 0; bj < 2; ++bj) { const int c0 = u.pn * 256 + bj * 128 + wc * 32 + 8 * fq; f32x4 v0 = acc[ai][bj][m][0] * rs, v1 = acc[ai][bj][m][1] * rs;
                    if (seg == 0) { v0 = v0 * 0.125f; v1 = v1 * 0.125f; *(v4u*)(Q + (size_t)row * 1024 + c0) = pack8(v0, v1); }
                    else if (seg == 1) { const int c = c0 - 1024, hh = c >> 6, d0 = c & 63, bb = row >> 12, tt = row & 4095;
                        *(v4u*)(K + ((((((size_t)(bb * 16 + hh) * 64 + (tt >> 6)) * 8 + ((tt & 63) >> 3)) * 2 + (d0 >> 5)) * 4 + ((d0 >> 3) & 3)) * 8 + (tt & 7)) * 8) = pack8(v0, v1); }
                    else if (seg == 2) { const int cu = c0 - 2048, g = cu >> 4, b = row >> 12, t = row & 4095; *(v4u*)(U + ((size_t)(b * 64 + g) * LPOS + 16 + t) * 16 + (cu & 15)) = pack8(v0, v1); }
                    else { gq[2 * bj] = q8(v0); gq[2 * bj + 1] = q8(v1); } }
                if (seg >= 3) { v4u w; w.x = gq[0]; w.y = gq[1]; w.z = gq[2]; w.w = gq[3]; *(v4u*)((seg == 3 ? SGNA + (u.pn - 12) * 256 : SGSSM + (u.pn - 20) * 256) + (size_t)row * 2048 + 64 * wc + 16 * fq) = w; } }
    }
};
struct EpiQKG {
    static constexpr bool PERM = true, AFTER_DRAIN = false, APERM = false;
    const float* r1; bf16 *Q, *K; unsigned char *SGNA, *SGSSM;
    __device__ __forceinline__ void operator()(const f32x4 (&acc)[2][2][4][2], const pg8::Unit& u, int wr, int wc, int fr, int fq) const {
        float rsv[2][4];
#pragma unroll
        for (int ai = 0; ai < 2; ++ai)
#pragma unroll
            for (int m = 0; m < 4; ++m) rsv[ai][m] = r1[u.pm * 256 + ai * 128 + wr * 64 + m * 16 + fr];
        if (u.pn >= 8) {
            unsigned char* dst = (u.pn < 16 ? SGNA + (u.pn - 8) * 256 : SGSSM + (u.pn - 16) * 256) + 64 * wc + 16 * fq;
#pragma unroll
            for (int ai = 0; ai < 2; ++ai)
#pragma unroll
                for (int m = 0; m < 4; ++m) { const int row = u.pm * 256 + ai * 128 + wr * 64 + m * 16 + fr; const float ns = rsv[ai][m] * (-1.4426950408889634f / 64.f);
                    v4u w; w.x = q8n(acc[ai][0][m][0], ns); w.y = q8n(acc[ai][0][m][1], ns); w.z = q8n(acc[ai][1][m][0], ns); w.w = q8n(acc[ai][1][m][1], ns);
                    *(v4u*)(dst + (size_t)row * 2048) = w; }
        } else {
#pragma unroll
            for (int ai = 0; ai < 2; ++ai)
#pragma unroll
                for (int m = 0; m < 4; ++m) { const int row = u.pm * 256 + ai * 128 + wr * 64 + m * 16 + fr; const float rs = rsv[ai][m] * (1.0f / 64.f);
#pragma unroll
                    for (int bj = 0; bj < 2; ++bj) { const int c0 = u.pn * 256 + bj * 128 + wc * 32 + 8 * fq;
                        if (u.pn < 4) { const float qs = rs * 0.125f; *(v4u*)(Q + (size_t)row * 1024 + c0) = pack8(acc[ai][bj][m][0] * qs, acc[ai][bj][m][1] * qs); }
                        else { const int c = c0 - 1024, hh = c >> 6, d0 = c & 63, bb = row >> 12, tt = row & 4095;
                            *(v4u*)(K + ((((((size_t)(bb * 16 + hh) * 64 + (tt >> 6)) * 8 + ((tt & 63) >> 3)) * 2 + (d0 >> 5)) * 4 + ((d0 >> 3) & 3)) * 8 + (tt & 7)) * 8) = pack8(acc[ai][bj][m][0] * rs, acc[ai][bj][m][1] * rs); } } }
        }
    }
};
struct EpiGate {
    static constexpr bool PERM = true, AFTER_DRAIN = false, APERM = false;
    const float* r1; unsigned char *SGNA, *SGSSM;
    __device__ __forceinline__ void operator()(const f32x4 (&acc)[2][2][4][2], const pg8::Unit& u, int wr, int wc, int fr, int fq) const {
        float rsv[2][4];
#pragma unroll
        for (int ai = 0; ai < 2; ++ai)
#pragma unroll
            for (int m = 0; m < 4; ++m) rsv[ai][m] = r1[u.pm * 256 + ai * 128 + wr * 64 + m * 16 + fr];
        unsigned char* dst = (u.pn < 8 ? SGNA + u.pn * 256 : SGSSM + (u.pn - 8) * 256) + 64 * wc + 16 * fq;
#pragma unroll
        for (int ai = 0; ai < 2; ++ai)
#pragma unroll
            for (int m = 0; m < 4; ++m) { const int row = u.pm * 256 + ai * 128 + wr * 64 + m * 16 + fr; const float ns = rsv[ai][m] * (-1.4426950408889634f / 64.f);
                v4u w; w.x = q8n(acc[ai][0][m][0], ns); w.y = q8n(acc[ai][0][m][1], ns); w.z = q8n(acc[ai][1][m][0], ns); w.w = q8n(acc[ai][1][m][1], ns);
                *(v4u*)(dst + (size_t)row * 2048) = w; }
    }
};
struct EpiVt {
    static constexpr bool PERM = true, AFTER_DRAIN = false, APERM = false;
    const float* r1; bf16* VT;
    __device__ __forceinline__ void operator()(const f32x4 (&acc)[2][2][4][2], const pg8::Unit& u, int wr, int wc, int fr, int fq) const {
#pragma unroll
        for (int bj = 0; bj < 2; ++bj) { const int c0 = u.pn * 256 + bj * 128 + wc * 32 + 8 * fq; const f32x4 s0 = *(const f32x4*)(r1 + c0) * (1.0f / 64.f), s1 = *(const f32x4*)(r1 + c0 + 4) * (1.0f / 64.f);
#pragma unroll
            for (int ai = 0; ai < 2; ++ai)
#pragma unroll
                for (int m = 0; m < 4; ++m) { const int row = u.pm * 256 + ai * 128 + wr * 64 + m * 16 + fr, bb = c0 >> 12, tt = c0 & 4095;
                    *(v4u*)(VT + (((((size_t)(bb * 16 + (row >> 6)) * 64 + (tt >> 6)) * 4 + ((row >> 2) & 3)) * 8 + ((tt & 63) >> 3)) * 16 + (((row >> 4) & 3) * 4 + (row & 3))) * 8) = pack8(acc[ai][bj][m][0] * s0, acc[ai][bj][m][1] * s1); } }
    }
};
struct EpiGlu {
    static constexpr bool PERM = true, AFTER_DRAIN = false, APERM = false;
    const bf16* YG; bf16* S;
    __device__ __forceinline__ void operator()(const f32x4 (&acc)[2][2][4][2], const pg8::Unit& u, int wr, int wc, int fr, int fq) const {
#pragma unroll
        for (int ai = 0; ai < 2; ++ai)
#pragma unroll
            for (int m = 0; m < 4; ++m) { const int row = u.pm * 256 + ai * 128 + wr * 64 + m * 16 + fr;
#pragma unroll
                for (int bj = 0; bj < 2; ++bj) { const int c0 = u.pn * 256 + bj * 128 + wc * 32 + 8 * fq; f32x4 y0, y1; unpack8(*(const v4u*)(YG + (size_t)row * 1024 + c0), y0, y1);
                    *(v4u*)(S + (size_t)row * 1024 + c0) = pack8(y0 * sig4(acc[ai][bj][m][0]), y1 * sig4(acc[ai][bj][m][1])); } }
    }
};
template <bool ADD> struct EpiMix {
    static constexpr bool PERM = true, AFTER_DRAIN = false, APERM = false;
    const unsigned char* GATE; bf16* MIX; float asc;
    __device__ __forceinline__ void operator()(const f32x4 (&acc)[2][2][4][2], const pg8::Unit& u, int wr, int wc, int fr, int fq) const {
#pragma unroll
        for (int ai = 0; ai < 2; ++ai)
#pragma unroll
            for (int m = 0; m < 4; ++m) { const int row = u.pm * 256 + ai * 128 + wr * 64 + m * 16 + fr;
                const v4u gw = *(const v4u*)(GATE + (size_t)row * 2048 + u.pn * 256 + 64 * wc + 16 * fq);
#pragma unroll
                for (int bj = 0; bj < 2; ++bj) { const int c0 = u.pn * 256 + bj * 128 + wc * 32 + 8 * fq;
                    f32x4 v0 = uq8(bj ? gw.z : gw.x) * (acc[ai][bj][m][0] * asc), v1 = uq8(bj ? gw.w : gw.y) * (acc[ai][bj][m][1] * asc);
                    if (ADD) { f32x4 p0, p1; unpack8(*(const v4u*)(MIX + (size_t)row * 2048 + c0), p0, p1); v0 = v0 + p0; v1 = v1 + p1; }
                    *(v4u*)(MIX + (size_t)row * 2048 + c0) = pack8(v0, v1); } }
    }
};

template <bool H2> struct EpiRes {
    static constexpr bool PERM = true, AFTER_DRAIN = false, APERM = false;
    const bf16* baseb; bf16* outb; float* rowsq;
    __device__ __forceinline__ void operator()(const f32x4 (&acc)[2][2][4][2], const pg8::Unit& u, int wr, int wc, int fr, int fq) const {
#pragma unroll
        for (int ai = 0; ai < 2; ++ai)
#pragma unroll
            for (int m = 0; m < 4; ++m) { const int row = u.pm * 256 + ai * 128 + wr * 64 + m * 16 + fr; float ss = 0.f;
#pragma unroll
                for (int bj = 0; bj < 2; ++bj) { const size_t off = (size_t)row * 2048 + u.pn * 256 + bj * 128 + wc * 32 + 8 * fq;
                    f32x4 v0, v1; unpack8(*(const v4u*)(baseb + off), v0, v1);
                    v0 = v0 + acc[ai][bj][m][0]; v1 = v1 + acc[ai][bj][m][1];
                    *(v4u*)(outb + off) = pack8(v0, v1);
                    ss += (v0[0] * v0[0] + v0[1] * v0[1]) + (v0[2] * v0[2] + v0[3] * v0[3]) + (v1[0] * v1[0] + v1[1] * v1[1]) + (v1[2] * v1[2] + v1[3] * v1[3]); }
                ss += __shfl_xor(ss, 16); ss += __shfl_xor(ss, 32);
                if (fq == 0) atomicAdd(rowsq + row, ss); }
    }
};
__device__ __forceinline__ size_t act_off(int row, int col) { return ((size_t)(col >> 6) * M + row) * 64 + (col & 63); }
struct EpiUp {
    static constexpr bool PERM = true, AFTER_DRAIN = false, APERM = true;
    const float* rowsq; const float* convw; const float* convb; bf16* ACT; float *EA, *EP, *EG; LAS unsigned char* ex;
    __device__ __forceinline__ void operator()(const f32x4 (&acc)[2][2][4][2], const pg8::Unit& u, int wr, int wc, int fr, int fq) const {
        const int ja0 = u.pn * 128 + wc * 32 + 8 * fq;
        LAS f32x4* EX = (LAS f32x4*)ex;
        float r2[2][4];
#pragma unroll
        for (int ai = 0; ai < 2; ++ai) { const f32x4 rq = *(const f32x4*)(rowsq + u.pm * 256 + ai * 128 + wr * 64 + 4 * fr);
#pragma unroll
            for (int m = 0; m < 4; ++m) r2[ai][m] = __builtin_amdgcn_rsqf(rq[m] * (1.0f / DM) + EPS); }
#pragma unroll
        for (int ai = 0; ai < 2; ++ai)
#pragma unroll
            for (int n = 0; n < 2; ++n) { const int e = (((2 * ai + wr) * 2) * 4 + wc) * 8 + fq * 2 + n;
                if (fr == 0) EX[e] = acc[ai][0][0][n] * r2[ai][0];
                if (fr == 15) EX[e + 32] = acc[ai][0][3][n] * r2[ai][3]; }
        __syncthreads();
#pragma unroll
        for (int ai = 0; ai < 2; ++ai) {
            const int row0 = u.pm * 256 + ai * 128 + wr * 64 + 4 * fr, blk = 2 * ai + wr;
            const bool has_up = blk > 0, has_dn = blk < 3;
            v2u wq[2][4];
#pragma unroll
            for (int n = 0; n < 2; ++n) {
                const int ja = ja0 + 4 * n;
                const f32x4 w0 = *(const f32x4*)(convw + ja), w1 = *(const f32x4*)(convw + DFF + ja), w2 = *(const f32x4*)(convw + 2 * DFF + ja), cb = *(const f32x4*)(convb + ja);
                f32x4 upn = {0.f, 0.f, 0.f, 0.f}, dnn = {0.f, 0.f, 0.f, 0.f};
                if (has_up) upn = EX[((((blk - 1) * 2 + 1) * 4 + wc) * 8) + fq * 2 + n];
                if (has_dn) dnn = EX[((((blk + 1) * 2) * 4 + wc) * 8) + fq * 2 + n];
                f32x4 av[4], gv[4], cv[4];
#pragma unroll
                for (int m = 0; m < 4; ++m) { av[m] = acc[ai][0][m][n] * r2[ai][m]; gv[m] = acc[ai][1][m][n] * r2[ai][m]; }
#pragma unroll
                for (int i = 0; i < 4; ++i) {
                    float up0 = dpp0<0x111>(av[3][i]), dn3 = dpp0<0x101>(av[0][i]);
                    if (fr == 0) up0 = upn[i];
                    if (fr == 15) dn3 = dnn[i];
                    cv[0][i] = __builtin_fmaf(w2[i], av[1][i], __builtin_fmaf(w0[i], up0, __builtin_fmaf(w1[i], av[0][i], cb[i])));
                    cv[1][i] = __builtin_fmaf(w2[i], av[2][i], __builtin_fmaf(w0[i], av[0][i], __builtin_fmaf(w1[i], av[1][i], cb[i])));
                    cv[2][i] = __builtin_fmaf(w2[i], av[3][i], __builtin_fmaf(w0[i], av[1][i], __builtin_fmaf(w1[i], av[2][i], cb[i])));
                    cv[3][i] = __builtin_fmaf(w2[i], dn3, __builtin_fmaf(w0[i], av[2][i], __builtin_fmaf(w1[i], av[3][i], cb[i])));
                }
                if (!has_up && fr == 0) { const size_t eo = (size_t)(u.pm * 8) * DFF + ja; *(f32x4*)(EA + eo) = av[0]; *(f32x4*)(EP + eo) = cv[0]; *(f32x4*)(EG + eo) = gv[0]; }
                if (!has_dn && fr == 15) { const size_t eo = (size_t)(u.pm * 8 + 7) * DFF + ja; *(f32x4*)(EA + eo) = av[3]; *(f32x4*)(EP + eo) = cv[3]; *(f32x4*)(EG + eo) = gv[3]; }
#pragma unroll
                for (int m = 0; m < 4; ++m) { wq[n][m].x = cvtpk(gelu_tanh(cv[m][0]) * gv[m][0], gelu_tanh(cv[m][1]) * gv[m][1]); wq[n][m].y = cvtpk(gelu_tanh(cv[m][2]) * gv[m][2], gelu_tanh(cv[m][3]) * gv[m][3]); }
            }
#pragma unroll
            for (int m = 0; m < 4; ++m) { const bool edge = (m == 0 && fr == 0 && !has_up) || (m == 3 && fr == 15 && !has_dn);
                if (!edge) { v4u w; w.x = wq[0][m].x; w.y = wq[0][m].y; w.z = wq[1][m].x; w.w = wq[1][m].y; *(v4u*)(ACT + act_off(row0 + m, ja0)) = w; } }
        }
    }
};


__device__ __forceinline__ void p1_meta(Frame& F) {
    const int lane = F.lane, lr = lane & 15, lg = lane >> 4;
    for (int cb0 = F.vcu; cb0 < 256; cb0 += F.G) {
        const int cb = cb0 + 256 * (F.wave >> 2), c16 = 16 * cb; const bool isu = c16 >= 2048 && c16 < 3072;
        const void* bt = isu ? (const void*)(WSP(bf16, WS_WIN) + (size_t)c16 * DM)
                             : (const void*)(c16 >= 7168 ? OUTP(unsigned char, OUT_WV8) + (size_t)(c16 - 7168) * DM : OUTP(unsigned char, OUT_W8) + (size_t)(c16 < 2048 ? c16 : c16 - 1024) * DM);
        const f32x4 r1m4 = *(const f32x4*)(SMP(float, SM_R1M) + 4 * lg);
        const f32x4 acc = meta_nt16_pair<DM>(F, SMP(bf16, SM_XBM), DM, bt, DM, !isu);
        if ((F.wave & 3) != 0) continue;
        const int col = 16 * cb + lr; const float wsc = isu ? 1.0f : (1.0f / 64.f);
#pragma unroll
        for (int r = 0; r < 4; ++r) { const int j = 4 * lg + r; const float v = acc[r] * (r1m4[r] * wsc);
            if (col < 1024) { if (j == 15) SMP(float, SM_Q15)[col] = v * 0.125f; }
            else if (col < 2048) SMP(bf16, SM_KM)[j * 1024 + (col - 1024)] = (bf16)f2bf(v);
            else if (col < 3072) { const int cu = col - 2048, g = cu >> 4; const bf16 h = (bf16)f2bf(v);
#pragma unroll
                for (int b = 0; b < NB; ++b) WSP(bf16, WS_U)[((size_t)(b * 64 + g) * LPOS + j) * 16 + (cu & 15)] = h; }
            else if (col < 5120) { if (j == 15) SMP(float, SM_SGNA15)[col - 3072] = sigmoidf_(v); }
            else if (col < 7168) { if (j == 15) SMP(float, SM_SGSSM15)[col - 5120] = sigmoidf_(v); }
            else { bf16* vm = SMP(bf16, SM_VMT) + (size_t)(col - 7168) * 32; vm[j] = (bf16)f2bf(v); vm[16 + j] = 0; } }
    }
}
__device__ __forceinline__ void p2_meta_attn(Frame& F, int h) {
    const int lane = F.lane, j = lane & 15, part = lane >> 4;
    const f32x4* q4 = (const f32x4*)(SMP(float, SM_Q15) + h * 64 + 16 * part); const v4u* k4 = (const v4u*)(SMP(bf16, SM_KM) + j * 1024 + h * 64 + 16 * part);
    const f32x4 qa = q4[0], qb = q4[1], qc = q4[2], qd = q4[3]; const v4u ka = k4[0], kb = k4[1];
    f32x4 k0, k1, k2, k3; unpack8(ka, k0, k1); unpack8(kb, k2, k3);
    const f32x4 pr = qa * k0 + qb * k1 + qc * k2 + qd * k3;
    float s = (pr[0] + pr[1]) + (pr[2] + pr[3]);
    s += __shfl_xor(s, 16); s += __shfl_xor(s, 32);
    float mx = s;
#pragma unroll
    for (int o = 1; o < 16; o <<= 1) mx = fmaxf(mx, __shfl_xor(mx, o));
    float p = __expf(s - mx), sum = p;
#pragma unroll
    for (int o = 1; o < 16; o <<= 1) sum += __shfl_xor(sum, o);
    p = p / sum;
    const v4u* v4 = (const v4u*)(SMP(bf16, SM_VMT) + (size_t)(h * 64 + lane) * 32); const v4u va = v4[0], vb = v4[1];
    f32x4 v0, v1, v2, v3; unpack8(va, v0, v1); unpack8(vb, v2, v3);
    float o = 0.f;
#pragma unroll
    for (int k = 0; k < 4; ++k) { o += __shfl(p, k) * v0[k] + __shfl(p, 4 + k) * v1[k] + __shfl(p, 8 + k) * v2[k] + __shfl(p, 12 + k) * v3[k]; }
    const bf16 ob = (bf16)f2bf(o);
#pragma unroll
    for (int b = 0; b < NB; ++b) SMP(bf16, SM_AO15)[b * 1024 + h * 64 + lane] = ob;
}
__device__ __forceinline__ void p3a_meta(Frame& F) {
    const int lane = F.lane, lr = lane & 15, lg = lane >> 4;
    for (int cb = F.vcu; cb < 64; cb += F.G) {
        float y4[4];
#pragma unroll
        for (int r = 0; r < 4; ++r) y4[r] = bf2f(SMP(bf16, SM_AYG15)[(4 * lg + r) * 1024 + 16 * cb + lr]);
        const f32x4 acc = meta_nt16<1024>(F, SMP(bf16, SM_AYG15), 1024, WSP(bf16, WS_WGLU) + (size_t)(16 * cb) * 1024, 1024);
        if (F.wave != 0) continue;
#pragma unroll
        for (int r = 0; r < 4; ++r) { const int i = 4 * lg + r, col = 16 * cb + lr; SMP(bf16, SM_AS15)[i * 1024 + col] = (bf16)f2bf(y4[r] * sigmoidf_(acc[r])); }
    }
}
__device__ __forceinline__ void p3b_meta(Frame& F) {
    const int lane = F.lane, lr = lane & 15, lg = lane >> 4;
    for (int cb = F.vcu; cb < 128; cb += F.G) {
        const float gn = SMP(float, SM_SGNA15)[16 * cb + lr], gs = SMP(float, SM_SGSSM15)[16 * cb + lr];
        f32x4 a2 = {0.f, 0.f, 0.f, 0.f};
        const bool hi = (F.wave >> 2) != 0;
        f32x4 a1 = meta_nt16_pair<1024>(F, hi ? SMP(bf16, SM_AS15) : SMP(bf16, SM_AO15), 1024, hi ? (const void*)(WSP(bf16, WS_WSSM) + (size_t)(16 * cb) * 1024) : (const void*)(OUTP(unsigned char, OUT_WNA8) + (size_t)(16 * cb) * 1024), 1024, !hi, &a2);
        if (F.wave != 0) continue;
        a1 = a1 * (1.0f / 64.f);
        const int col = 16 * cb + lr;
#pragma unroll
        for (int r = 0; r < 4; ++r) { const int i = 4 * lg + r; SMP(bf16, SM_AMIX15)[i * 2048 + col] = (bf16)f2bf(gn * a1[r] + gs * a2[r]); }
    }
}
__device__ __forceinline__ void p3c_meta(Frame& F) {
    const int lane = F.lane, lr = lane & 15, lg = lane >> 4;
    for (int cb = F.vcu; cb < 128; cb += F.G) {
        const float mt = F.in[IN_META][15 * DM + 16 * cb + lr];
        const f32x4 acc = meta_nt16<2048>(F, SMP(bf16, SM_AMIX15), 2048, WSP(bf16, WS_WOUT) + (size_t)(16 * cb) * 2048, 2048);
        if (F.wave != 0) continue;
        const int col = 16 * cb + lr;
#pragma unroll
        for (int r = 0; r < 4; ++r) { const int i = 4 * lg + r; const float v = mt + acc[r]; SMP(bf16, SM_AH2B15)[i * 2048 + col] = (bf16)f2bf(v);
            float ss = v * v;
#pragma unroll
            for (int o = 1; o < 16; o <<= 1) ss += __shfl_xor(ss, o);
            if (lr == 0 && i < NB) atomicAdd((float*)(F.ws + WS_CTL + CTL_ROWSQM) + i, ss); }
    }
}
__device__ __forceinline__ void p4_meta(Frame& F) {
    const int lane = F.lane, lr = lane & 15, lg = lane >> 4;
    for (int cb0 = F.vcu; cb0 < DFF / 32; cb0 += F.G) {
        const int cb = cb0 + (DFF / 32) * (F.wave >> 2), j0 = 16 * cb, wrow = 256 * (j0 >> 7) + (j0 & 127);
        const f32x4 rq = *(const f32x4*)(F.ws + WS_CTL + CTL_ROWSQM);
        const f32x4 acc = meta_nt16_pair<2048>(F, SMP(bf16, SM_AH2B15), 2048, WSP(bf16, WS_WUP) + (size_t)wrow * 2048, 2048, false);
        if ((F.wave & 3) != 0) continue;
        if (lg == 0) {
#pragma unroll
            for (int r = 0; r < 4; ++r) { const float r2 = 1.0f / sqrtf(rq[r] * (1.0f / DM) + EPS); SMP(float, SM_A15)[r * DFF + j0 + lr] = acc[r] * r2; } }
    }
}

constexpr int NA_K_OFF = 8 * 9216, NA_RPB_OFF = NA_K_OFF + 9 * 8192;
__device__ __forceinline__ void na_prefetch(Frame& F, int gi, v4u (&k)[9], float (&bs)[2]) {
    const int r0 = (2 * gi) & 63, h = (gi >> 5) & 15, b = gi >> 9, rs0 = min(max(r0 - 4, 0), 56);
    const unsigned char* src = (const unsigned char*)(WSP(bf16, WS_K) + (size_t)((b * 16 + h) * 64 + rs0) * 4096) + F.tid * 16;
#pragma unroll
    for (int i = 0; i < 9; ++i) k[i] = *(const v4u*)(src + i * 8192);
#pragma unroll
    for (int q = 0; q < 2; ++q) { const int e = F.tid + 512 * q, x = (e & 63) - 16; bs[q] = (e < 960 && x >= 0 && x < 31) ? F.in[IN_RPB][(h * 15 + (e >> 6)) * 31 + x] : 0.f; }
}
__device__ __forceinline__ void na_commit(Frame& F, const v4u (&k)[9], const float (&bs)[2]) {
#pragma unroll
    for (int i = 0; i < 9; ++i) *(LAS v4u*)(F.lds + NA_K_OFF + i * 8192 + F.tid * 16) = k[i];
#pragma unroll
    for (int q = 0; q < 2; ++q) { const int e = F.tid + 512 * q; if (e < 960) ((LAS float*)(F.lds + NA_RPB_OFF))[e] = bs[q]; }
}
__device__ __forceinline__ void na_qload(Frame& F, int gi, bf16x8 (&qf)[2]) {
    const int qb = F.wave & 3, r = ((2 * gi) & 63) + (F.wave >> 2), h = (gi >> 5) & 15, b = gi >> 9;
    const bf16* Qp = WSP(bf16, WS_Q) + ((size_t)(b * SEQ + r * 64 + 16 * qb) * 1024 + h * 64);
    qf[0] = ldfrag(Qp, 1024, F.lane); qf[1] = ldfrag(Qp + 32, 1024, F.lane);
}
__device__ __forceinline__ void na_task(Frame& F, int gi, LAS bf16* P  , const v4u (&kpre)[9], const float (&bpre)[2], bf16x8 (&qf)[2], bool has_next) {
    const int qb = F.wave & 3, r0 = (2 * gi) & 63, r = r0 + (F.wave >> 2), h = (gi >> 5) & 15, b = gi >> 9;
    const int lane = F.lane, lr = lane & 15, lg = lane >> 4;
    const int w0 = (qb == 0) ? 0 : (qb == 1) ? 8 : (qb == 2) ? 24 : 32;
    const int rs = min(max(r - 4, 0), 56), rs0 = min(max(r0 - 4, 0), 56);
    const int cq = 16 * qb + lr, cs = min(max(cq - 8, 0), 48);
    const bf16x8 qf0 = qf[0], qf1 = qf[1];
    const LAS float* rpb = (const LAS float*)(F.lds + NA_RPB_OFF) + (rs - r + 7) * 64 + 16 + (w0 + 4 * lg - cq + 15);
    bool vld[2][4];
#pragma unroll
    for (int hf = 0; hf < 2; ++hf)
#pragma unroll
        for (int i = 0; i < 4; ++i) vld[hf][i] = (unsigned)(w0 + 16 * hf + 4 * lg + i - cs) < 16u;
    const LAS unsigned char* Kb = F.lds + NA_K_OFF + (rs - rs0) * 8192 + ((w0 >> 3) + (lr >> 3)) * 1024 + lg * 128 + (lr & 7) * 16;
    const bf16* Km = SMP(bf16, SM_KM) + lr * 1024 + h * 64 + 8 * lg;
    const bf16* Vb = WSP(bf16, WS_VT) + ((size_t)((b * 16 + h) * 64 + rs) * 4096 + ((w0 >> 3) + lg) * 128 + lr * 8);
    const bf16* Vm = SMP(bf16, SM_VMT) + (size_t)(h * 64 + 16 * (lr >> 2) + (lr & 3)) * 32 + 8 * lg;
#define NA_KLD(t, ks) (*(const LAS bf16x8*)(Kb + (((t) >> 1) * 8192 + ((t) & 1) * 2048 + (ks) * 512)))
#define NA_SB() __builtin_amdgcn_sched_barrier(0)
    f32x4 s[17];
    float bq[4][4];
#define NA_BIAS4(t0) do { _Pragma("unroll") for (int tt = 0; tt < 4; ++tt) _Pragma("unroll") for (int i = 0; i < 4; ++i) bq[tt][i] = rpb[(((t0) + tt) >> 1) * 64 + 16 * (((t0) + tt) & 1) + i]; \
        asm volatile("" : "+v"(bq[0][0]), "+v"(bq[0][1]), "+v"(bq[0][2]), "+v"(bq[0][3]), "+v"(bq[1][0]), "+v"(bq[1][1]), "+v"(bq[1][2]), "+v"(bq[1][3]), \
                          "+v"(bq[2][0]), "+v"(bq[2][1]), "+v"(bq[2][2]), "+v"(bq[2][3]), "+v"(bq[3][0]), "+v"(bq[3][1]), "+v"(bq[3][2]), "+v"(bq[3][3])); } while (0)
#define NA_TILE(t, f0, f1) do { f32x4 a_ = {0.f, 0.f, 0.f, 0.f}; a_ = MFMA16((f0), qf0, a_); a_ = MFMA16((f1), qf1, a_); \
        s[t][0] = vld[(t) & 1][0] ? a_[0] + bq[(t) & 3][0] : -INFINITY; s[t][1] = vld[(t) & 1][1] ? a_[1] + bq[(t) & 3][1] : -INFINITY; \
        s[t][2] = vld[(t) & 1][2] ? a_[2] + bq[(t) & 3][2] : -INFINITY; s[t][3] = vld[(t) & 1][3] ? a_[3] + bq[(t) & 3][3] : -INFINITY; } while (0)
    bf16x8 ka[8], kb[8]; const bf16x8 km0 = *(const bf16x8*)Km, km1 = *(const bf16x8*)(Km + 32);
#pragma unroll
    for (int t = 0; t < 4; ++t) { ka[2 * t] = NA_KLD(t, 0); ka[2 * t + 1] = NA_KLD(t, 1); }
#pragma unroll
    for (int t = 0; t < 4; ++t) { kb[2 * t] = NA_KLD(t + 4, 0); kb[2 * t + 1] = NA_KLD(t + 4, 1); }
    NA_SB();
#pragma unroll
    for (int t = 0; t < 4; ++t) { if (t == 0) NA_BIAS4(0); NA_TILE(t, ka[2 * t], ka[2 * t + 1]); }
    NA_SB();
#pragma unroll
    for (int t = 0; t < 4; ++t) { ka[2 * t] = NA_KLD(t + 8, 0); ka[2 * t + 1] = NA_KLD(t + 8, 1); }
    NA_SB();
#pragma unroll
    for (int t = 0; t < 4; ++t) { if (t == 0) NA_BIAS4(4); NA_TILE(t + 4, kb[2 * t], kb[2 * t + 1]); }
    NA_SB();
#pragma unroll
    for (int t = 0; t < 4; ++t) { kb[2 * t] = NA_KLD(t + 12, 0); kb[2 * t + 1] = NA_KLD(t + 12, 1); }
    NA_SB();
#pragma unroll
    for (int t = 0; t < 4; ++t) { if (t == 0) NA_BIAS4(8); NA_TILE(t + 8, ka[2 * t], ka[2 * t + 1]); }
    NA_SB();
#pragma unroll
    for (int t = 0; t < 4; ++t) { if (t == 0) NA_BIAS4(12); NA_TILE(t + 12, kb[2 * t], kb[2 * t + 1]); }
    { f32x4 a_ = {0.f, 0.f, 0.f, 0.f}; a_ = MFMA16(km0, qf0, a_); a_ = MFMA16(km1, qf1, a_); s[16] = a_; }
    LDS_WAIT(); __syncthreads();
    if (has_next) { na_commit(F, kpre, bpre); na_qload(F, gi + F.G, qf); }
    NA_SB();
    bf16x8 va[9], vb[9];
#pragma unroll
    for (int s8 = 0; s8 < 8; ++s8) { va[s8] = *(const bf16x8*)(Vb + s8 * 4096); vb[s8] = *(const bf16x8*)(Vb + 1024 + s8 * 4096); }
    va[8] = *(const bf16x8*)Vm; vb[8] = *(const bf16x8*)(Vm + 4 * 32);
    NA_SB();
    float mx = -INFINITY;
#pragma unroll
    for (int t = 0; t < 17; ++t) mx = fmaxf(mx, fmaxf(fmaxf(s[t][0], s[t][1]), fmaxf(s[t][2], s[t][3])));
    mx = fmaxf(mx, __shfl_xor(mx, 16)); mx = fmaxf(mx, __shfl_xor(mx, 32));
    float sum = 0.f;
#pragma unroll
    for (int t = 0; t < 17; ++t) {
#pragma unroll
        for (int i = 0; i < 4; ++i) { const float p = __expf(s[t][i] - mx); s[t][i] = p; sum += p; } }
    sum += __shfl_xor(sum, 16); sum += __shfl_xor(sum, 32);
    const float inv = 1.0f / sum;
#pragma unroll
    for (int t = 0; t < 17; ++t) { v2u w; w.x = cvtpk(s[t][0] * inv, s[t][1] * inv); w.y = cvtpk(s[t][2] * inv, s[t][3] * inv);
        *(LAS v2u*)(P + lr * 288 + t * 16 + 4 * lg) = w; }
    { v2u z; z.x = 0u; z.y = 0u; *(LAS v2u*)(P + lr * 288 + 272 + 4 * lg) = z; }
    NA_SB();
    bf16x8 vc[9];
#pragma unroll
    for (int s8 = 0; s8 < 8; ++s8) vc[s8] = *(const bf16x8*)(Vb + 2048 + s8 * 4096);
    vc[8] = *(const bf16x8*)(Vm + 8 * 32);
    NA_SB();
    LDS_WAIT(); asm volatile("" ::: "memory");
    unsigned char* Op = WSP(unsigned char, WS_O) + ((size_t)(b * SEQ + r * 64 + 16 * qb + lr) * 1024 + h * 64) + 16 * lg;
    unsigned ow[4];
    bf16x8 pf[9];
#pragma unroll
    for (int s8 = 0; s8 < 9; ++s8) pf[s8] = ldfrag_lds(P + 32 * s8, 288, lane);
#define NA_PV(db, vf) do { f32x4 o_ = {0.f, 0.f, 0.f, 0.f}; _Pragma("unroll") for (int s8 = 0; s8 < 9; ++s8) o_ = MFMA16(vf[s8], pf[s8], o_); \
        ow[db] = pk4_fp8(o_[0] * 16.f, o_[1] * 16.f, o_[2] * 16.f, o_[3] * 16.f); } while (0)
    NA_SB();
    NA_PV(0, va);
    NA_SB();
#pragma unroll
    for (int s8 = 0; s8 < 8; ++s8) va[s8] = *(const bf16x8*)(Vb + 3072 + s8 * 4096);
    va[8] = *(const bf16x8*)(Vm + 12 * 32);
    NA_SB();
    NA_PV(1, vb);
    NA_SB();
    NA_PV(2, vc);
    NA_SB();
    NA_PV(3, va);
    { v4u w0; w0.x = ow[0]; w0.y = ow[1]; w0.z = ow[2]; w0.w = ow[3]; *(v4u*)Op = w0; }
    LDS_WAIT(); asm volatile("" ::: "memory");
#undef NA_KLD
#undef NA_TILE
#undef NA_BIAS4
#undef NA_PV
#undef NA_SB
}

typedef float f32x16 __attribute__((ext_vector_type(16)));
#define MFMA32(a, b, c) __builtin_amdgcn_mfma_f32_32x32x16_bf16((a), (b), (c), 0, 0, 0)
constexpr int S5_PP = 528;
constexpr int S5_A = 0, S5_B = 128 * S5_PP, S5_C = 2 * 128 * S5_PP, S5_TOT = S5_C + 8320, S5_M = S5_C + 17408;
constexpr int S5_L5 = S5_M, S5_X0 = S5_M + 5120, S5_XB0 = S5_X0 + 512, S5_U0 = S5_XB0 + 512;
static_assert(S5_U0 + 512 <= MISC_OFF, "S5 LDS map");
template <int BYTES> __device__ __forceinline__ void s5_copy(LAS unsigned char* dst, const unsigned char* src, int tid) {
    unsigned t16 = (unsigned)tid * 16u; asm volatile("" : "+v"(t16));
    constexpr int NIT = (BYTES + 8191) / 8192; v4u tmp[NIT];
#pragma unroll
    for (int i = 0; i < NIT; ++i) if (BYTES % 8192 == 0 || i < NIT - 1 || t16 + i * 8192u < (unsigned)BYTES) tmp[i] = *(const v4u*)(src + t16 + i * 8192u);
#pragma unroll
    for (int i = 0; i < NIT; ++i) if (BYTES % 8192 == 0 || i < NIT - 1 || t16 + i * 8192u < (unsigned)BYTES) *(LAS v4u*)(dst + t16 + i * 8192u) = tmp[i];
}
template <int BYTES> __device__ __forceinline__ void s5_ld(v4u (&tmp)[(BYTES + 8191) / 8192], const unsigned char* src, unsigned t16) {
    constexpr int NIT = (BYTES + 8191) / 8192;
#pragma unroll
    for (int i = 0; i < NIT; ++i) if (BYTES % 8192 == 0 || i < NIT - 1 || t16 + i * 8192u < (unsigned)BYTES) tmp[i] = *(const v4u*)(src + t16 + i * 8192u);
}
template <int BYTES> __device__ __forceinline__ void s5_st(LAS unsigned char* dst, const v4u (&tmp)[(BYTES + 8191) / 8192], unsigned t16) {
    constexpr int NIT = (BYTES + 8191) / 8192;
#pragma unroll
    for (int i = 0; i < NIT; ++i) if (BYTES % 8192 == 0 || i < NIT - 1 || t16 + i * 8192u < (unsigned)BYTES) *(LAS v4u*)(dst + t16 + i * 8192u) = tmp[i];
}
__device__ __forceinline__ void s5_st_p(LAS unsigned char* dst, const v4u (&tmp)[8], unsigned t16) {
#pragma unroll
    for (int i = 0; i < 8; ++i) { const unsigned o = t16 + i * 8192u; *(LAS v4u*)(dst + (o >> 9) * S5_PP + (o & 511)) = tmp[i]; }
}
__device__ __forceinline__ void s5_copy_p(LAS unsigned char* dst, const unsigned char* src, int tid) {
    unsigned t16 = (unsigned)tid * 16u; asm volatile("" : "+v"(t16));
    v4u tmp[8];
#pragma unroll
    for (int i = 0; i < 8; ++i) tmp[i] = *(const v4u*)(src + t16 + i * 8192u);
#pragma unroll
    for (int i = 0; i < 8; ++i) { const unsigned o = t16 + i * 8192u; *(LAS v4u*)(dst + (o >> 9) * S5_PP + (o & 511)) = tmp[i]; }
}
#define S5_LOAD_UF(uf) bf16x8 uf[16]; { unsigned uo_ = (unsigned)(((1 + 32 * wv + r32) * 256 + 8 * h) * 2); asm volatile("" : "+v"(uo_)); const unsigned char* up_ = (const unsigned char*)Ug + uo_; \
    _Pragma("unroll") for (int ks = 0; ks < 16; ++ks) uf[ks] = *(const bf16x8*)(up_ + 32 * ks); }
#define S5_LDUF(uf) { unsigned uo_ = (unsigned)(((1 + 32 * wv + r32) * 256 + 8 * h) * 2); asm volatile("" : "+v"(uo_)); const unsigned char* up_ = (const unsigned char*)Ug + uo_; \
    _Pragma("unroll") for (int ks = 0; ks < 16; ++ks) uf[ks] = *(const bf16x8*)(up_ + 32 * ks); }
template <int CTRL> __device__ __forceinline__ float s5_dpp(float x) { return __builtin_bit_cast(float, __builtin_amdgcn_update_dpp(0, __builtin_bit_cast(int, x), CTRL, 0xf, 0xf, false)); }
#define S5_PIN8(A, B, r0) asm volatile("" : "+v"(A[r0]), "+v"(A[r0 + 1]), "+v"(A[r0 + 2]), "+v"(A[r0 + 3]), "+v"(B[r0]), "+v"(B[r0 + 1]), "+v"(B[r0 + 2]), "+v"(B[r0 + 3]))
#define S5_FENCE(p, reg) do { if (((reg) & 3) == 3) { S5_PIN8(S[2 * (p)], S[2 * (p) + 1], (reg) - 3); if ((reg) < 15) S5_PIN8(S[2 * (p)], S[2 * (p) + 1], (reg) + 1); else if ((p) == 0) S5_PIN8(S[2], S[3], 0); } } while (0)
template <int dir> __device__ __forceinline__ void s5_dir(Frame& F, int g, const bf16* Ug, const v4u (&cpt)[2], bf16x8 (&xf)[4][2]) {
    LAS unsigned char* L = F.lds;
    const int tid = F.tid, lane = F.lane, r32 = lane & 31, h = lane >> 5, fr = lane & 15, wv = F.wave;
    const unsigned char* ob = (const unsigned char*)F.out;
        { unsigned t16 = (unsigned)tid * 16u; asm volatile("" : "+v"(t16)); s5_st<8320>(L + S5_C, cpt, t16); }
        __syncthreads();
        if (dir == 0) {
            const int rho = tid >> 2, qq = tid & 3; float acc = 0.f;
#pragma unroll
            for (int p8 = 0; p8 < 8; ++p8) { const int q = 8 * qq + p8; const v4u pw = *(const LAS v4u*)(L + S5_A + rho * S5_PP + (q << 4)), uw = *(const LAS v4u*)(L + S5_U0 + q * 16);
                acc += bf2f((bf16)(pw.x & 0xffff)) * bf2f((bf16)(uw.x & 0xffff)) + bf2f((bf16)(pw.x >> 16)) * bf2f((bf16)(uw.x >> 16)) + bf2f((bf16)(pw.y & 0xffff)) * bf2f((bf16)(uw.y & 0xffff)) + bf2f((bf16)(pw.y >> 16)) * bf2f((bf16)(uw.y >> 16))
                     + bf2f((bf16)(pw.z & 0xffff)) * bf2f((bf16)(uw.z & 0xffff)) + bf2f((bf16)(pw.z >> 16)) * bf2f((bf16)(uw.z >> 16)) + bf2f((bf16)(pw.w & 0xffff)) * bf2f((bf16)(uw.w & 0xffff)) + bf2f((bf16)(pw.w >> 16)) * bf2f((bf16)(uw.w >> 16)); }
            { int lo_ = lane; asm volatile("" : "+v"(lo_));
              acc += __builtin_bit_cast(float, __builtin_amdgcn_ds_bpermute((lo_ ^ 1) << 2, __builtin_bit_cast(int, acc))); acc += __builtin_bit_cast(float, __builtin_amdgcn_ds_bpermute((lo_ ^ 2) << 2, __builtin_bit_cast(int, acc))); }
            if (qq == 0) { const int part = (rho >> 5) & 1, n = (rho & 31) + 32 * (rho >> 6); ((LAS float*)(L + S5_X0))[part * 64 + n] = acc; }
        }
        f32x16 S[4];
#pragma unroll
        for (int rt = 0; rt < 4; ++rt) S[rt] = (f32x16){0.f,0.f,0.f,0.f,0.f,0.f,0.f,0.f,0.f,0.f,0.f,0.f,0.f,0.f,0.f,0.f};
        { unsigned pbo = (unsigned)((dir ? S5_B : S5_A) + r32 * S5_PP + h * 16); asm volatile("" : "+v"(pbo)); const LAS unsigned char* Pb = L + pbo; S5_LOAD_UF(uf)
#pragma unroll
          for (int ks = 0; ks < 16; ++ks) {
#pragma unroll
            for (int rt = 0; rt < 4; ++rt) S[rt] = MFMA32(*(const LAS bf16x8*)(Pb + rt * 32 * S5_PP + ks * 32), uf[ks], S[rt]); __builtin_amdgcn_sched_barrier(0); } }
        unsigned l5o = (unsigned)(S5_L5 + dir * 2560); asm volatile("" : "+v"(l5o)); const LAS float* L5 = (const LAS float*)(L + l5o); const LAS float* L5h = L5 + 8 * h;
#pragma unroll
        for (int p = 0; p < 2; ++p)
#pragma unroll
            for (int reg = 0; reg < 16; ++reg) { const int n = 32 * p + (reg & 3) + 8 * (reg >> 2);
#define S5_STEP(sstep) { constexpr int CT = (dir ? 0x100 : 0x110) | (1 << (sstep)); const f32x2 lam = *(const LAS f32x2*)(L5h + ((sstep) * 64 + n) * 2); \
                    const float tr = s5_dpp<CT>(S[2 * p][reg]), ti = s5_dpp<CT>(S[2 * p + 1][reg]); S[2 * p][reg] += lam.x * tr - lam.y * ti; S[2 * p + 1][reg] += lam.x * ti + lam.y * tr; }
                S5_STEP(0) S5_STEP(1) S5_STEP(2) S5_STEP(3)
#undef S5_STEP
                S5_FENCE(p, reg); }
        { unsigned tw = (unsigned)(S5_TOT + (2 * wv + (r32 >> 4)) * 512 + h * 16); asm volatile("" : "+v"(tw)); LAS float* tot = (LAS float*)(L + tw);
          if (fr == (dir ? 0 : 15)) {
#pragma unroll
            for (int p = 0; p < 2; ++p)
#pragma unroll
                for (int reg = 0; reg < 16; ++reg) { const int n = 32 * p + (reg & 3) + 8 * (reg >> 2); tot[n] = S[2 * p][reg]; tot[64 + n] = S[2 * p + 1][reg]; } } }
        __syncthreads();
        { unsigned toto = (unsigned)(S5_TOT + lane * 4), x0o = (unsigned)(S5_X0 + lane * 4); asm volatile("" : "+v"(toto), "+v"(x0o));
          const LAS float* tot = (const LAS float*)(L + toto); const f32x2 l256 = *(const LAS f32x2*)(L5 + (4 * 64 + lane) * 2);
          float wr_ = dir ? 0.f : ((const LAS float*)(L + x0o))[0], wi_ = dir ? 0.f : ((const LAS float*)(L + x0o))[64];
          float w0r = 0.f, w0i = 0.f, w1r = 0.f, w1i = 0.f;
          const int s0 = dir ? 2 * wv + 1 : 2 * wv, s1 = dir ? 2 * wv : 2 * wv + 1;
          for (int kk = 0; kk < 16; ++kk) { const int k = dir ? 15 - kk : kk;
              if (k == s0) { w0r = wr_; w0i = wi_; } if (k == s1) { w1r = wr_; w1i = wi_; }
              const float tr = tot[k * 128], ti = tot[k * 128 + 64];
              const float nr = l256.x * wr_ - l256.y * wi_ + tr, ni = l256.x * wi_ + l256.y * wr_ + ti; wr_ = nr; wi_ = ni; }
          if (dir == 1 && wv == 0) { ((LAS float*)(L + x0o))[128] = wr_; ((LAS float*)(L + x0o))[192] = wi_; }
          __syncthreads();
          LAS float* win = (LAS float*)(L + toto);
          win[s0 * 128] = w0r; win[s0 * 128 + 64] = w0i; win[s1 * 128] = w1r; win[s1 * 128 + 64] = w1i; }
        LDS_WAIT(); asm volatile("" ::: "memory");
        { unsigned wino = (unsigned)(S5_TOT + (2 * wv + (r32 >> 4)) * 512 + h * 16), cpo = (unsigned)(S5_C + fr * 520 + h * 32); asm volatile("" : "+v"(wino), "+v"(cpo));
          const LAS float* win = (const LAS float*)(L + wino); const LAS float* CP = (const LAS float*)(L + cpo);
#pragma unroll
          for (int p = 0; p < 2; ++p)
#pragma unroll
            for (int reg = 0; reg < 16; ++reg) { const int n = 32 * p + (reg & 3) + 8 * (reg >> 2);
                const float er = s5_dpp<(dir ? 0x100 : 0x110) | 1>(S[2 * p][reg]), ei = s5_dpp<(dir ? 0x100 : 0x110) | 1>(S[2 * p + 1][reg]);
                const f32x2 cp = *(const LAS f32x2*)(CP + 2 * n); const float wr_ = win[n], wi_ = win[64 + n];
                S[2 * p][reg] = er + cp.x * wr_ - cp.y * wi_; S[2 * p + 1][reg] = ei + cp.x * wi_ + cp.y * wr_; S5_FENCE(p, reg); }
#pragma unroll
          for (int rt = 0; rt < 4; ++rt)
#pragma unroll
            for (int s = 0; s < 2; ++s) { v4u w; w.x = cvtpk(S[rt][8 * s], S[rt][8 * s + 1]); w.y = cvtpk(S[rt][8 * s + 2], S[rt][8 * s + 3]); w.z = cvtpk(S[rt][8 * s + 4], S[rt][8 * s + 5]); w.w = cvtpk(S[rt][8 * s + 6], S[rt][8 * s + 7]);
                xf[rt][s] = __builtin_bit_cast(bf16x8, w); } }
        __syncthreads();
}
__device__ __forceinline__ void s5_block(Frame& F, int b, int g) {
    LAS unsigned char* L = F.lds;
    const int tid = F.tid, lane = F.lane, r32 = lane & 31, h = lane >> 5, fr = lane & 15, wv = F.wave;
    const unsigned char* ob = (const unsigned char*)F.out;
    const bf16* Ug = WSP(bf16, WS_U) + (size_t)(b * 64 + g) * LPOS * 16;
    v4u cpt[2];
    { unsigned t16 = (unsigned)tid * 16u; asm volatile("" : "+v"(t16));
      v4u pa[8], la[1], lb[1], u0v = {0u, 0u, 0u, 0u};
      s5_ld<65536>(pa, ob + OUT_P + (size_t)g * 65536, t16);
      s5_ld<2560>(la, ob + OUT_L5 + (size_t)g * 2560, t16); s5_ld<2560>(lb, ob + OUT_L5 + (size_t)(64 + g) * 2560, t16);
      if (tid < 32) u0v = *(const v4u*)((const unsigned char*)Ug + t16);
      s5_ld<8320>(cpt, ob + OUT_CP + (size_t)g * 9216, t16);
      s5_st_p(L + S5_A, pa, t16);
      s5_st<2560>(L + S5_L5, la, t16); s5_st<2560>(L + S5_L5 + 2560, lb, t16);
      if (tid < 32) *(LAS v4u*)(L + S5_U0 + t16) = u0v; }
    { unsigned t16 = (unsigned)tid * 16u; asm volatile("" : "+v"(t16));
      v4u pb[8]; s5_ld<65536>(pb, ob + OUT_P + (size_t)(64 + g) * 65536, t16);
      s5_st_p(L + S5_B, pb, t16); }
    bf16x8 xf0[4][2], xf1[4][2];
    s5_dir<0>(F, g, Ug, cpt, xf0);
    { unsigned t16 = (unsigned)tid * 16u; asm volatile("" : "+v"(t16)); s5_ld<8320>(cpt, ob + OUT_CP + (size_t)(64 + g) * 9216, t16); }
    s5_dir<1>(F, g, Ug, cpt, xf1);
    s5_copy<65536>(L + S5_A, ob + OUT_R + (size_t)g * 65536, tid);
    s5_copy<65536>(L + S5_B, ob + OUT_R + (size_t)(64 + g) * 65536, tid);
    { unsigned t16 = (unsigned)tid * 16u; asm volatile("" : "+v"(t16));
      v4u kf[2], kb2[2];
      s5_ld<8704>(kf, ob + OUT_KL + (size_t)g * 9216, t16); s5_ld<8704>(kb2, ob + OUT_KL + (size_t)(64 + g) * 9216, t16);
      s5_st<8704>(L + S5_C, kf, t16); s5_st<8704>(L + S5_C + 8704, kb2, t16); }
    __syncthreads();
    { S5_LOAD_UF(uf)
#pragma unroll
    for (int hf = 0; hf < 4; ++hf) {
        f32x16 Y[2];
#pragma unroll
        for (int t2 = 0; t2 < 2; ++t2) Y[t2] = (f32x16){0.f,0.f,0.f,0.f,0.f,0.f,0.f,0.f,0.f,0.f,0.f,0.f,0.f,0.f,0.f,0.f};
#pragma unroll
        for (int t2 = 0; t2 < 2; ++t2) { const int RT = 2 * hf + t2;
            unsigned kfo = (unsigned)(S5_C + ((r32 & 15) * 16 + 8 * h) * 2 + (r32 >> 4) * 512), kbo = (unsigned)(S5_C + 8704 + ((r32 & 15) * 16 + 8 * h) * 2 - (r32 >> 4) * 512);
            asm volatile("" : "+v"(kfo), "+v"(kbo)); const LAS unsigned char* KLf = L + kfo; const LAS unsigned char* KLb = L + kbo;
#pragma unroll
            for (int k4 = 0; k4 < 4; ++k4) {
                bf16x8 ff[4], fb[4];
#pragma unroll
                for (int q = 0; q < 4; ++q) { const int ks = 4 * k4 + q;
                    if (ks <= 2 * RT + 1) ff[q] = *(const LAS bf16x8*)(KLf + (2 * RT - ks + 1) * 512);
                    if (ks >= 2 * RT) fb[q] = *(const LAS bf16x8*)(KLb + (ks - 2 * RT + 1) * 512); }
                __builtin_amdgcn_sched_barrier(0);
#pragma unroll
                for (int q = 0; q < 4; ++q) { const int ks = 4 * k4 + q;
                    if (ks <= 2 * RT + 1) Y[t2] = MFMA32(ff[q], uf[ks], Y[t2]);
                    if (ks >= 2 * RT) Y[t2] = MFMA32(fb[q], uf[ks], Y[t2]); }
                __builtin_amdgcn_sched_barrier(0); }
            unsigned fx = (unsigned)((fr ^ h) << 4); asm volatile("" : "+v"(fx));
#pragma unroll
            for (int dir = 0; dir < 2; ++dir) { unsigned rbo = (unsigned)((dir ? S5_B : S5_A) + r32 * 256); asm volatile("" : "+v"(rbo)); const LAS unsigned char* Rb = L + rbo + RT * 8192;
#pragma unroll
                for (int rb = 0; rb < 2; ++rb) { bf16x8 rf[4];
#pragma unroll
                    for (int q = 0; q < 4; ++q) rf[q] = *(const LAS bf16x8*)(Rb + (((4 * rb + q) * 32) ^ fx));
                    __builtin_amdgcn_sched_barrier(0);
#pragma unroll
                    for (int q = 0; q < 4; ++q) Y[t2] = MFMA32(rf[q], (dir ? xf1[2 * rb + (q >> 1)][q & 1] : xf0[2 * rb + (q >> 1)][q & 1]), Y[t2]);
                    __builtin_amdgcn_sched_barrier(0); } } }
        const int chunk = 1 + 32 * wv + r32;
#pragma unroll
        for (int t2 = 0; t2 < 2; ++t2)
#pragma unroll
            for (int il = 0; il < 2; ++il) { const int pos = chunk * 16 + 2 * (2 * hf + t2) + il; bf16* yp = OUTP(bf16, OUT_YG) + (size_t)(b * SEQ + pos - 16) * 1024 + g * 16 + 4 * h;
#pragma unroll
                for (int cg = 0; cg < 2; ++cg) { const int r0 = 8 * il + 4 * cg; v2u w; w.x = cvtpk(gelu_tanh(Y[t2][r0]), gelu_tanh(Y[t2][r0 + 1])); w.y = cvtpk(gelu_tanh(Y[t2][r0 + 2]), gelu_tanh(Y[t2][r0 + 3]));
                    *(v2u*)(yp + 8 * cg) = w; } }
        __builtin_amdgcn_sched_barrier(0);
    } }
    if (tid < 256) {
        const int c = tid >> 4, q = tid & 15; float acc = 0.f;
        { const LAS unsigned char* kf = L + S5_C + ((16 - q) * 256 + c * 16) * 2; const LAS unsigned char* u0 = L + S5_U0 + q * 32;
#pragma unroll
          for (int e = 0; e < 16; ++e) acc += bf2f(*(const LAS bf16*)(kf + 2 * e)) * bf2f(*(const LAS bf16*)(u0 + 2 * e)); }
        if (q == 0) { const LAS unsigned char* kb = L + S5_C + 8704 + (1 * 256 + c * 16) * 2; const LAS unsigned char* u15 = L + S5_U0 + 15 * 32;
#pragma unroll
          for (int e = 0; e < 16; ++e) acc += bf2f(*(const LAS bf16*)(kb + 2 * e)) * bf2f(*(const LAS bf16*)(u15 + 2 * e)); }
        { const int row = 240 + c; const LAS unsigned char* rp = L + S5_B + row * 256 + ((q ^ (row & 15)) << 4); const LAS float* xb0 = (const LAS float*)(L + S5_XB0);
          const int rt = q >> 2, s = (q >> 1) & 1, hh = q & 1;
#pragma unroll
          for (int j = 0; j < 8; ++j) { const int sig = 16 * s + 8 * (j >> 2) + 4 * hh + (j & 3); acc += bf2f(*(const LAS bf16*)(rp + 2 * j)) * xb0[(rt & 1) * 64 + 32 * (rt >> 1) + sig]; } }
#pragma unroll
        for (int o = 1; o < 16; o <<= 1) acc += __shfl_xor(acc, o);
        if (q == 0) SMP(bf16, SM_AYG15)[b * 1024 + g * 16 + c] = (bf16)f2bf(gelu_tanh(acc));
    }
    __syncthreads();
}

__device__ __forceinline__ void p5_fixup_panel(Frame& F, int pm) {
    const float* EA = WSP(float, WS_EA); const float* EP = WSP(float, WS_EP); const float* EG = WSP(float, WS_EG);
    const float* cw = F.in[IN_CONVW]; bf16* ACT = WSP(bf16, WS_ACT);
    constexpr int NJ = (DFF / 4 + NWAVES * 64 - 1) / (NWAVES * 64);
    f32x4 w0[NJ], w2[NJ], p[NJ][2], g[NJ][2], nb[NJ][2];
#pragma unroll
    for (int q = 0; q < NJ; ++q) { const int j = (F.tid + q * NWAVES * 64) * 4; if (j < DFF) {
        w0[q] = *(const f32x4*)(cw + j); w2[q] = *(const f32x4*)(cw + 2 * DFF + j);
#pragma unroll
        for (int side = 0; side < 2; ++side) { const int er = 8 * pm + 7 * side, eblk = er >> 1, row = eblk * 64 + (side ? 63 : 0);
            p[q][side] = *(const f32x4*)(EP + (size_t)er * DFF + j); g[q][side] = *(const f32x4*)(EG + (size_t)er * DFF + j);
            if (!side) nb[q][side] = ((row & 4095) == 0) ? *(const f32x4*)(SMP(float, SM_A15) + (row >> 12) * DFF + j) : *(const f32x4*)(EA + (size_t)((eblk - 1) * 2 + 1) * DFF + j);
            else nb[q][side] = ((row & 4095) == 4095) ? (f32x4){0.f, 0.f, 0.f, 0.f} : *(const f32x4*)(EA + (size_t)((eblk + 1) * 2) * DFF + j); } } }
#pragma unroll
    for (int q = 0; q < NJ; ++q) { const int j = (F.tid + q * NWAVES * 64) * 4; if (j < DFF) {
#pragma unroll
        for (int side = 0; side < 2; ++side) { const int er = 8 * pm + 7 * side, row = (er >> 1) * 64 + (side ? 63 : 0); const f32x4 v = p[q][side] + (side ? w2[q] : w0[q]) * nb[q][side];
            v2u w; w.x = cvtpk(gelu_tanh(v[0]) * g[q][side][0], gelu_tanh(v[1]) * g[q][side][1]); w.y = cvtpk(gelu_tanh(v[2]) * g[q][side][2], gelu_tanh(v[3]) * g[q][side][3]);
            *(v2u*)(ACT + act_off(row, j)) = w; } } }
}
__device__ __forceinline__ void p7_final(Frame& F) {
    const float* rowsq = (const float*)(F.ws + WS_CTL + CTL_ROWSQ3); const f32x4* gf = (const f32x4*)F.in[IN_GF] + F.lane;
    for (int m = F.gw; m < M; m += 2 * F.NGW) {
        const int m2 = m + F.NGW;
        const float rs = 1.0f / sqrtf(rowsq[m] * (1.0f / DM) + EPS), rs2 = 1.0f / sqrtf(rowsq[m2] * (1.0f / DM) + EPS);
        const v2u* hr = (const v2u*)(WSP(bf16, WS_H3B) + (size_t)m * DM) + F.lane; const v2u* hr2 = (const v2u*)(WSP(bf16, WS_H3B) + (size_t)m2 * DM) + F.lane;
        f32x4* xr = (f32x4*)(F.out + (size_t)m * DM) + F.lane; f32x4* xr2 = (f32x4*)(F.out + (size_t)m2 * DM) + F.lane;
        v2u a[8], b[8];
#pragma unroll
        for (int j = 0; j < 8; ++j) { a[j] = hr[64 * j]; b[j] = hr2[64 * j]; }
#pragma unroll
        for (int j = 0; j < 8; ++j) { const f32x4 g = gf[64 * j];
            f32x4 va, vb; va[0] = __builtin_bit_cast(float, a[j].x << 16); va[1] = __builtin_bit_cast(float, a[j].x & 0xffff0000u); va[2] = __builtin_bit_cast(float, a[j].y << 16); va[3] = __builtin_bit_cast(float, a[j].y & 0xffff0000u);
            vb[0] = __builtin_bit_cast(float, b[j].x << 16); vb[1] = __builtin_bit_cast(float, b[j].x & 0xffff0000u); vb[2] = __builtin_bit_cast(float, b[j].y << 16); vb[3] = __builtin_bit_cast(float, b[j].y & 0xffff0000u);
            xr[64 * j] = va * rs * g; xr2[64 * j] = vb * rs2 * g; }
    }
}

#ifndef MK_N_LAUNCHES
#define MK_N_LAUNCHES 1
#endif
constexpr int N_PHASES = 10;
#ifndef GEMM_ALIGN
#define GEMM_ALIGN true
#endif
#ifndef GEMM_SP2
#define GEMM_SP2 true
#endif
struct Args { const float* in[23]; float* out; unsigned char* ws; int ph_lo, ph_hi, li, pad; };
__global__ void __launch_bounds__(NWAVES * 64, 2) skel_fwd(Args args) {
    extern __shared__ __attribute__((aligned(16))) unsigned char lds_raw[];
    Frame F;
    F.lds = (LAS unsigned char*)lds_raw;
    F.tid = threadIdx.x; F.lane = F.tid & 63; F.wave = __builtin_amdgcn_readfirstlane(F.tid >> 6);
    F.G = gridDim.x; { const int bx = blockIdx.x; F.vcu = (F.G % 8 == 0) ? (bx % 8) * (F.G / 8) + bx / 8 : bx; }
    F.gw = F.vcu * NWAVES + F.wave; F.NGW = F.G * NWAVES;
#pragma unroll
    for (int i = 0; i < 23; ++i) F.in[i] = args.in[i];
    F.out = args.out; F.ws = args.ws;
    volatile LAS unsigned* MISC = (volatile LAS unsigned*)(F.lds + MISC_OFF);
    for (int u = F.tid; u < (LDS_BYTES - RING_BYTES) / 4; u += NWAVES * 64) ((LAS unsigned*)(F.lds + RING_BYTES))[u] = 0u;
    __syncthreads();
    XcdBarrier bar; bar.bar = (unsigned*)(F.ws + WS_CTL) + CW_BAR; bar.x = 0; bar.st = nullptr;
    if (MK_N_LAUNCHES == 1) bar = xcd_barrier_post((unsigned*)(F.ws + WS_CTL) + CW_BAR, MISC + 8);
    const int lo = args.ph_lo, hi = args.ph_hi;
#define IN(k) (lo <= (k) && (k) < hi)
#define SEAM(k) do { if (IN(k) && IN((k) + 1)) xcd_barrier(bar); } while (0)
    const int bid = (int)blockIdx.x;

    if (IN(0)) { p0_prologue(F); } SEAM(0);

    if (IN(1)) {
        p1_meta(F); VM_WAIT(); __syncthreads();
        { pg8::Gemm g{WSP(bf16, WS_XB), WSP(bf16, WS_WIN) + (size_t)2048 * DM, M, 1024, DM}; pg8::StaticOrder S; S.init(M, 1024, F.G, bid);
          EpiG1 E{SMP(float, SM_R1), WSP(bf16, WS_Q), WSP(bf16, WS_K), WSP(bf16, WS_U), WSP(unsigned char, WS_SGNA), WSP(unsigned char, WS_SGSSM), 8};
          pg8::gemm_phase<EpiG1, pg8::StaticOrder, GEMM_ALIGN, GEMM_SP2>(F.lds, g, S, E);
          }
        { pg8::Gemm g{OUTP(bf16, OUT_XB8), OUTP(bf16, OUT_W8), M, 6144, DM / 2}; pg8::StaticOrder S; S.init(M, 6144, F.G, bid, 4);
          EpiQKG E{SMP(float, SM_R1), WSP(bf16, WS_Q), WSP(bf16, WS_K), WSP(unsigned char, WS_SGNA), WSP(unsigned char, WS_SGSSM)};
          pg8::gemm_phase<EpiQKG, pg8::StaticOrder, GEMM_ALIGN, GEMM_SP2, true>(F.lds, g, S, E);
          }
        { pg8::Gemm g{OUTP(bf16, OUT_WV8), OUTP(bf16, OUT_XB8), 1024, M, DM / 2}; pg8::StaticOrder S; S.init(1024, M, F.G, bid);
          EpiVt E{SMP(float, SM_R1), WSP(bf16, WS_VT)};
          pg8::gemm_phase<EpiVt, pg8::StaticOrder, GEMM_ALIGN, GEMM_SP2, true>(F.lds, g, S, E);
          }
    } SEAM(1);

    if (IN(2)) {
        for (int bg = F.vcu; bg < NB * 64; bg += F.G) s5_block(F, bg >> 6, bg & 63);
        if (F.wave == 7 && F.vcu < NHEAD) p2_meta_attn(F, F.vcu);
        LAS bf16* P = (LAS bf16*)(F.lds + F.wave * 9216);
        { constexpr int NGRP = NB * NHEAD * 32;
          v4u kp[9]; float bp[2]; bf16x8 qf[2]; int gi = F.vcu;
          if (gi < NGRP) { na_prefetch(F, gi, kp, bp); na_commit(F, kp, bp); na_qload(F, gi, qf); }
          __syncthreads();
          for (; gi < NGRP; gi += F.G) { const bool hn = gi + F.G < NGRP;
              if (hn) na_prefetch(F, gi + F.G, kp, bp);
              na_task(F, gi, P, kp, bp, qf, hn);
              __syncthreads(); } }
    } SEAM(2);

    if (IN(3)) {
        p3a_meta(F); VM_WAIT(); __syncthreads();
        pg8::Gemm g{OUTP(bf16, OUT_YG), WSP(bf16, WS_WGLU), M, 1024, 1024}; pg8::StaticOrder S; S.init(M, 1024, F.G, bid);
        EpiGlu E{OUTP(bf16, OUT_YG), OUTP(bf16, OUT_SGLU)};
        pg8::gemm_phase<EpiGlu, pg8::StaticOrder, GEMM_ALIGN, GEMM_SP2>(F.lds, g, S, E);
    } SEAM(3);

    if (IN(4)) {
        p3b_meta(F); VM_WAIT(); __syncthreads();
        { pg8::Gemm g{WSP(bf16, WS_O), OUTP(bf16, OUT_WNA8), M, DM, 512}; pg8::StaticOrder S; S.init(M, DM, F.G, bid, 4);
          EpiMix<false> E{WSP(unsigned char, WS_SGNA), WSP(bf16, WS_MIX), 1.0f / (255.f * 1024.f)};
          pg8::gemm_phase<EpiMix<false>, pg8::StaticOrder, GEMM_ALIGN, GEMM_SP2, true>(F.lds, g, S, E);
          }
        { pg8::Gemm g{OUTP(bf16, OUT_SGLU), WSP(bf16, WS_WSSM), M, DM, 1024}; pg8::StaticOrder S; S.init(M, DM, F.G, bid, 4);
          EpiMix<true> E{WSP(unsigned char, WS_SGSSM), WSP(bf16, WS_MIX), 1.0f / 255.f};
          pg8::gemm_phase<EpiMix<true>, pg8::StaticOrder, GEMM_ALIGN, GEMM_SP2>(F.lds, g, S, E); }
    } SEAM(4);

    if (IN(5)) {
        p3c_meta(F); VM_WAIT(); __syncthreads();
        pg8::Gemm g{WSP(bf16, WS_MIX), WSP(bf16, WS_WOUT), M, DM, DM}; pg8::StaticOrder S; S.init(M, DM, F.G, bid, 4);
        EpiRes<true> E{WSP(bf16, WS_XB), WSP(bf16, WS_H2B), (float*)(F.ws + WS_CTL + CTL_ROWSQ2)};
        pg8::gemm_phase<EpiRes<true>, pg8::StaticOrder, GEMM_ALIGN, GEMM_SP2>(F.lds, g, S, E);
    } SEAM(5);

    if (IN(6)) {
        p4_meta(F); VM_WAIT(); __syncthreads();
        pg8::Gemm g{WSP(bf16, WS_H2B), WSP(bf16, WS_WUP), M, 2 * DFF, DM}; pg8::StaticOrder S; S.init(M, 2 * DFF, F.G, bid, 4);
        EpiUp E{(const float*)(F.ws + WS_CTL + CTL_ROWSQ2), F.in[IN_CONVW], F.in[IN_CONVB], WSP(bf16, WS_ACT), WSP(float, WS_EA), WSP(float, WS_EP), WSP(float, WS_EG), F.lds + RING_BYTES};
        pg8::gemm_phase<EpiUp, pg8::StaticOrder, GEMM_ALIGN, GEMM_SP2>(F.lds, g, S, E);
    } SEAM(6);

    if (IN(8)) {
        pg8::Gemm g{WSP(bf16, WS_ACT), WSP(bf16, WS_WDOWN), M, DM, DFF, 1}; pg8::StaticOrder S; S.init(M, DM, F.G, bid, 4);
        { pg8::Unit u; int lastpm = -1; for (int i = 0; S.next(i, u); ++i) if (u.pm != lastpm) { p5_fixup_panel(F, u.pm); lastpm = u.pm; } }
        VM_WAIT(); __syncthreads();
        EpiRes<false> E{WSP(bf16, WS_H2B), WSP(bf16, WS_H3B), (float*)(F.ws + WS_CTL + CTL_ROWSQ3)};
        pg8::gemm_phase<EpiRes<false>, pg8::StaticOrder, GEMM_ALIGN, GEMM_SP2>(F.lds, g, S, E);
    } SEAM(8);

    if (IN(9)) { p7_final(F); }

#undef IN
#undef SEAM
}

extern "C" void kernel_launch(void* const* d_in, const int* in_sizes, int n_in, void* d_out, int out_size, void* d_ws, size_t ws_size, hipStream_t stream) {
    static int grid = 0;
    if (grid == 0) {
        if (n_in != 23 || out_size != M * DM || ws_size < WS_END) { fprintf(stderr, "kernel_launch: unexpected shapes (n_in %d out %d ws %zu)\n", n_in, out_size, ws_size); grid = -1; return; }
        int dev = 0, cus = 0, per_cu = 0;
        if (hipGetDevice(&dev) != hipSuccess || hipDeviceGetAttribute(&cus, hipDeviceAttributeMultiprocessorCount, dev) != hipSuccess) { grid = -1; return; }
        if (hipFuncSetAttribute((const void*)skel_fwd, hipFuncAttributeMaxDynamicSharedMemorySize, LDS_BYTES) != hipSuccess) { fprintf(stderr, "kernel_launch: hipFuncSetAttribute failed\n"); grid = -1; return; }
        if (hipOccupancyMaxActiveBlocksPerMultiprocessor(&per_cu, (const void*)skel_fwd, NWAVES * 64, LDS_BYTES) != hipSuccess || per_cu < 1) fprintf(stderr, "kernel_launch: occupancy query reports %d\n", per_cu);
        (void)hipGetLastError();
        grid = cus;
    }
    if (grid < 0) return;
    if (hipMemsetAsync((char*)d_ws + WS_CTL, 0, CTL_ZERO_BYTES, stream) != hipSuccess) return;
    Args a{};
    for (int i = 0; i < 23; ++i) a.in[i] = (const float*)d_in[i];
    a.out = (float*)d_out; a.ws = (unsigned char*)d_ws;
    const int nl = MK_N_LAUNCHES;
    for (int li = 0; li < nl; ++li) {
        a.ph_lo = (MK_N_LAUNCHES == 1) ? 0 : li; a.ph_hi = (MK_N_LAUNCHES == 1) ? N_PHASES : li + 1; a.li = li;
        hipLaunchKernelGGL(skel_fwd, dim3(grid), dim3(NWAVES * 64), LDS_BYTES, stream, a);
        const hipError_t le = hipPeekAtLastError();
        if (le != hipSuccess) { fprintf(stderr, "kernel_launch: launch %d failed: %s\n", li, hipGetErrorName(le)); break; }
    }
}
```
